# Optimizing an MI355X kernel written in HIP

```python
import math
import jax
import jax.numpy as jnp
from jax import lax
import numpy as np

D_MODEL = 2048
BATCH = 4
SEQ = 2048
DEPTH = 2

CTX_LEN = 256
GRID_W = 64
NORM_EPS = 1e-6

DN_HEADS = 8
DN_HEAD_DIM = 128
DN_WIDTH = DN_HEADS * DN_HEAD_DIM
DN_CONV = 5
DN_CHUNK = 64
HG_HEADS = 8
HG_KEY_DIM = 128
HG_VAL_DIM = 128
HG_K_WIDTH = HG_HEADS * HG_KEY_DIM
HG_V_WIDTH = HG_HEADS * HG_VAL_DIM
HG_CHUNK = 64
IN0_SIZES = (3 * DN_WIDTH, DN_WIDTH, 2 * DN_HEADS, 2 * DN_HEADS,
             HG_K_WIDTH, 2 * HG_K_WIDTH, HG_V_WIDTH, HG_V_WIDTH)
IN0_WIDTH = sum(IN0_SIZES)
DA_HEADS = 8
DA_HEAD_DIM = 128
DA_Q_BLOCK = 128
ROPE_BASE = 10000.0
N_EXPERTS = 64
TOP_K = 8
N_GROUPS = 8
TOPK_GROUPS = 4
EXPERT_FF = 512
SHARED_FF = 512
ROUTED_SCALE = 2.5
EXPERT_BLOCK = 128

kernel_name = "hybrid_deltanet_hgrn2_diffattn_moe_dit"


def rms_norm(x, w, eps=NORM_EPS):
    xf = x.astype(jnp.float32)
    y = xf * lax.rsqrt(jnp.mean(jnp.square(xf), axis=-1, keepdims=True) + eps)
    return (y * w.astype(jnp.float32)).astype(x.dtype)


def l2_norm(x, eps=1e-6):
    xf = x.astype(jnp.float32)
    return (xf * lax.rsqrt(jnp.sum(xf * xf, axis=-1, keepdims=True) + eps)).astype(x.dtype)


def split_cols(x, sizes):
    cuts = [int(v) for v in np.cumsum(sizes)[:-1]]
    return jnp.split(x, cuts, axis=-1)


def to_heads(t, n_heads):
    b, l, _ = t.shape
    return t.reshape(b, l, n_heads, -1).transpose(0, 2, 1, 3)


def from_heads(t):
    b, h, l, dh = t.shape
    return t.transpose(0, 2, 1, 3).reshape(b, l, h * dh)


def centred_depthwise_conv(x, w):
    c, k = w.shape
    rhs = jnp.transpose(w)[:, None, :].astype(x.dtype)
    return lax.conv_general_dilated(x, rhs, window_strides=(1,), padding=[(k // 2, k // 2)],
                                    dimension_numbers=("NWC", "WIO", "NWC"),
                                    feature_group_count=c)


def latent_grid_positions(n_tokens):
    rows = n_tokens // GRID_W
    row = jnp.repeat(jnp.arange(rows, dtype=jnp.float32), GRID_W)
    col = jnp.tile(jnp.arange(GRID_W, dtype=jnp.float32), rows)
    return row, col


def axial_rope(x, row, col):
    quarter = x.shape[-1] // 4
    inv_freq = ROPE_BASE ** (-jnp.arange(quarter, dtype=jnp.float32) / quarter)

    def rotate(xs, pos):
        ang = pos[:, None] * inv_freq[None, :]
        cos, sin = jnp.cos(ang), jnp.sin(ang)
        x1 = xs[..., :quarter].astype(jnp.float32)
        x2 = xs[..., quarter:].astype(jnp.float32)
        return jnp.concatenate([x1 * cos - x2 * sin, x2 * cos + x1 * sin], axis=-1)

    half = 2 * quarter
    out = jnp.concatenate([rotate(x[..., :half], row), rotate(x[..., half:], col)], axis=-1)
    return out.astype(x.dtype)


def gated_delta_chunked(q, k, v, g, beta, s0):
    b_, h_, l_, kd = q.shape
    vd = v.shape[-1]
    c = DN_CHUNK
    n = l_ // c
    q = q.astype(jnp.float32).reshape(b_, h_, n, c, kd)
    k = k.astype(jnp.float32).reshape(b_, h_, n, c, kd)
    v = v.astype(jnp.float32).reshape(b_, h_, n, c, vd)
    beta = beta.astype(jnp.float32).reshape(b_, h_, n, c)
    g = jnp.cumsum(g.astype(jnp.float32).reshape(b_, h_, n, c), axis=-1)
    incl = jnp.tril(jnp.ones((c, c), bool))
    strict = jnp.tril(jnp.ones((c, c), bool), -1)
    decay = jnp.exp(jnp.where(incl, g[..., :, None] - g[..., None, :], -jnp.inf))
    kb = k * beta[..., None]
    a_low = jnp.where(strict, jnp.einsum("bhnik,bhnjk->bhnij", kb, k) * decay, 0.0)
    t_mat = a_low + jnp.eye(c, dtype=jnp.float32)
    rhs = jnp.concatenate([v * beta[..., None], kb * jnp.exp(g)[..., None]], axis=-1)
    sol = lax.linalg.triangular_solve(t_mat, rhs, left_side=True, lower=True, unit_diagonal=True)
    u0, w = sol[..., :vd], sol[..., vd:]
    attn = jnp.einsum("bhnik,bhnjk->bhnij", q, k) * decay
    q_dec = q * jnp.exp(g)[..., None]
    k_dec = k * jnp.exp(g[..., -1:] - g)[..., None]
    g_last = jnp.exp(g[..., -1])

    def step(s, xs):
        u0c, wc, ac, qd, kdc, gl = xs
        u = u0c - jnp.einsum("bhck,bhkv->bhcv", wc, s)
        o = jnp.einsum("bhck,bhkv->bhcv", qd, s) + jnp.einsum("bhij,bhjv->bhiv", ac, u)
        s = s * gl[..., None, None] + jnp.einsum("bhck,bhcv->bhkv", kdc, u)
        return s, o

    xs = tuple(jnp.moveaxis(a, 2, 0) for a in (u0, w, attn, q_dec, k_dec, g_last))
    s_fin, o = lax.scan(step, s0.astype(jnp.float32), xs)
    return jnp.moveaxis(o, 0, 2).reshape(b_, h_, l_, vd), s_fin


def hgrn2_chunked(q, k, v, log_f, s0):
    b_, h_, l_, kd = q.shape
    vd = v.shape[-1]
    c = HG_CHUNK
    n = l_ // c

    def chunks(t):
        return jnp.moveaxis(t.astype(jnp.float32).reshape(b_, h_, n, c, t.shape[-1]), 2, 0)

    incl = jnp.tril(jnp.ones((c, c), bool))[:, :, None]

    def step(s, xs):
        qc, kc, vc, lf = xs
        cum = jnp.cumsum(lf, axis=2)
        diff = cum[:, :, :, None, :] - cum[:, :, None, :, :]
        dec = jnp.exp(jnp.where(incl, diff, -jnp.inf))
        a = jnp.sum(qc[:, :, :, None, :] * kc[:, :, None, :, :] * dec, axis=-1)
        o = (jnp.einsum("bhik,bhkv->bhiv", qc * jnp.exp(cum), s)
             + jnp.einsum("bhij,bhjv->bhiv", a, vc))
        last = cum[:, :, -1:, :]
        s = (s * jnp.exp(last[:, :, 0, :])[..., None]
             + jnp.einsum("bhjk,bhjv->bhkv", kc * jnp.exp(last - cum), vc))
        return s, o

    s_fin, o = lax.scan(step, s0.astype(jnp.float32), (chunks(q), chunks(k), chunks(v), chunks(log_f)))
    return jnp.moveaxis(o, 0, 2).reshape(b_, h_, l_, vd), s_fin


def two_segment_scan(scan_fn, ctx_args, lat_args, s0, reverse):
    if reverse:
        ctx_args = tuple(jnp.flip(a, axis=2) for a in ctx_args)
        lat_args = tuple(jnp.flip(a, axis=2) for a in lat_args)
    out_ctx, s_ctx = scan_fn(*ctx_args, s0)
    out_lat, _ = scan_fn(*lat_args, s_ctx)
    if reverse:
        out_ctx, out_lat = jnp.flip(out_ctx, axis=2), jnp.flip(out_lat, axis=2)
    return out_ctx, out_lat


def mixer_delta_hgrn(hl, hc, layer_idx, need_ctx, w_in, dn_conv, dn_a_log, dn_dt_bias, dn_norm,
                     hg_lb_logits, hg_norm, w_out):
    lb = jnp.cumsum(jax.nn.softmax(hg_lb_logits.astype(jnp.float32), axis=0), axis=0)[layer_idx]

    def prepare(h):
        b_, l_, _ = h.shape
        dn_qkv, dn_z, dn_a, dn_b, hg_q, hg_f, hg_i, hg_og = split_cols(h @ w_in, IN0_SIZES)
        qkv = jax.nn.silu(centred_depthwise_conv(dn_qkv, dn_conv))
        q, k, v = jnp.split(qkv, 3, axis=-1)
        g = -jnp.exp(dn_a_log.astype(jnp.float32)) * jax.nn.softplus(
            dn_a.reshape(b_, l_, 2, DN_HEADS).astype(jnp.float32) + dn_dt_bias.astype(jnp.float32))
        beta = jax.nn.sigmoid(dn_b.reshape(b_, l_, 2, DN_HEADS).astype(jnp.float32))
        f = lb + (1.0 - lb) * jax.nn.sigmoid(hg_f.reshape(b_, l_, 2, HG_K_WIDTH).astype(jnp.float32))
        f = f.reshape(b_, l_, 2, HG_HEADS, HG_KEY_DIM).transpose(2, 0, 3, 1, 4)
        return dict(
            dq=l2_norm(to_heads(q, DN_HEADS)) * DN_HEAD_DIM ** -0.5,
            dk=l2_norm(to_heads(k, DN_HEADS)),
            dv=to_heads(v, DN_HEADS),
            g=g.transpose(2, 0, 3, 1), beta=beta.transpose(2, 0, 3, 1),
            z=to_heads(dn_z, DN_HEADS),
            hq=to_heads(jax.nn.silu(hg_q), HG_HEADS),
            hk=1.0 - f, logf=jnp.log(f),
            hv=to_heads(hg_i, HG_HEADS),
            og=to_heads(hg_og, HG_HEADS))

    pc, pl = prepare(hc), prepare(hl)
    b_ = hl.shape[0]
    s0_dn = jnp.zeros((b_, DN_HEADS, DN_HEAD_DIM, DN_HEAD_DIM), jnp.float32)
    s0_hg = jnp.zeros((b_, HG_HEADS, HG_KEY_DIM, HG_VAL_DIM), jnp.float32)
    dn_c = dn_l = hg_c = hg_l = 0.0
    for d in range(2):
        rev = d == 1
        oc, ol = two_segment_scan(gated_delta_chunked,
                                  (pc["dq"], pc["dk"], pc["dv"], pc["g"][d], pc["beta"][d]),
                                  (pl["dq"], pl["dk"], pl["dv"], pl["g"][d], pl["beta"][d]),
                                  s0_dn, rev)
        dn_c, dn_l = dn_c + oc, dn_l + ol
        oc, ol = two_segment_scan(hgrn2_chunked,
                                  (pc["hq"], pc["hk"][d], pc["hv"], pc["logf"][d]),
                                  (pl["hq"], pl["hk"][d], pl["hv"], pl["logf"][d]),
                                  s0_hg, rev)
        hg_c, hg_l = hg_c + oc, hg_l + ol

    def output(p, dn_o, hg_o, dtype):
        dn = rms_norm(dn_o, dn_norm) * jax.nn.silu(p["z"].astype(jnp.float32))
        hg = rms_norm(hg_o, hg_norm) * jax.nn.sigmoid(p["og"].astype(jnp.float32))
        y = jnp.concatenate([from_heads(dn), from_heads(hg)], axis=-1).astype(dtype)
        return y @ w_out

    yl = output(pl, dn_l, hg_l, hl.dtype)
    yc = output(pc, dn_c, hg_c, hc.dtype) if need_ctx else None
    return yl, yc


def mixer_diff_attn(hl, hc, layer_idx, need_ctx, w_in, q_norm, k_norm, lam, sub_norm, w_out):
    lam_init = 0.8 - 0.6 * math.exp(-0.3 * layer_idx)
    lf = lam.astype(jnp.float32)
    lmbda = jnp.exp(jnp.sum(lf[0] * lf[1])) - jnp.exp(jnp.sum(lf[2] * lf[3])) + lam_init

    def project(h, pos):
        b_, l_, _ = h.shape
        q, k, v = jnp.split(h @ w_in, 3, axis=-1)
        q = rms_norm(q.reshape(b_, l_, DA_HEADS, 2, DA_HEAD_DIM), q_norm).transpose(0, 2, 3, 1, 4)
        k = rms_norm(k.reshape(b_, l_, DA_HEADS, 2, DA_HEAD_DIM), k_norm).transpose(0, 2, 3, 1, 4)
        if pos is not None:
            q, k = axial_rope(q, *pos), axial_rope(k, *pos)
        return q, k, to_heads(v, DA_HEADS)

    def attend(q, k, v):
        s = jnp.einsum("bhsqd,bhskd->bhsqk", q, k,
                       preferred_element_type=jnp.float32) * DA_HEAD_DIM ** -0.5
        p = jax.nn.softmax(s, axis=-1)
        p = p[:, :, 0] - lmbda * p[:, :, 1]
        return jnp.einsum("bhqk,bhkv->bhqv", p.astype(v.dtype), v)

    def finish(o):
        o = rms_norm(o, sub_norm) * (1.0 - lam_init)
        return from_heads(o) @ w_out

    b_, l_, _ = hl.shape
    ql, kl, vl = project(hl, latent_grid_positions(l_))
    qc, kc, vc = project(hc, None)
    k_all = jnp.concatenate([kl, kc], axis=3)
    v_all = jnp.concatenate([vl, vc], axis=2)
    nb = l_ // DA_Q_BLOCK
    qb = ql.reshape(b_, DA_HEADS, 2, nb, DA_Q_BLOCK, DA_HEAD_DIM).transpose(3, 0, 1, 2, 4, 5)
    ol = lax.map(lambda qi: attend(qi, k_all, v_all), qb)
    ol = ol.transpose(1, 2, 0, 3, 4).reshape(b_, DA_HEADS, l_, 2 * DA_HEAD_DIM)
    yl = finish(ol)
    yc = finish(attend(qc, kc, vc)) if need_ctx else None
    return yl, yc


def route(h, router_w, router_b):
    t = h.shape[0]
    scores = jax.nn.sigmoid(jnp.dot(h.astype(jnp.float32), router_w.astype(jnp.float32)))
    biased = scores + router_b.astype(jnp.float32)
    per_group = N_EXPERTS // N_GROUPS
    group_score = jnp.sum(lax.top_k(biased.reshape(t, N_GROUPS, per_group), 2)[0], axis=-1)
    _, top_groups = lax.top_k(group_score, TOPK_GROUPS)
    group_mask = jnp.any(top_groups[..., None] == jnp.arange(N_GROUPS), axis=-2)
    expert_mask = jnp.repeat(group_mask, per_group, axis=-1)
    _, idx = lax.top_k(jnp.where(expert_mask, biased, -jnp.inf), TOP_K)
    w = jnp.take_along_axis(scores, idx, axis=-1)
    w = w / jnp.sum(w, axis=-1, keepdims=True) * ROUTED_SCALE
    return idx, w


def routed_experts(h, idx, w, gate_up, down):
    t, d = h.shape
    e_count = gate_up.shape[0]
    n_assign = idx.size
    n_blk = (n_assign + e_count * (EXPERT_BLOCK - 1) + EXPERT_BLOCK - 1) // EXPERT_BLOCK
    n_slot = n_blk * EXPERT_BLOCK
    flat_e = idx.reshape(-1)
    order = jnp.argsort(flat_e)
    sorted_e = flat_e[order]
    counts = jnp.bincount(flat_e, length=e_count)
    padded = (counts + EXPERT_BLOCK - 1) // EXPERT_BLOCK * EXPERT_BLOCK
    pad_end = jnp.cumsum(padded)
    pad_start = pad_end - padded
    start = jnp.cumsum(counts) - counts
    dest = pad_start[sorted_e] + jnp.arange(n_assign) - start[sorted_e]
    slot_tok = jnp.full((n_slot,), t, jnp.int32).at[dest].set((order // TOP_K).astype(jnp.int32))
    slot_w = jnp.zeros((n_slot,), h.dtype).at[dest].set(w.reshape(-1)[order].astype(h.dtype))
    blk_e = jnp.minimum(jnp.searchsorted(pad_end, jnp.arange(n_blk) * EXPERT_BLOCK, side="right"),
                        e_count - 1)
    h_pad = jnp.concatenate([h, jnp.zeros((1, d), h.dtype)], axis=0)

    def expert_block(args):
        tok, wt, e = args
        a, b = jnp.split(h_pad[tok] @ gate_up[e], 2, axis=-1)
        return ((jax.nn.silu(a) * b) @ down[e]) * wt[:, None]

    y_blk = lax.map(expert_block, (slot_tok.reshape(n_blk, EXPERT_BLOCK),
                                   slot_w.reshape(n_blk, EXPERT_BLOCK), blk_e))
    return jax.ops.segment_sum(y_blk.reshape(n_slot, d), slot_tok, num_segments=t + 1)[:t]


def swiglu(h, gate_up, down):
    a, b = jnp.split(h @ gate_up, 2, axis=-1)
    return (jax.nn.silu(a) * b) @ down


def moe_ffn(h, router_w, router_b, exp_gate_up, exp_down, shared_gate_up, shared_down):
    idx, w = route(h, router_w, router_b)
    return routed_experts(h, idx, w, exp_gate_up, exp_down) + swiglu(h, shared_gate_up, shared_down)


def modulation(cond, w, b):
    return jnp.split(jax.nn.silu(cond) @ w + b, 6, axis=-1)


def setup_inputs(seed: int = 0) -> dict:
    key = jax.random.key(seed)
    subkeys = jax.random.split(key, 64)
    counter = [0]

    def nxt():
        counter[0] += 1
        return subkeys[counter[0] - 1]

    def nrm(shape, scale):
        return jax.random.normal(nxt(), shape, jnp.float32) * scale

    def gain(n):
        return 1.0 + 0.02 * jax.random.normal(nxt(), (n,), jnp.float32)

    d = D_MODEL
    inp = {}
    inp["x"] = nrm((BATCH, SEQ, d), 1.0)
    inp["c"] = nrm((BATCH, d), 1.0)
    inp["ctx"] = nrm((BATCH, CTX_LEN, d), 1.0)
    inp["c_ctx"] = nrm((d,), 1.0)
    inp["hg_lb_logits"] = nrm((DEPTH + 1, HG_K_WIDTH), 0.1)
    for l in range(DEPTH):
        pre = "l%d_" % l
        inp[pre + "mod_w"] = nrm((d, 6 * d), 0.5 * d ** -0.5)
        inp[pre + "mod_b"] = nrm((6 * d,), 0.02)
        inp[pre + "norm1"] = gain(d)
        inp[pre + "norm2"] = gain(d)
        if l % 2 == 0:
            inp[pre + "w_in"] = nrm((d, IN0_WIDTH), d ** -0.5)
            inp[pre + "dn_conv"] = nrm((3 * DN_WIDTH, DN_CONV), DN_CONV ** -0.5)
            inp[pre + "dn_a_log"] = jnp.log(jax.random.uniform(nxt(), (2, DN_HEADS), jnp.float32, 1.0, 16.0))
            dt = jnp.exp(jax.random.uniform(nxt(), (2, DN_HEADS), jnp.float32,
                                            math.log(1e-3), math.log(1e-1)))
            inp[pre + "dn_dt_bias"] = dt + jnp.log(-jnp.expm1(-dt))
            inp[pre + "dn_norm"] = gain(DN_HEAD_DIM)
            inp[pre + "hg_norm"] = gain(HG_VAL_DIM)
        else:
            inp[pre + "w_in"] = nrm((d, 3 * d), d ** -0.5)
            inp[pre + "q_norm"] = gain(DA_HEAD_DIM)
            inp[pre + "k_norm"] = gain(DA_HEAD_DIM)
            inp[pre + "lambda"] = nrm((4, DA_HEAD_DIM), 0.1)
            inp[pre + "sub_norm"] = gain(2 * DA_HEAD_DIM)
        inp[pre + "w_out"] = nrm((d, d), d ** -0.5)
        inp[pre + "router_w"] = nrm((d, N_EXPERTS), d ** -0.5)
        inp[pre + "router_b"] = nrm((N_EXPERTS,), 0.01)
        inp[pre + "exp_gate_up"] = nrm((N_EXPERTS, d, 2 * EXPERT_FF), d ** -0.5)
        inp[pre + "exp_down"] = nrm((N_EXPERTS, EXPERT_FF, d), EXPERT_FF ** -0.5)
        inp[pre + "shared_gate_up"] = nrm((d, 2 * SHARED_FF), d ** -0.5)
        inp[pre + "shared_down"] = nrm((SHARED_FF, d), SHARED_FF ** -0.5)
    return inp


def reference(x, c, ctx, c_ctx, hg_lb_logits,
              l0_mod_w, l0_mod_b, l0_norm1, l0_norm2, l0_w_in, l0_dn_conv, l0_dn_a_log,
              l0_dn_dt_bias, l0_dn_norm, l0_hg_norm, l0_w_out, l0_router_w, l0_router_b,
              l0_exp_gate_up, l0_exp_down, l0_shared_gate_up, l0_shared_down,
              l1_mod_w, l1_mod_b, l1_norm1, l1_norm2, l1_w_in, l1_q_norm, l1_k_norm, l1_lambda,
              l1_sub_norm, l1_w_out, l1_router_w, l1_router_b, l1_exp_gate_up, l1_exp_down,
              l1_shared_gate_up, l1_shared_down):
    layers = [
        dict(mod_w=l0_mod_w, mod_b=l0_mod_b, norm1=l0_norm1, norm2=l0_norm2,
             mixer=(l0_w_in, l0_dn_conv, l0_dn_a_log, l0_dn_dt_bias, l0_dn_norm,
                    hg_lb_logits, l0_hg_norm, l0_w_out),
             moe=(l0_router_w, l0_router_b, l0_exp_gate_up, l0_exp_down,
                  l0_shared_gate_up, l0_shared_down)),
        dict(mod_w=l1_mod_w, mod_b=l1_mod_b, norm1=l1_norm1, norm2=l1_norm2,
             mixer=(l1_w_in, l1_q_norm, l1_k_norm, l1_lambda, l1_sub_norm, l1_w_out),
             moe=(l1_router_w, l1_router_b, l1_exp_gate_up, l1_exp_down,
                  l1_shared_gate_up, l1_shared_down)),
    ]
    d = x.shape[-1]
    xl, xc = x, ctx
    for l in range(DEPTH):
        p = layers[l]
        last = l == DEPTH - 1
        ml = [m[:, None, :] for m in modulation(c, p["mod_w"], p["mod_b"])]
        mc = modulation(c_ctx, p["mod_w"], p["mod_b"])
        hl = rms_norm(xl, p["norm1"]) * (1.0 + ml[1]) + ml[0]
        hc = rms_norm(xc, p["norm1"]) * (1.0 + mc[1]) + mc[0]
        if l % 2 == 0:
            yl, yc = mixer_delta_hgrn(hl, hc, l, not last, *p["mixer"])
        else:
            yl, yc = mixer_diff_attn(hl, hc, l, not last, *p["mixer"])
        xl = xl + ml[2] * yl
        hl = rms_norm(xl, p["norm2"]) * (1.0 + ml[4]) + ml[3]
        if last:
            y = moe_ffn(hl.reshape(-1, d), *p["moe"]).reshape(hl.shape)
            xl = xl + ml[5] * y
        else:
            xc = xc + mc[2] * yc
            hc = rms_norm(xc, p["norm2"]) * (1.0 + mc[4]) + mc[3]
            n_lat = hl.shape[0] * hl.shape[1]
            y = moe_ffn(jnp.concatenate([hl.reshape(-1, d), hc.reshape(-1, d)], axis=0), *p["moe"])
            xl = xl + ml[5] * y[:n_lat].reshape(hl.shape)
            xc = xc + mc[5] * y[n_lat:].reshape(hc.shape)
    return xl
```

```cpp
#include <hip/hip_bf16.h>
#include <hip/hip_runtime.h>
#include <cstdio>
#include <cstdint>
namespace pg8 {
#define PG8_LAS __attribute__((address_space(3)))
typedef unsigned short bf16_t;
typedef short bf16x8 __attribute__((ext_vector_type(8)));
typedef float f32x4 __attribute__((ext_vector_type(4)));
typedef unsigned u32x4 __attribute__((ext_vector_type(4)));
constexpr int BM = 256, BK = 64, HALF = 128, HTB = HALF * BK * 2  , STAGE_BYTES = 8 * HTB, NXCD = 8, WGM = 8;

__host__ __device__ __forceinline__ int lds_byte(int r, int c) { const int st = (r >> 4) * 2 + (c >> 5), rr = r & 15, cc = c & 31, ob = rr * 64 + cc * 2; return st * 1024 + (ob ^ (((ob >> 9) & 1) << 5)); }
__host__ __device__ __forceinline__ void stage_rc(int b, int& R, int& C) { const int st = b / 1024, sb = b % 1024, swz = sb ^ (((sb >> 9) & 1) << 5); R = (st >> 1) * 16 + swz / 64; C = (st & 1) * 32 + (swz % 64) / 2; }
__host__ __device__ __forceinline__ int perm32(int rho) { const int n = rho >> 4, i = rho & 15; return 8 * (i >> 2) + 4 * n + (i & 3); }

struct Unit { int pm, pn; };
struct Gemm { const bf16_t* A; const bf16_t* Bt; int M, N, K; };

struct StaticOrder {
    int nM, nN, nwg, G, c;
    __host__ __device__ void init(int M, int N, int G_, int c_) { nM = M / BM; nN = N / BM; nwg = nM * nN; G = G_; c = c_; }
    __host__ __device__ bool next(int i, Unit& u) const {
        const long L = (long)i * G + c; if (L >= nwg) return false;
        int wgid = (int)L; { const int q = nwg / NXCD, r = nwg % NXCD, xcd = wgid % NXCD, off = wgid / NXCD; wgid = (xcd < r ? xcd * (q + 1) : r * (q + 1) + (xcd - r) * q) + off; }
        const int nig = WGM * nN, gid = wgid / nig, fm = gid * WGM, gsz = (nM - fm) < WGM ? (nM - fm) : WGM;
        u.pm = fm + ((wgid % nig) % gsz); u.pn = (wgid % nig) / gsz; return true;
    }
    __device__ __forceinline__ void a_ready(const Unit&) const {}
    __device__ __forceinline__ void done(const Unit&) const {}
};

__device__ __forceinline__ unsigned cvt_pk_bf16(float lo, float hi) { unsigned r; asm volatile("v_cvt_pk_bf16_f32 %0, %1, %2" : "=v"(r) : "v"(lo), "v"(hi)); return r; }
typedef float f32x2 __attribute__((ext_vector_type(2)));
__device__ __forceinline__ f32x2 gelu_pk(f32x2 v) {
    const f32x2 av = __builtin_elementwise_abs(v), d = av * 0.2316418882f + 1.0f;
    f32x2 t; t.x = __builtin_amdgcn_rcpf(d.x); t.y = __builtin_amdgcn_rcpf(d.y);
    f32x2 q = t * 0.5307027145f + (-0.7265760135f); q = q * t + 0.7107068705f; q = q * t + (-0.142248368f); q = q * t + 0.127414796f; q = q * t;
    const f32x2 s = (v * v) * (-0.72134752044f);
    f32x2 e; e.x = __builtin_amdgcn_exp2f(s.x); e.y = __builtin_amdgcn_exp2f(s.y);
    const f32x2 m = v * (q * e), r = v - m;
    f32x2 o; o.x = v.x < 0.f ? m.x : r.x; o.y = v.y < 0.f ? m.y : r.y; return o;
}

template <int ACT  > struct EpiBf16 {
    static constexpr bool PERM = true, AFTER_DRAIN = false; static_assert(ACT == 0 || ACT == 1, "EpiBf16: ACT is 0 (none) or 1 (gelu_pk)");
    bf16_t* O; int ldc; const float* bias; int split_cols; size_t split_stride; float scale0;
    __device__ __forceinline__ void operator()(const f32x4 (&acc)[2][2][4][2], const Unit& u, int wr, int wc, int fr, int fq) const {
        const int row0 = u.pm * BM + wr * 64 + fr; int colt = u.pn * BM; bf16_t* base = O;
        float sc = 1.f; if (split_cols) { const int t = colt / split_cols; base += (size_t)t * split_stride; colt -= t * split_cols; if (t == 0) sc = scale0; }
        const int col0 = colt + wc * 32 + 8 * fq, bcol0 = u.pn * BM + wc * 32 + 8 * fq;
        f32x4 bv[2][2];
#pragma unroll
        for (int bj = 0; bj < 2; ++bj)
#pragma unroll
            for (int n = 0; n < 2; ++n) bv[bj][n] = bias ? *(const f32x4*)(bias + bcol0 + bj * HALF + 4 * n) : (f32x4){0.f, 0.f, 0.f, 0.f};
#pragma unroll
        for (int ai = 0; ai < 2; ++ai)
#pragma unroll
            for (int m = 0; m < 4; ++m) { bf16_t* rowp = base + (size_t)(row0 + ai * HALF + m * 16) * ldc + col0;
#pragma unroll
                for (int bj = 0; bj < 2; ++bj) { f32x4 v0 = acc[ai][bj][m][0] + bv[bj][0], v1 = acc[ai][bj][m][1] + bv[bj][1];
                    if (ACT == 1) { f32x2 a = gelu_pk((f32x2){v0[0], v0[1]}), b = gelu_pk((f32x2){v0[2], v0[3]}), c = gelu_pk((f32x2){v1[0], v1[1]}), d = gelu_pk((f32x2){v1[2], v1[3]});
                        v0 = (f32x4){a.x, a.y, b.x, b.y}; v1 = (f32x4){c.x, c.y, d.x, d.y}; }
                    v0 = v0 * sc; v1 = v1 * sc; u32x4 w; w.x = cvt_pk_bf16(v0[0], v0[1]); w.y = cvt_pk_bf16(v0[2], v0[3]); w.z = cvt_pk_bf16(v1[0], v1[1]); w.w = cvt_pk_bf16(v1[2], v1[3]);
                    *(u32x4*)(rowp + bj * HALF) = w; } }
    }
};

template <class Epi, class Sched, bool ALIGN_EPI = false, bool SP2 = false>
__device__ __forceinline__ void gemm_phase(PG8_LAS unsigned char* lds, const Gemm g, const Sched& S, const Epi& E) {
    int tid_l = threadIdx.x; asm volatile("" : "+v"(tid_l));
    const int tid = tid_l, wid = __builtin_amdgcn_readfirstlane(tid >> 6), lane = tid & 63, wr = wid >> 2, wc = wid & 3, fr = lane & 15, fq = lane >> 4;
    const int K = g.K, nt = K / BK;
    unsigned voffA[2], voffB[2];
#pragma unroll
    for (int i = 0; i < 2; ++i) { int R, C; stage_rc(tid * 16 + i * 8192, R, C); const int Rb = Epi::PERM ? ((R & ~31) + perm32(R & 31)) : R;
        voffA[i] = (unsigned)(R * K + C) * 2u; voffB[i] = (unsigned)(Rb * K + C) * 2u; }
    const size_t kstep = (size_t)(BK * 2);
    const size_t hstep = (size_t)HALF * K * 2;
    const size_t tstep = 2 * hstep;
    const unsigned ldsw = (unsigned)wid * 1024u;
    const int aoff = lds_byte(wr * 64 + fr, fq * 8), boff = lds_byte(wc * 32 + fr, fq * 8);
#define PG8_SA(b, h) (((b) * 2 + (h)) * HTB)
#define PG8_SB(b, h) ((4 + (b) * 2 + (h)) * HTB)
#define PG8_STAGE(bufoff, gbase, voff) do { _Pragma("unroll") for (int _i = 0; _i < 2; ++_i) \
        __builtin_amdgcn_global_load_lds((const unsigned*)((const char*)(gbase) + (voff)[_i]), (PG8_LAS unsigned*)(lds + (bufoff) + ldsw + _i * 8192), 16, 0, 0); } while (0)
#define PG8_LDA(dst, b, h) do { _Pragma("unroll") for (int m = 0; m < 4; ++m) _Pragma("unroll") for (int k = 0; k < 2; ++k) dst[m][k] = *(const PG8_LAS bf16x8*)(lds + PG8_SA(b, h) + aoff + m * 2048 + k * 1024); } while (0)
#define PG8_LDB(dst, b, h) do { _Pragma("unroll") for (int n = 0; n < 2; ++n) _Pragma("unroll") for (int k = 0; k < 2; ++k) dst[n][k] = *(const PG8_LAS bf16x8*)(lds + PG8_SB(b, h) + boff + n * 2048 + k * 1024); } while (0)
#define PG8_MMA(ai, bj, At, Bt) do { __builtin_amdgcn_s_setprio(1); _Pragma("unroll") for (int m = 0; m < 4; ++m) _Pragma("unroll") for (int n = 0; n < 2; ++n) _Pragma("unroll") for (int k = 0; k < 2; ++k) \
        acc[ai][bj][m][n] = __builtin_amdgcn_mfma_f32_16x16x32_bf16(Bt[n][k], At[m][k], acc[ai][bj][m][n], 0, 0, 0); __builtin_amdgcn_s_setprio(0); } while (0)
#define PG8_WAIT_V(n) asm volatile("s_waitcnt vmcnt(" #n ")" ::: "memory")
#define PG8_WAIT_L(n) asm volatile("s_waitcnt lgkmcnt(" #n ")" ::: "memory")
#define PG8_BAR __builtin_amdgcn_s_barrier()
#define PG8_SCHED __builtin_amdgcn_sched_barrier(0)
    Unit cur, nxt; int ui = 0;
    if (!S.next(0, cur)) return;
    f32x4 acc[2][2][4][2];
#pragma unroll
    for (int a = 0; a < 2; ++a)
#pragma unroll
        for (int b = 0; b < 2; ++b)
#pragma unroll
            for (int m = 0; m < 4; ++m)
#pragma unroll
                for (int n = 0; n < 2; ++n) acc[a][b][m][n] = (f32x4){0.f, 0.f, 0.f, 0.f};
    bf16x8 At[4][2], B0[2][2], B1[2][2];
    const char* cA = (const char*)g.A + (size_t)cur.pm * tstep; const char* cB = (const char*)g.Bt + (size_t)cur.pn * tstep;
    S.a_ready(cur);
    if constexpr (SP2) {
        PG8_STAGE(PG8_SB(0, 0), cB, voffB); PG8_STAGE(PG8_SB(0, 1), cB + hstep, voffB); PG8_STAGE(PG8_SA(0, 0), cA, voffA); PG8_STAGE(PG8_SA(0, 1), cA + hstep, voffA);
        if (wr == 1) PG8_BAR;
        PG8_WAIT_V(2); PG8_BAR;
        PG8_STAGE(PG8_SB(1, 0), cB + kstep, voffB); PG8_STAGE(PG8_SA(1, 0), cA + kstep, voffA); PG8_STAGE(PG8_SB(1, 1), cB + hstep + kstep, voffB);
        PG8_WAIT_V(6); PG8_BAR;
    } else {
        PG8_STAGE(PG8_SB(0, 0), cB, voffB); PG8_STAGE(PG8_SA(0, 0), cA, voffA); PG8_STAGE(PG8_SB(0, 1), cB + hstep, voffB); PG8_STAGE(PG8_SA(0, 1), cA + hstep, voffA);
        if (wr == 1) PG8_BAR;
        PG8_WAIT_V(4); PG8_BAR;
        PG8_STAGE(PG8_SB(1, 0), cB + kstep, voffB); PG8_STAGE(PG8_SA(1, 0), cA + kstep, voffA); PG8_STAGE(PG8_SB(1, 1), cB + hstep + kstep, voffB);
        PG8_WAIT_V(6); PG8_BAR;
    }
    for (;;) {
        const bool has_next = S.next(ui + 1, nxt);
        const char* nA = has_next ? (const char*)g.A + (size_t)nxt.pm * tstep : cA; const char* nB = has_next ? (const char*)g.Bt + (size_t)nxt.pn * tstep : cB;
        for (int t = 0; t < nt; t += 2) {
            const bool last = (t == nt - 2);
            const char* a1 = cA + (size_t)(t + 1) * kstep;
            const char* a2 = last ? nA : cA + (size_t)(t + 2) * kstep; const char* b2 = last ? nB : cB + (size_t)(t + 2) * kstep;
            const char* a3 = a2 + kstep; const char* b3 = b2 + kstep;
            if (last && has_next) S.a_ready(nxt);
            if constexpr (SP2) {
            PG8_LDB(B0, 0, 0); PG8_LDB(B1, 0, 1); PG8_SCHED; PG8_LDA(At, 0, 0); PG8_STAGE(PG8_SA(1, 1), a1 + hstep, voffA);
            PG8_WAIT_V(8); PG8_WAIT_L(0); PG8_BAR; PG8_MMA(0, 0, At, B0); PG8_MMA(0, 1, At, B1); PG8_BAR; PG8_SCHED;
            PG8_LDA(At, 0, 1); PG8_STAGE(PG8_SB(0, 0), b2, voffB); PG8_STAGE(PG8_SB(0, 1), b2 + hstep, voffB); PG8_STAGE(PG8_SA(0, 0), a2, voffA);
            PG8_WAIT_V(8); PG8_WAIT_L(0); PG8_BAR; PG8_MMA(1, 0, At, B0); PG8_MMA(1, 1, At, B1); PG8_BAR; PG8_SCHED;
            PG8_LDB(B0, 1, 0); PG8_LDB(B1, 1, 1); PG8_SCHED; PG8_LDA(At, 1, 0); PG8_STAGE(PG8_SA(0, 1), a2 + hstep, voffA);
            PG8_WAIT_V(8); PG8_WAIT_L(0); PG8_BAR; PG8_MMA(0, 0, At, B0); PG8_MMA(0, 1, At, B1); PG8_BAR; PG8_SCHED;
            PG8_LDA(At, 1, 1); PG8_STAGE(PG8_SB(1, 0), b3, voffB); PG8_STAGE(PG8_SB(1, 1), b3 + hstep, voffB); PG8_STAGE(PG8_SA(1, 0), a3, voffA);
            PG8_WAIT_V(8); PG8_WAIT_L(0); PG8_BAR; PG8_MMA(1, 0, At, B0); PG8_MMA(1, 1, At, B1); PG8_BAR; PG8_SCHED;
            } else {
            PG8_LDB(B0, 0, 0); PG8_SCHED; PG8_LDA(At, 0, 0); PG8_STAGE(PG8_SA(1, 1), a1 + hstep, voffA);
            PG8_WAIT_L(8); PG8_BAR; PG8_WAIT_L(0); PG8_MMA(0, 0, At, B0); PG8_BAR; PG8_SCHED;
            PG8_LDB(B1, 0, 1); PG8_STAGE(PG8_SB(0, 0), b2, voffB);
            PG8_BAR; PG8_WAIT_L(0); PG8_MMA(0, 1, At, B1); PG8_BAR;
            PG8_LDA(At, 0, 1); PG8_STAGE(PG8_SA(0, 0), a2, voffA);
            PG8_BAR; PG8_WAIT_L(0); PG8_MMA(1, 0, At, B0); PG8_BAR; PG8_SCHED;
            PG8_STAGE(PG8_SB(0, 1), b2 + hstep, voffB);
            PG8_WAIT_V(6); PG8_BAR; PG8_MMA(1, 1, At, B1); PG8_BAR;
            PG8_LDB(B0, 1, 0); PG8_SCHED; PG8_LDA(At, 1, 0); PG8_STAGE(PG8_SA(0, 1), a2 + hstep, voffA);
            PG8_WAIT_L(8); PG8_BAR; PG8_WAIT_L(0); PG8_MMA(0, 0, At, B0); PG8_BAR; PG8_SCHED;
            PG8_LDB(B1, 1, 1); PG8_STAGE(PG8_SB(1, 0), b3, voffB);
            PG8_BAR; PG8_WAIT_L(0); PG8_MMA(0, 1, At, B1); PG8_BAR;
            PG8_LDA(At, 1, 1); PG8_STAGE(PG8_SA(1, 0), a3, voffA);
            PG8_BAR; PG8_WAIT_L(0); PG8_MMA(1, 0, At, B0); PG8_BAR; PG8_SCHED;
            PG8_STAGE(PG8_SB(1, 1), b3 + hstep, voffB);
            PG8_WAIT_V(6); PG8_BAR; PG8_MMA(1, 1, At, B1); PG8_BAR;
            }
        }
        if constexpr (ALIGN_EPI) { if (wr == 0) PG8_BAR; }
        if constexpr (!Epi::AFTER_DRAIN) { E(acc, cur, wr, wc, fr, fq); S.done(cur); }
        if (!has_next) break;
#pragma unroll
        for (int a = 0; a < 2; ++a)
#pragma unroll
            for (int b = 0; b < 2; ++b)
#pragma unroll
                for (int m = 0; m < 4; ++m)
#pragma unroll
                    for (int n = 0; n < 2; ++n) acc[a][b][m][n] = (f32x4){0.f, 0.f, 0.f, 0.f};
        cur = nxt; cA = nA; cB = nB; ++ui;
        if constexpr (ALIGN_EPI) { if (wr == 1) PG8_BAR; }
    }
    PG8_WAIT_V(0);
    if constexpr (!ALIGN_EPI) { if (wr == 0) PG8_BAR; }
    PG8_BAR;
    if constexpr (Epi::AFTER_DRAIN) { E.fused(acc, cur, wr, wc, fr, fq, lds, wid, lane); S.done(cur); }
#undef PG8_SA
#undef PG8_SB
#undef PG8_STAGE
#undef PG8_LDA
#undef PG8_LDB
#undef PG8_MMA
#undef PG8_WAIT_V
#undef PG8_WAIT_L
#undef PG8_BAR
#undef PG8_SCHED
}
}
#define GAS __attribute__((address_space(1)))
#define LAS __attribute__((address_space(3)))
typedef unsigned short bf16;
typedef unsigned v4u __attribute__((ext_vector_type(4)));
typedef float f32x4 __attribute__((ext_vector_type(4)));
typedef short bf16x8 __attribute__((ext_vector_type(8)));
typedef GAS unsigned gu32;
typedef GAS unsigned long long gu64;
#define RLX_AGENT __ATOMIC_RELAXED, __HIP_MEMORY_SCOPE_AGENT
#define LDS_WAIT() asm volatile("s_waitcnt lgkmcnt(0)" ::: "memory")
#define VM_WAIT() asm volatile("s_waitcnt vmcnt(0)" ::: "memory")
__device__ __forceinline__ unsigned long long rt() { return __builtin_amdgcn_s_memrealtime(); }
__device__ __forceinline__ unsigned f2bf(float f) { unsigned u = __builtin_bit_cast(unsigned, f); return (u + 0x7fffu + ((u >> 16) & 1u)) >> 16; }
__device__ __forceinline__ unsigned pk2(float lo, float hi) { return f2bf(lo) | (f2bf(hi) << 16); }

#define XB_TMO      128
#define XB_XCNT(j)  (256  + 64 * (j))
#define XB_XSUB(j)  (1280 + 64 * (j))
#define XB_XGEN(j)  (2304 + 64 * (j))
#define XB_TOP      3328
#define XB_TOPGEN   3392
#define XCD_BAR_WORDS 3456
#define XB_SPIN_CAP (1u << 18)

__device__ __forceinline__ unsigned xb_ld(unsigned* p)              { return __hip_atomic_load(p, __ATOMIC_RELAXED, __HIP_MEMORY_SCOPE_AGENT); }
__device__ __forceinline__ unsigned xb_add(unsigned* p, unsigned v) { return __hip_atomic_fetch_add(p, v, __ATOMIC_RELAXED, __HIP_MEMORY_SCOPE_AGENT); }
__device__ __forceinline__ unsigned xb_xcc_id() { return (unsigned)__builtin_amdgcn_s_getreg((3 << 11) | 20) & 0xFu; }
#define XB_SPIN(cond, bar) do { unsigned _sp = 0; while (cond) { __builtin_amdgcn_s_sleep(1); \
    if ((++_sp & 255u) == 0u) { if (xb_ld(&(bar)[XB_TMO])) break; if (_sp > XB_SPIN_CAP) { atomicAdd(&(bar)[XB_TMO], 1u); break; } } } } while (0)

struct XcdBarrier {
    unsigned* bar; unsigned x;
    volatile LAS unsigned* st;
};

__device__ __forceinline__ XcdBarrier xcd_barrier_post(unsigned* bar, volatile LAS unsigned* st) {
    XcdBarrier b; b.bar = bar; b.x = xb_xcc_id(); b.st = st;
    if (threadIdx.x == 0) (void)xb_add(&bar[XB_XCNT(b.x)], 1u);
    return b;
}
__device__ __forceinline__ void xcd_barrier_complete(unsigned* bar, unsigned x, unsigned& nloc, unsigned& nx) {
    const unsigned G = gridDim.x * gridDim.y * gridDim.z;
    unsigned sum, cnt, mine, sp = 0u;
    for (;;) {
        sum = 0u; cnt = 0u; mine = 0u;
#pragma unroll
        for (unsigned j = 0; j < 16; ++j) { const unsigned c = xb_ld(&bar[XB_XCNT(j)]); sum += c; cnt += (c > 0u) ? 1u : 0u; mine = (j == x) ? c : mine; }
        if (sum == G) break;
        __builtin_amdgcn_s_sleep(1);
        if ((++sp & 255u) == 0u) { if (xb_ld(&bar[XB_TMO])) break; if (sp > XB_SPIN_CAP) { atomicAdd(&bar[XB_TMO], 1u); break; } }
    }
    nloc = mine > 0u ? mine : 1u; nx = cnt > 0u ? cnt : 1u;
}

__device__ __forceinline__ void xcd_barrier(const XcdBarrier& b) {
    asm volatile("s_waitcnt vmcnt(0)" ::: "memory");
    __syncthreads();
    if (threadIdx.x == 0) {
        unsigned* bar = b.bar;
        __builtin_amdgcn_s_waitcnt(0);
        unsigned nloc = b.st[0], nx = b.st[1];
        if (nloc == 0u) { xcd_barrier_complete(bar, b.x, nloc, nx); b.st[0] = nloc; b.st[1] = nx; }
        const unsigned old = xb_add(&bar[XB_XSUB(b.x)], 1u);
        const unsigned gen = old / nloc;
        if (old + 1u == (gen + 1u) * nloc) {
            __builtin_amdgcn_fence(__ATOMIC_RELEASE, "agent");
            asm volatile("s_waitcnt vmcnt(0)" ::: "memory");
            const unsigned og = xb_add(&bar[XB_TOP], 1u);
            const unsigned tg = og / nx;
            if (og + 1u == (tg + 1u) * nx) xb_add(&bar[XB_TOPGEN], 1u);
            else XB_SPIN(xb_ld(&bar[XB_TOPGEN]) == tg, bar);
            __builtin_amdgcn_fence(__ATOMIC_ACQUIRE, "agent");
            xb_add(&bar[XB_XGEN(b.x)], 1u);
            asm volatile("s_waitcnt vmcnt(0)" ::: "memory");
        } else {
            XB_SPIN(xb_ld(&bar[XB_XGEN(b.x)]) == gen, bar);
            __builtin_amdgcn_fence(__ATOMIC_ACQUIRE, "agent");
            asm volatile("s_waitcnt vmcnt(0)" ::: "memory");
        }
    }
    __syncthreads();
}
namespace att {
using bf16 = __hip_bfloat16;
constexpr int   D = 128, NW = 8, QBLK = 32, KVBLK = 64;
constexpr float SCALE = 0.088388347648318440f;
constexpr float THR = 8.f;
#ifndef ATT_SDEPTH
#define ATT_SDEPTH 1
#endif
constexpr int SDEPTH = ATT_SDEPTH;
constexpr size_t SHM_V = KVBLK * D * 2, SHM_K = KVBLK * D * 2, SHM_ATTN = 2 * SHM_V + 2 * SHM_K + NW * 64 * 4;
using bf16x8 = __attribute__((ext_vector_type(8))) short;
using s16x4  = __attribute__((ext_vector_type(4))) short;
using f32x16 = __attribute__((ext_vector_type(16))) float;
using u32x4  = __attribute__((ext_vector_type(4))) unsigned;
#define KSWZ(row, colB) ((row) * 256 + ((colB) ^ (((row) & 7) << 4)))
#define SBAR() __builtin_amdgcn_sched_barrier(0)
__device__ __forceinline__ int crow(int r, int hi) { return (r & 3) + 8 * (r >> 2) + 4 * hi; }
__device__ __forceinline__ unsigned cvtpk(float lo, float hi) {
  unsigned r; asm volatile("v_cvt_pk_bf16_f32 %0, %1, %2" : "=v"(r) : "v"(lo), "v"(hi)); return r;
}
__device__ __forceinline__ bf16x8 ld8(const bf16* p) { return *reinterpret_cast<const bf16x8*>(p); }
__device__ __forceinline__ void partialSM(f32x16& p0, f32x16& p1, float& m_reg, float& mn, float& alpha) {
  constexpr float C = SCALE * 1.4426950408889634f;
  float pmax = p0[0]; for (int r = 1; r < 16; ++r) pmax = fmaxf(pmax, p0[r]); for (int r = 0; r < 16; ++r) pmax = fmaxf(pmax, p1[r]);
  { auto rr = __builtin_amdgcn_permlane32_swap(__float_as_uint(pmax), __float_as_uint(pmax), false, false);
    pmax = fmaxf(__uint_as_float(rr[0]), __uint_as_float(rr[1])); }
  if (__builtin_expect(__all(pmax - m_reg <= THR / SCALE), 1)) { mn = m_reg; alpha = 1.f; }
  else { mn = fmaxf(m_reg, pmax); alpha = __builtin_amdgcn_exp2f((m_reg - mn) * C); m_reg = mn; }
  float mnC = -mn * C;
  for (int r = 0; r < 16; ++r) p0[r] = fmaf(p0[r], C, mnC); for (int r = 0; r < 16; ++r) p1[r] = fmaf(p1[r], C, mnC);
  for (int r = 0; r < 16; ++r) p0[r] = __builtin_amdgcn_exp2f(p0[r]);
}
__device__ __forceinline__ void finishSM(f32x16& p0, f32x16& p1, float alpha, float& l_reg, bf16x8& pa0, bf16x8& pa1, bf16x8& pa2, bf16x8& pa3) {
  for (int r = 0; r < 16; ++r) p1[r] = __builtin_amdgcn_exp2f(p1[r]);
  float ps = 0; for (int r = 0; r < 16; ++r) ps += p0[r]; for (int r = 0; r < 16; ++r) ps += p1[r];
  { auto rr = __builtin_amdgcn_permlane32_swap(__float_as_uint(ps), __float_as_uint(ps), false, false);
    ps = __uint_as_float(rr[0]) + __uint_as_float(rr[1]); }
  l_reg = l_reg * alpha + ps;
#define PK4(P, BASE, OUT) do { unsigned a0 = cvtpk(P[BASE + 0], P[BASE + 1]), a1 = cvtpk(P[BASE + 2], P[BASE + 3]);   \
    unsigned b0 = cvtpk(P[BASE + 4], P[BASE + 5]), b1 = cvtpk(P[BASE + 6], P[BASE + 7]);                              \
    auto r0 = __builtin_amdgcn_permlane32_swap(a0, b0, false, false); auto r1 = __builtin_amdgcn_permlane32_swap(a1, b1, false, false); \
    u32x4 w = {r0[0], r1[0], r0[1], r1[1]}; OUT = *reinterpret_cast<bf16x8*>(&w); } while (0)
  PK4(p0, 0, pa0); PK4(p0, 8, pa1); PK4(p1, 0, pa2); PK4(p1, 8, pa3);
#undef PK4
}
__device__ __forceinline__ void qkt(f32x16& p0, f32x16& p1, const bf16* Ks, const bf16x8* qr, int r32, int hi) {
  p0 = f32x16{}; p1 = f32x16{};
  for (int d0 = 0; d0 < 8; ++d0) { int cb = (d0 * 16 + hi * 8) * 2;
    bf16x8 b0 = *reinterpret_cast<const bf16x8*>((const char*)Ks + KSWZ(r32, cb));
    bf16x8 b1 = *reinterpret_cast<const bf16x8*>((const char*)Ks + KSWZ(32 + r32, cb));
    p0 = __builtin_amdgcn_mfma_f32_32x32x16_bf16(b0, qr[d0], p0, 0, 0, 0);
    p1 = __builtin_amdgcn_mfma_f32_32x32x16_bf16(b1, qr[d0], p1, 0, 0, 0); }
}
__device__ __forceinline__ int v_st(int k, int c) { const int kk = (k & ~0xC) | ((k & 4) << 1) | ((k & 8) >> 1); return ((kk >> 3) * 4 + (c >> 5)) * 512 + ((kk & 7) * 32 + (c & 31)) * 2; }
__device__ __forceinline__ int v_rd_base(int lane) { return ((lane & 3) << 3) | (((lane >> 2) & 3) << 6) | (((lane >> 4) & 1) << 5) | (((lane >> 5) & 1) << 8); }
constexpr int v_rd_off(int d0, int ks, int half) { return d0 * 512 + ks * 4096 + half * 2048; }
template <int OFF> __device__ __forceinline__ s16x4 tr_read(int vb) {
  s16x4 r; asm volatile("ds_read_b64_tr_b16 %0, %1 offset:%2" : "=&v"(r) : "v"(vb), "i"(OFF) : "memory"); return r;
}
template <int D0> __device__ __forceinline__ void pv_one(f32x16& od, int vb, bf16x8 pa0, bf16x8 pa1, bf16x8 pa2, bf16x8 pa3) {
  const s16x4 l0 = tr_read<v_rd_off(D0, 0, 0)>(vb), h0 = tr_read<v_rd_off(D0, 0, 1)>(vb), l1 = tr_read<v_rd_off(D0, 1, 0)>(vb), h1 = tr_read<v_rd_off(D0, 1, 1)>(vb);
  const s16x4 l2 = tr_read<v_rd_off(D0, 2, 0)>(vb), h2 = tr_read<v_rd_off(D0, 2, 1)>(vb), l3 = tr_read<v_rd_off(D0, 3, 0)>(vb), h3 = tr_read<v_rd_off(D0, 3, 1)>(vb);
  asm volatile("s_waitcnt lgkmcnt(0)" ::: "memory"); SBAR();
#define PK(L, H) (bf16x8){L[0], L[1], L[2], L[3], H[0], H[1], H[2], H[3]}
  od = __builtin_amdgcn_mfma_f32_32x32x16_bf16(pa0, PK(l0, h0), od, 0, 0, 0);
  od = __builtin_amdgcn_mfma_f32_32x32x16_bf16(pa1, PK(l1, h1), od, 0, 0, 0);
  od = __builtin_amdgcn_mfma_f32_32x32x16_bf16(pa2, PK(l2, h2), od, 0, 0, 0);
  od = __builtin_amdgcn_mfma_f32_32x32x16_bf16(pa3, PK(l3, h3), od, 0, 0, 0);
#undef PK
}
__device__ __forceinline__ void pv_d0(f32x16* o, int vb, bf16x8 pa0, bf16x8 pa1, bf16x8 pa2, bf16x8 pa3) {
  pv_one<0>(o[0], vb, pa0, pa1, pa2, pa3); pv_one<1>(o[1], vb, pa0, pa1, pa2, pa3); pv_one<2>(o[2], vb, pa0, pa1, pa2, pa3); pv_one<3>(o[3], vb, pa0, pa1, pa2, pa3);
}
template <int LDQ, int LDKK, int LDV, int LDO>
__device__ __forceinline__ void attn_dense_body(const bf16* __restrict__ Qb, const bf16* __restrict__ Kh, const bf16* __restrict__ Vh,
                                                float* __restrict__ Ob, int seq, char* lds) {
  const int tid = threadIdx.x, wid = tid >> 6, lane = tid & 63, r32 = lane & 31, hi = lane >> 5;
  bf16* V_lds = (bf16*)lds; bf16* K_lds = (bf16*)(lds + 2 * SHM_V);
  float* ws = (float*)(lds + 2 * SHM_V + 2 * SHM_K) + wid * 64; float* li_l = ws; float* al_l = ws + 32;
  float m_reg = -1e30f, l_reg = 0; f32x16 o[4] = {}; bf16x8 qr[8];
  const bf16* Qw = Qb + (long)(wid * QBLK + r32) * LDQ + hi * 8;
#pragma unroll
  for (int d0 = 0; d0 < 8; ++d0) qr[d0] = ld8(Qw + d0 * 16);
  const int sr = tid >> 4, sc = (tid & 15) * 8, vst0 = v_st(sr, sc), vst1 = v_st(32 + sr, sc);
  const int vb0 = (int)(uintptr_t)V_lds + v_rd_base(lane);
  struct { bf16x8 vs0, vs1, ks0, ks1; } sr_[SDEPTH];
#define SLOAD(i, k0) do { sr_[i].vs0 = ld8(&Vh[(long)((k0) + sr) * LDV + sc]); sr_[i].vs1 = ld8(&Vh[(long)((k0) + 32 + sr) * LDV + sc]); \
    sr_[i].ks0 = ld8(&Kh[(long)((k0) + sr) * LDKK + sc]); sr_[i].ks1 = ld8(&Kh[(long)((k0) + 32 + sr) * LDKK + sc]); } while (0)
#define SWRITE(b, i) do { *(bf16x8*)((char*)V_lds + (b) * SHM_V + vst0) = sr_[i].vs0;          \
    *(bf16x8*)((char*)V_lds + (b) * SHM_V + vst1) = sr_[i].vs1; int kc = sc * 2;               \
    *(bf16x8*)((char*)K_lds + (b) * SHM_K + KSWZ(sr, kc)) = sr_[i].ks0;                       \
    *(bf16x8*)((char*)K_lds + (b) * SHM_K + KSWZ(32 + sr, kc)) = sr_[i].ks1; } while (0)
#define SWAIT() do { if constexpr (SDEPTH == 2) asm volatile("s_waitcnt vmcnt(4)" ::: "memory"); else asm volatile("s_waitcnt vmcnt(0)" ::: "memory"); } while (0)
#define RESC(a) do { if (__any((a) < 1.f)) { if (hi == 0) al_l[r32] = (a); asm volatile("s_waitcnt lgkmcnt(0)" ::: "memory"); \
    for (int d = 0; d < 4; ++d) for (int r = 0; r < 16; ++r) o[d][r] *= al_l[crow(r, hi)]; } } while (0)
  f32x16 pA0, pA1, pB0, pB1; float mnA, mnB, alA, alB; bf16x8 pa0, pa1, pa2, pa3; const int NT = seq / KVBLK;
  constexpr int SE = 0, SO = SDEPTH - 1;
  SLOAD(SE, 0); asm volatile("s_waitcnt vmcnt(0)" ::: "memory"); SWRITE(0, SE); __syncthreads();
  qkt(pA0, pA1, K_lds, qr, r32, hi); partialSM(pA0, pA1, m_reg, mnA, alA);
  SLOAD(SO, KVBLK); if constexpr (SDEPTH == 2) { if (2 < NT) SLOAD(SE, 2 * KVBLK); }
  SWAIT(); SWRITE(1, SO); __syncthreads();
  for (int j = 1; j + 1 < NT; j += 2) {
    SBAR(); qkt(pB0, pB1, (bf16*)((char*)K_lds + SHM_K), qr, r32, hi);
    finishSM(pA0, pA1, alA, l_reg, pa0, pa1, pa2, pa3); SBAR();
    SLOAD(SO, (j + SDEPTH) * KVBLK); SBAR();
    pv_d0(o, vb0, pa0, pa1, pa2, pa3); partialSM(pB0, pB1, m_reg, mnB, alB);
    __syncthreads(); SWAIT(); SWRITE(0, SE);
    RESC(alB); __syncthreads();
    SBAR(); qkt(pA0, pA1, K_lds, qr, r32, hi);
    finishSM(pB0, pB1, alB, l_reg, pa0, pa1, pa2, pa3); SBAR();
    if (SDEPTH == 1 || j + 3 < NT) SLOAD(SE, (j + 1 + SDEPTH) * KVBLK); SBAR();
    pv_d0(o, vb0 + (int)SHM_V, pa0, pa1, pa2, pa3); partialSM(pA0, pA1, m_reg, mnA, alA);
    __syncthreads(); SWAIT(); SWRITE(1, SO);
    RESC(alA); __syncthreads();
  }
  SBAR(); qkt(pB0, pB1, (bf16*)((char*)K_lds + SHM_K), qr, r32, hi);
  finishSM(pA0, pA1, alA, l_reg, pa0, pa1, pa2, pa3); SBAR();
  pv_d0(o, vb0, pa0, pa1, pa2, pa3); partialSM(pB0, pB1, m_reg, mnB, alB);
  __syncthreads(); RESC(alB);
  finishSM(pB0, pB1, alB, l_reg, pa0, pa1, pa2, pa3); SBAR();
  pv_d0(o, vb0 + (int)SHM_V, pa0, pa1, pa2, pa3);
  if (hi == 0) li_l[r32] = l_reg; asm volatile("s_waitcnt lgkmcnt(0)" ::: "memory");
  float rli[16];
#pragma unroll
  for (int r = 0; r < 16; ++r) rli[r] = __builtin_amdgcn_rcpf(li_l[crow(r, hi)]);
  float* Ow = Ob + (long)(wid * QBLK) * LDO;
#pragma unroll
  for (int r = 0; r < 16; ++r) { int orow = crow(r, hi);
    for (int d0 = 0; d0 < 4; ++d0) Ow[(long)orow * LDO + d0 * 32 + r32] = o[d0][r] * rli[r]; }
#undef SLOAD
#undef SWRITE
#undef SWAIT
#undef RESC
}
#undef KSWZ
#undef SBAR
}
constexpr int NWAVES = 8;
constexpr int DM = 2048, NBATCH = 4, SEQ = 2048, CTXL = 256;
constexpr int TL = NBATCH * SEQ, TC = NBATCH * CTXL, TT = TL + TC;
constexpr int N0 = 9248, N0P = 9472, N1 = 6144;
constexpr int NE = 64, TCAP = TT;
constexpr int MAXROWS = 99328;
constexpr int C_Z = 3072, C_A = 4096, C_B = 4112, C_HQ = 4128, C_HF = 5152, C_HI = 7200, C_OG = 8224;
constexpr float EPS = 1e-6f;
constexpr float LAM_INIT = 0.35550906759310186f;
constexpr size_t MiB = 1u << 20;
constexpr size_t WS_CTL = 0, CTL_ZERO_BYTES = 1 * MiB;
constexpr size_t WS_MODV = 2, WS_LTOK = 3, WS_LW = 6, WS_SELE = 9, WS_SELP = 10, WS_SLOTW = 11, WS_G = 12, WS_BETA = 14;
constexpr size_t WS_WIN0 = 16, WS_WOUT0 = 53, WS_GU0 = 61, WS_DN0 = 321, WS_WIN1 = 451, WS_WOUT1 = 475, WS_GU1 = 483, WS_DN1 = 743;
constexpr size_t WS_XR = 873, WS_H = 945, WS_BIG = 981;
constexpr size_t WS_PROJ0 = WS_BIG, WS_DQ = 1144, WS_DK = 1180, WS_DV = 1216, WS_HQ = 1252, WS_HF = 1288, WS_OD = 1362, WS_OH = 1434, WS_Y = 1506;
constexpr size_t WS_QKV = WS_BIG, WS_Q = 1089, WS_K = 1121, WS_V = 1157, WS_OATT = 1193;
constexpr size_t WS_HA = WS_BIG, WS_ACT = 1369;
constexpr size_t WS_END = 1544;
constexpr int CW_TMO = 0, CW_BAR = 4096, CW_CNT = 8192;
constexpr int RING_BYTES = 131072, LDSCTL_OFF = RING_BYTES, LDS_BYTES = 147456;
constexpr int L_TILEE = LDSCTL_OFF;
constexpr int L_RSTART = LDSCTL_OFF + 2048;
constexpr int L_CNT = LDSCTL_OFF + 2048 + 512;
constexpr int L_MISC = LDSCTL_OFF + 4096;

struct Args { const float* in[38]; float* out; unsigned char* ws; };
struct Frame { LAS unsigned char* lds; unsigned char* ldsg; int tid, lane, wave, G, bid; unsigned char* ws; gu32* ctl; };

typedef const float* cfptr_t;
__device__ __forceinline__ const float* ARG(int i) {
    unsigned long long b = (unsigned long long)__builtin_amdgcn_kernarg_segment_ptr(); asm volatile("" : "+s"(b));
    return ((const __attribute__((address_space(4))) cfptr_t*)b)[i];
}
__device__ __forceinline__ float* ARG_OUT() { return (float*)ARG(38); }
__device__ __forceinline__ float wave_sum(float v) {
#pragma unroll
    for (int o = 1; o < 64; o <<= 1) v += __shfl_xor(v, o);
    return v;
}
__device__ __forceinline__ float bf2f(unsigned short b) { return __uint_as_float(((unsigned)b) << 16); }
__device__ __forceinline__ float bflo(unsigned w) { return __uint_as_float(w << 16); }
__device__ __forceinline__ float bfhi(unsigned w) { return __uint_as_float(w & 0xffff0000u); }
__device__ __forceinline__ float sigmoidf_(float x) { return 1.f / (1.f + __expf(-x)); }
__device__ __forceinline__ float siluf_(float x) { return x / (1.f + __expf(-x)); }
__device__ __forceinline__ void unpack8(const v4u w, float (&o)[8]) {
    o[0] = bflo(w.x); o[1] = bfhi(w.x); o[2] = bflo(w.y); o[3] = bfhi(w.y); o[4] = bflo(w.z); o[5] = bfhi(w.z); o[6] = bflo(w.w); o[7] = bfhi(w.w);
}
__device__ __forceinline__ v4u pack8(const float (&o)[8]) { v4u w; w.x = pk2(o[0], o[1]); w.y = pk2(o[2], o[3]); w.z = pk2(o[4], o[5]); w.w = pk2(o[6], o[7]); return w; }

__device__ __forceinline__ void phase_mod(Frame& F, const Args& A) {
    LAS float* sc = (LAS float*)(F.lds);
    LAS float* part = (LAS float*)(F.lds + 40960);
    float* modv = (float*)(F.ws + WS_MODV * MiB);
    for (int i = F.tid; i < 5 * 2048; i += 512) { const int r = i >> 11, k = i & 2047; const float v = (r < 4) ? ARG(1)[r * 2048 + k] : ARG(3)[k]; sc[i] = siluf_(v); }
    __syncthreads();
    const int kq = F.lane >> 4, c4 = F.lane & 15;
    for (int item = F.bid; item < 384; item += F.G) {
        const int l = item / 192, cb = item % 192;
        const float* W = l ? ARG(22) : ARG(5); const float* Bv = l ? ARG(23) : ARG(6);
        float acc[5][4];
#pragma unroll
        for (int r = 0; r < 5; ++r)
#pragma unroll
            for (int j = 0; j < 4; ++j) acc[r][j] = 0.f;
        const float* wp = W + (size_t)(F.wave * 256 + kq) * 12288 + cb * 64 + c4 * 4;
#pragma unroll 4
        for (int i = 0; i < 64; ++i) {
            const f32x4 w = *(const f32x4*)(wp + (size_t)i * 4 * 12288);
            const int k = F.wave * 256 + 4 * i + kq;
#pragma unroll
            for (int r = 0; r < 5; ++r) { const float s = sc[r * 2048 + k];
#pragma unroll
                for (int j = 0; j < 4; ++j) acc[r][j] += s * w[j]; }
        }
#pragma unroll
        for (int r = 0; r < 5; ++r)
#pragma unroll
            for (int j = 0; j < 4; ++j) { float a = acc[r][j]; a += __shfl_xor(a, 16); a += __shfl_xor(a, 32); acc[r][j] = a; }
        if (kq == 0) {
#pragma unroll
            for (int r = 0; r < 5; ++r)
#pragma unroll
                for (int j = 0; j < 4; ++j) part[(F.wave * 5 + r) * 64 + c4 * 4 + j] = acc[r][j];
        }
        __syncthreads();
        if (F.tid < 320) { const int r = F.tid >> 6, cc = F.tid & 63; float s = 0.f;
#pragma unroll
            for (int w = 0; w < 8; ++w) s += part[(w * 5 + r) * 64 + cc];
            modv[(size_t)(l * 5 + r) * 12288 + cb * 64 + cc] = s + Bv[cb * 64 + cc]; }
        __syncthreads();
    }
}

template <int MODE> __device__ __forceinline__ void transpose_item(const float* W, int K, int N, bf16* WT, LAS float* scr, int item, int lane) {
    const int nblk = N / 32, kb = item / nblk, nb = item % nblk, k0 = 64 * kb, n0 = 32 * nb;
    const int d0 = MODE ? (256 * ((n0 & 511) >> 7) + 128 * (n0 >> 9) + (n0 & 127)) : n0;
#pragma unroll 8
    for (int i = 0; i < 32; ++i) { const int kk = 2 * i + (lane >> 5); scr[kk * 33 + (lane & 31)] = W[(size_t)(k0 + kk) * N + n0 + (lane & 31)]; }
    LDS_WAIT(); asm volatile("" ::: "memory");
    const int c = lane & 7;
#pragma unroll
    for (int j = 0; j < 4; ++j) { const int n = (lane >> 3) + 8 * j; const LAS float* s = scr + (8 * c) * 33 + n;
        v4u o; o.x = pk2(s[0 * 33], s[1 * 33]); o.y = pk2(s[2 * 33], s[3 * 33]); o.z = pk2(s[4 * 33], s[5 * 33]); o.w = pk2(s[6 * 33], s[7 * 33]);
        *(GAS v4u*)(WT + (size_t)(d0 + n) * K + k0 + 8 * c) = o; }
    LDS_WAIT(); asm volatile("" ::: "memory");
}
__device__ __forceinline__ void phase_convert(Frame& F, const Args& A) {
    LAS float* scr = (LAS float*)(F.lds + 51200 + F.wave * 8704);
    const int gw = F.bid * NWAVES + F.wave, NGW = F.G * NWAVES;
    constexpr int I_IN0 = 32 * 289, I_OUT = 32 * 64, I_GU = 32 * 32, I_DN = 8 * 64, I_IN1 = 32 * 192;
    constexpr int PER_L_E = NE * I_GU + I_GU + NE * I_DN + I_DN;
    constexpr int NITEMS = I_IN0 + I_OUT + I_IN1 + I_OUT + 2 * PER_L_E;
    unsigned char* ws = F.ws;
    for (int it = gw; it < NITEMS; it += NGW) {
        int r = it;
        if (r < I_IN0) { transpose_item<0>(ARG(9), 2048, N0, (bf16*)(ws + WS_WIN0 * MiB), scr, r, F.lane); continue; } r -= I_IN0;
        if (r < I_OUT) { transpose_item<0>(ARG(15), 2048, 2048, (bf16*)(ws + WS_WOUT0 * MiB), scr, r, F.lane); continue; } r -= I_OUT;
        if (r < I_IN1) { transpose_item<0>(ARG(26), 2048, N1, (bf16*)(ws + WS_WIN1 * MiB), scr, r, F.lane); continue; } r -= I_IN1;
        if (r < I_OUT) { transpose_item<0>(ARG(31), 2048, 2048, (bf16*)(ws + WS_WOUT1 * MiB), scr, r, F.lane); continue; } r -= I_OUT;
        const int l = r / PER_L_E; r -= l * PER_L_E;
        const float* egu = l ? ARG(34) : ARG(18); const float* edn = l ? ARG(35) : ARG(19);
        const float* sgu = l ? ARG(36) : ARG(20); const float* sdn = l ? ARG(37) : ARG(21);
        bf16* GU = (bf16*)(ws + (l ? WS_GU1 : WS_GU0) * MiB); bf16* DN = (bf16*)(ws + (l ? WS_DN1 : WS_DN0) * MiB);
        if (r < NE * I_GU) { const int e = r / I_GU; transpose_item<1>(egu + (size_t)e * 2048 * 1024, 2048, 1024, GU + (size_t)e * 1024 * 2048, scr, r % I_GU, F.lane); continue; } r -= NE * I_GU;
        if (r < I_GU) { transpose_item<1>(sgu, 2048, 1024, GU + (size_t)NE * 1024 * 2048, scr, r, F.lane); continue; } r -= I_GU;
        if (r < NE * I_DN) { const int e = r / I_DN; transpose_item<0>(edn + (size_t)e * 512 * 2048, 512, 2048, DN + (size_t)e * 2048 * 512, scr, r % I_DN, F.lane); continue; } r -= NE * I_DN;
        transpose_item<0>(sdn, 512, 2048, DN + (size_t)NE * 2048 * 512, scr, r, F.lane);
    }
    { v4u z; z.x = z.y = z.z = z.w = 0u; GAS v4u* p = (GAS v4u*)(ws + WS_WIN0 * MiB + (size_t)N0 * 2048 * 2);
      for (int i = F.bid * 512 + F.tid; i < (N0P - N0) * 2048 * 2 / 16; i += F.G * 512) p[i] = z; }
}

__device__ __forceinline__ void norm_row_regs(const float* xr, const float* nw, const float* sh, const float* scl, int lane, f32x4 (&o)[8]) {
    f32x4 v[8]; float ss = 0.f;
#pragma unroll
    for (int j = 0; j < 8; ++j) { v[j] = *(const f32x4*)(xr + j * 256 + lane * 4); ss += (v[j].x * v[j].x + v[j].y * v[j].y) + (v[j].z * v[j].z + v[j].w * v[j].w); }
    const float rstd = 1.f / sqrtf(wave_sum(ss) * (1.f / 2048.f) + EPS);
#pragma unroll
    for (int j = 0; j < 8; ++j) { const int c = j * 256 + lane * 4; const f32x4 w = *(const f32x4*)(nw + c), s = *(const f32x4*)(sh + c), g = *(const f32x4*)(scl + c);
        o[j] = v[j] * rstd * w * (g + 1.f) + s; }
}
__device__ __forceinline__ int bidx_of_row(int row) { return row < TL ? (row >> 11) : 4; }
__device__ __forceinline__ void phase_norm0(Frame& F, const Args& A) {
    const float* modv = (const float*)(F.ws + WS_MODV * MiB); bf16* H = (bf16*)(F.ws + WS_H * MiB);
    const int gw = F.bid * NWAVES + F.wave, NGW = F.G * NWAVES;
    for (int row = gw; row < TT; row += NGW) {
        const float* xr = row < TL ? ARG(0) + (size_t)row * DM : ARG(2) + (size_t)(row - TL) * DM;
        const float* mv = modv + (size_t)bidx_of_row(row) * 12288;
        f32x4 o[8]; norm_row_regs(xr, ARG(7), mv, mv + 2048, F.lane, o);
#pragma unroll
        for (int j = 0; j < 8; ++j) { uint2 w; w.x = pk2(o[j].x, o[j].y); w.y = pk2(o[j].z, o[j].w); *(uint2*)(H + (size_t)row * DM + j * 256 + F.lane * 4) = w; }
    }
}

__device__ __forceinline__ void phase_prep0(Frame& F, const Args& A) {
    const bf16* P = (const bf16*)(F.ws + WS_PROJ0 * MiB);
    float* DQ = (float*)(F.ws + WS_DQ * MiB); float* HQ = (float*)(F.ws + WS_HQ * MiB); float* HF = (float*)(F.ws + WS_HF * MiB);
    float* Gb = (float*)(F.ws + WS_G * MiB); float* Bb = (float*)(F.ws + WS_BETA * MiB);
    const float* cw = ARG(10); const float* lbl = ARG(4);
    const int gw = F.bid * NWAVES + F.wave, NGW = F.G * NWAVES, lane = F.lane;
    for (int row = gw; row < TT; row += NGW) {
        int t, L, base;
        if (row < TL) { t = row & 2047; L = SEQ; base = row - t; } else { const int rr = row - TL; t = rr & 255; L = CTXL; base = row - t; }
#pragma unroll 1
        for (int p = 0; p < 6; ++p) {
            const int c0 = p * 512 + lane * 8;
            float acc[8];
#pragma unroll
            for (int e = 0; e < 8; ++e) acc[e] = 0.f;
            float wv[40];
#pragma unroll
            for (int q4 = 0; q4 < 10; ++q4) { const f32x4 w = *(const f32x4*)(cw + (size_t)c0 * 5 + q4 * 4); wv[q4 * 4 + 0] = w.x; wv[q4 * 4 + 1] = w.y; wv[q4 * 4 + 2] = w.z; wv[q4 * 4 + 3] = w.w; }
#pragma unroll
            for (int j = 0; j < 5; ++j) { const int tt = t + j - 2;
                if (tt >= 0 && tt < L) { const v4u xw = *(const v4u*)(P + (size_t)(base + tt) * N0 + c0); float xf[8]; unpack8(xw, xf);
#pragma unroll
                    for (int e = 0; e < 8; ++e) acc[e] += xf[e] * wv[e * 5 + j]; } }
#pragma unroll
            for (int e = 0; e < 8; ++e) acc[e] = siluf_(acc[e]);
            if (p < 4) { float ss = 0.f;
#pragma unroll
                for (int e = 0; e < 8; ++e) ss += acc[e] * acc[e];
                ss += __shfl_xor(ss, 1); ss += __shfl_xor(ss, 2); ss += __shfl_xor(ss, 4); ss += __shfl_xor(ss, 8);
                float inv = 1.f / sqrtf(ss + 1e-6f); if (p < 2) inv *= 0.08838834764831845f;
#pragma unroll
                for (int e = 0; e < 8; ++e) acc[e] *= inv; }
            float* dst = DQ + (size_t)(p >> 1) * (36 * MiB / 4) + (size_t)row * 1024 + (p & 1) * 512 + lane * 8;
            *(f32x4*)dst = (f32x4){acc[0], acc[1], acc[2], acc[3]}; *(f32x4*)(dst + 4) = (f32x4){acc[4], acc[5], acc[6], acc[7]};
        }
        if (lane < 32) { const int idx = lane & 15, d = idx >> 3, h = idx & 7;
            if (lane < 16) { const float a = bf2f(P[(size_t)row * N0 + C_A + idx]); const float x = a + ARG(12)[idx];
                const float sp = fmaxf(x, 0.f) + log1pf(__expf(-fabsf(x)));
                Gb[((size_t)d * TT + row) * 8 + h] = -__expf(ARG(11)[idx]) * sp; }
            else { const float bb = bf2f(P[(size_t)row * N0 + C_B + idx]); Bb[((size_t)d * TT + row) * 8 + h] = sigmoidf_(bb); } }
#pragma unroll 1
        for (int p = 0; p < 2; ++p) { const int c0 = p * 512 + lane * 8; const v4u xw = *(const v4u*)(P + (size_t)row * N0 + C_HQ + c0); float xf[8]; unpack8(xw, xf);
#pragma unroll
            for (int e = 0; e < 8; ++e) xf[e] = siluf_(xf[e]);
            float* dst = HQ + (size_t)row * 1024 + c0; *(f32x4*)dst = (f32x4){xf[0], xf[1], xf[2], xf[3]}; *(f32x4*)(dst + 4) = (f32x4){xf[4], xf[5], xf[6], xf[7]}; }
#pragma unroll 1
        for (int p = 0; p < 4; ++p) { const int d = p >> 1, c0 = (p & 1) * 512 + lane * 8; const v4u xw = *(const v4u*)(P + (size_t)row * N0 + C_HF + d * 1024 + c0); float xf[8]; unpack8(xw, xf);
#pragma unroll
            for (int e = 0; e < 8; ++e) { const int c = c0 + e; const float e0 = __expf(lbl[c]), e1 = __expf(lbl[1024 + c]), e2 = __expf(lbl[2048 + c]); const float lb = e0 / (e0 + e1 + e2);
                xf[e] = lb + (1.f - lb) * sigmoidf_(xf[e]); }
            float* dst = HF + ((size_t)d * TT + row) * 1024 + c0; *(f32x4*)dst = (f32x4){xf[0], xf[1], xf[2], xf[3]}; *(f32x4*)(dst + 4) = (f32x4){xf[4], xf[5], xf[6], xf[7]}; }
    }
}

__device__ __forceinline__ void phase_scan0(Frame& F, const Args& A) {
    const bf16* P = (const bf16*)(F.ws + WS_PROJ0 * MiB);
    LAS float* qs = (LAS float*)(F.lds);
    LAS float* ks = (LAS float*)(F.lds + 32768);
    LAS float* vs = (LAS float*)(F.lds + 65536);
    LAS float* ob = (LAS float*)(F.lds + 81920);
    LAS float* gs = (LAS float*)(F.lds + 98304);
    LAS float* bs = (LAS float*)(F.lds + 98304 + 256);
    const int tid = F.tid, lane = F.lane, w = F.wave, vl = lane & 7, kp = lane >> 3;
    for (int unit = F.bid; unit < 256; unit += F.G) {
        const int type = unit >> 7, rem = unit & 127, b = rem >> 5, h = (rem >> 2) & 7, dir = (rem >> 1) & 1, vh = rem & 1;
        const float* Qg = (const float*)(F.ws + (type ? WS_HQ : WS_DQ) * MiB);
        const float* Kg = type ? (const float*)(F.ws + WS_HF * MiB) + (size_t)dir * TT * 1024 : (const float*)(F.ws + WS_DK * MiB);
        const float* Vg = (const float*)(F.ws + WS_DV * MiB);
        const float* Gg = (const float*)(F.ws + WS_G * MiB) + (size_t)dir * TT * 8; const float* Bg = (const float*)(F.ws + WS_BETA * MiB) + (size_t)dir * TT * 8;
        float* Og = (float*)(F.ws + (type ? WS_OH : WS_OD) * MiB) + (size_t)dir * TT * 1024;
        float S[16];
#pragma unroll
        for (int e = 0; e < 16; ++e) S[e] = 0.f;
        f32x4 rq[4], rk[4], rv[2]; float rg = 0.f, rb = 0.f;
#define SCAN_ROW(ci, i) ((ci) < 4 ? (TL + b * CTXL + (dir ? (CTXL - 1 - ((ci) * 64 + (i))) : ((ci) * 64 + (i)))) : (b * SEQ + (dir ? (SEQ - 1 - (((ci) - 4) * 64 + (i))) : (((ci) - 4) * 64 + (i)))))
#define SCAN_LOAD(ci) do { \
            _Pragma("unroll") for (int j = 0; j < 4; ++j) { const int idx = tid + 512 * j, tok = idx >> 5, c4 = idx & 31; const size_t r = (size_t)SCAN_ROW(ci, tok); \
                rq[j] = *(const f32x4*)(Qg + r * 1024 + h * 128 + c4 * 4); rk[j] = *(const f32x4*)(Kg + r * 1024 + h * 128 + c4 * 4); } \
            _Pragma("unroll") for (int j = 0; j < 2; ++j) { const int idx = tid + 512 * j, tok = idx >> 4, c4 = idx & 15; const size_t r = (size_t)SCAN_ROW(ci, tok); \
                if (type) { const uint2 xw = *(const uint2*)(P + r * N0 + C_HI + h * 128 + vh * 64 + c4 * 4); rv[j] = (f32x4){bflo(xw.x), bfhi(xw.x), bflo(xw.y), bfhi(xw.y)}; } \
                else rv[j] = *(const f32x4*)(Vg + r * 1024 + h * 128 + vh * 64 + c4 * 4); } \
            if (tid < 64 && type == 0) { const size_t r = (size_t)SCAN_ROW(ci, tid); rg = __expf(Gg[r * 8 + h]); rb = Bg[r * 8 + h]; } } while (0)
        SCAN_LOAD(0);
#pragma unroll 1
        for (int ci = 0; ci < 36; ++ci) {
            __syncthreads();
#pragma unroll
            for (int j = 0; j < 4; ++j) { const int idx = tid + 512 * j; *(LAS f32x4*)(qs + idx * 4) = rq[j]; *(LAS f32x4*)(ks + idx * 4) = rk[j]; }
#pragma unroll
            for (int j = 0; j < 2; ++j) { const int idx = tid + 512 * j; *(LAS f32x4*)(vs + idx * 4) = rv[j]; }
            if (tid < 64) { gs[tid] = rg; bs[tid] = rb; }
            __syncthreads();
            if (ci + 1 < 36) SCAN_LOAD(ci + 1);
            if (type == 0) {
#pragma unroll 2
                for (int i = 0; i < 64; ++i) {
                    const float a = gs[i], bt = bs[i], vv = vs[i * 64 + w * 8 + vl];
                    float kx[16], qx[16];
#pragma unroll
                    for (int q4 = 0; q4 < 4; ++q4) { const f32x4 kk = *(const LAS f32x4*)(ks + i * 128 + kp * 16 + q4 * 4); const f32x4 qq = *(const LAS f32x4*)(qs + i * 128 + kp * 16 + q4 * 4);
                        kx[q4 * 4] = kk.x; kx[q4 * 4 + 1] = kk.y; kx[q4 * 4 + 2] = kk.z; kx[q4 * 4 + 3] = kk.w; qx[q4 * 4] = qq.x; qx[q4 * 4 + 1] = qq.y; qx[q4 * 4 + 2] = qq.z; qx[q4 * 4 + 3] = qq.w; }
                    float s0 = 0.f, s1 = 0.f, s2 = 0.f, s3 = 0.f;
#pragma unroll
                    for (int e = 0; e < 16; e += 4) { s0 += kx[e] * S[e]; s1 += kx[e + 1] * S[e + 1]; s2 += kx[e + 2] * S[e + 2]; s3 += kx[e + 3] * S[e + 3]; }
                    float kS = (s0 + s1) + (s2 + s3);
                    kS += __shfl_xor(kS, 8); kS += __shfl_xor(kS, 16); kS += __shfl_xor(kS, 32);
                    const float c = bt * (vv - a * kS);
                    float o0 = 0.f, o1 = 0.f, o2 = 0.f, o3 = 0.f;
#pragma unroll
                    for (int e = 0; e < 16; e += 4) { S[e] = a * S[e] + kx[e] * c; S[e + 1] = a * S[e + 1] + kx[e + 1] * c; S[e + 2] = a * S[e + 2] + kx[e + 2] * c; S[e + 3] = a * S[e + 3] + kx[e + 3] * c;
                        o0 += qx[e] * S[e]; o1 += qx[e + 1] * S[e + 1]; o2 += qx[e + 2] * S[e + 2]; o3 += qx[e + 3] * S[e + 3]; }
                    float op = (o0 + o1) + (o2 + o3);
                    op += __shfl_xor(op, 8); op += __shfl_xor(op, 16); op += __shfl_xor(op, 32);
                    if (kp == 0) ob[i * 64 + w * 8 + vl] = op;
                }
            } else {
#pragma unroll 2
                for (int i = 0; i < 64; ++i) {
                    const float vv = vs[i * 64 + w * 8 + vl];
                    float fx[16], qx[16];
#pragma unroll
                    for (int q4 = 0; q4 < 4; ++q4) { const f32x4 kk = *(const LAS f32x4*)(ks + i * 128 + kp * 16 + q4 * 4); const f32x4 qq = *(const LAS f32x4*)(qs + i * 128 + kp * 16 + q4 * 4);
                        fx[q4 * 4] = kk.x; fx[q4 * 4 + 1] = kk.y; fx[q4 * 4 + 2] = kk.z; fx[q4 * 4 + 3] = kk.w; qx[q4 * 4] = qq.x; qx[q4 * 4 + 1] = qq.y; qx[q4 * 4 + 2] = qq.z; qx[q4 * 4 + 3] = qq.w; }
                    float o0 = 0.f, o1 = 0.f, o2 = 0.f, o3 = 0.f;
#pragma unroll
                    for (int e = 0; e < 16; e += 4) {
                        S[e] = fx[e] * S[e] + (1.f - fx[e]) * vv; S[e + 1] = fx[e + 1] * S[e + 1] + (1.f - fx[e + 1]) * vv; S[e + 2] = fx[e + 2] * S[e + 2] + (1.f - fx[e + 2]) * vv; S[e + 3] = fx[e + 3] * S[e + 3] + (1.f - fx[e + 3]) * vv;
                        o0 += qx[e] * S[e]; o1 += qx[e + 1] * S[e + 1]; o2 += qx[e + 2] * S[e + 2]; o3 += qx[e + 3] * S[e + 3]; }
                    float op = (o0 + o1) + (o2 + o3);
                    op += __shfl_xor(op, 8); op += __shfl_xor(op, 16); op += __shfl_xor(op, 32);
                    if (kp == 0) ob[i * 64 + w * 8 + vl] = op;
                }
            }
            __syncthreads();
#pragma unroll
            for (int j = 0; j < 2; ++j) { const int idx = tid + 512 * j, tok = idx >> 4, c4 = idx & 15; const size_t r = (size_t)SCAN_ROW(ci, tok);
                *(f32x4*)(Og + r * 1024 + h * 128 + vh * 64 + c4 * 4) = *(const LAS f32x4*)(ob + tok * 64 + c4 * 4); }
        }
        __syncthreads();
#undef SCAN_LOAD
#undef SCAN_ROW
    }
}

__device__ __forceinline__ void phase_outnorm0(Frame& F, const Args& A) {
    const bf16* P = (const bf16*)(F.ws + WS_PROJ0 * MiB); bf16* Y = (bf16*)(F.ws + WS_Y * MiB);
    const int gw = F.bid * NWAVES + F.wave, NGW = F.G * NWAVES, lane = F.lane;
    for (int row = gw; row < TT; row += NGW) {
#pragma unroll 1
        for (int p = 0; p < 4; ++p) { const int t2 = p >> 1, c0 = (p & 1) * 512 + lane * 8;
            const float* O0 = (const float*)(F.ws + (t2 ? WS_OH : WS_OD) * MiB) + (size_t)row * 1024 + c0; const float* O1 = O0 + (size_t)TT * 1024;
            const f32x4 a0 = *(const f32x4*)O0, a1 = *(const f32x4*)(O0 + 4), b0 = *(const f32x4*)O1, b1 = *(const f32x4*)(O1 + 4);
            float o[8] = {a0.x + b0.x, a0.y + b0.y, a0.z + b0.z, a0.w + b0.w, a1.x + b1.x, a1.y + b1.y, a1.z + b1.z, a1.w + b1.w};
            float ss = 0.f;
#pragma unroll
            for (int e = 0; e < 8; ++e) ss += o[e] * o[e];
            ss += __shfl_xor(ss, 1); ss += __shfl_xor(ss, 2); ss += __shfl_xor(ss, 4); ss += __shfl_xor(ss, 8);
            const float rstd = 1.f / sqrtf(ss * (1.f / 128.f) + EPS);
            const float* nw = (t2 ? ARG(14) : ARG(13)) + (c0 & 127);
            const v4u gw4 = *(const v4u*)(P + (size_t)row * N0 + (t2 ? C_OG : C_Z) + c0); float gf[8]; unpack8(gw4, gf);
#pragma unroll
            for (int e = 0; e < 8; ++e) o[e] = o[e] * rstd * nw[e] * (t2 ? sigmoidf_(gf[e]) : siluf_(gf[e]));
            *(v4u*)(Y + (size_t)row * DM + t2 * 1024 + c0) = pack8(o);
        }
    }
}

struct EpiProj0 {
    static constexpr bool PERM = true, AFTER_DRAIN = false;
    bf16* O;
    __device__ __forceinline__ void operator()(const pg8::f32x4 (&acc)[2][2][4][2], const pg8::Unit& u, int wr, int wc, int fr, int fq) const {
        const int row0 = u.pm * 256 + wr * 64 + fr, col0 = u.pn * 256 + wc * 32 + 8 * fq;
#pragma unroll
        for (int ai = 0; ai < 2; ++ai)
#pragma unroll
            for (int m = 0; m < 4; ++m) { bf16* rowp = O + (size_t)(row0 + ai * 128 + m * 16) * N0 + col0;
#pragma unroll
                for (int bj = 0; bj < 2; ++bj) { if (col0 + bj * 128 < N0) { const pg8::f32x4 v0 = acc[ai][bj][m][0], v1 = acc[ai][bj][m][1];
                    pg8::u32x4 w; w.x = pg8::cvt_pk_bf16(v0[0], v0[1]); w.y = pg8::cvt_pk_bf16(v0[2], v0[3]); w.z = pg8::cvt_pk_bf16(v1[0], v1[1]); w.w = pg8::cvt_pk_bf16(v1[2], v1[3]);
                    *(pg8::u32x4*)(rowp + bj * 128) = w; } } }
    }
};
struct EpiResid {
    static constexpr bool PERM = false, AFTER_DRAIN = false;
    const float* baseL; const float* baseC; float* out; const float* gate;
    __device__ __forceinline__ void operator()(const pg8::f32x4 (&acc)[2][2][4][2], const pg8::Unit& u, int wr, int wc, int fr, int fq) const {
        const int row0 = u.pm * 256 + wr * 64 + fr, col0 = u.pn * 256 + wc * 32 + 4 * fq;
#pragma unroll
        for (int ai = 0; ai < 2; ++ai)
#pragma unroll
            for (int m = 0; m < 4; ++m) { const int row = row0 + ai * 128 + m * 16;
                const float* bp = (row < TL ? baseL + (size_t)row * DM : baseC + (size_t)(row - TL) * DM) + col0; const float* gp = gate + (size_t)bidx_of_row(row) * 12288 + col0; float* op = out + (size_t)row * DM + col0;
#pragma unroll
                for (int bj = 0; bj < 2; ++bj)
#pragma unroll
                    for (int n = 0; n < 2; ++n) { const int o = bj * 128 + n * 16; const pg8::f32x4 bs = *(const pg8::f32x4*)(bp + o), g = *(const pg8::f32x4*)(gp + o);
                        *(pg8::f32x4*)(op + o) = bs + g * acc[ai][bj][m][n]; } }
    }
};
struct EpiSwiGLU {
    static constexpr bool PERM = true, AFTER_DRAIN = false;
    bf16* ACT;
    __device__ __forceinline__ void operator()(const pg8::f32x4 (&acc)[2][2][4][2], const pg8::Unit& u, int wr, int wc, int fr, int fq) const {
        const int row0 = u.pm * 256 + wr * 64 + fr, col0 = (u.pn & 3) * 128 + wc * 32 + 8 * fq;
#pragma unroll
        for (int ai = 0; ai < 2; ++ai)
#pragma unroll
            for (int m = 0; m < 4; ++m) { bf16* rowp = ACT + (size_t)(row0 + ai * 128 + m * 16) * 512 + col0; float r[8];
#pragma unroll
                for (int n = 0; n < 2; ++n)
#pragma unroll
                    for (int i = 0; i < 4; ++i) { const float a = acc[ai][0][m][n][i], b = acc[ai][1][m][n][i]; r[n * 4 + i] = siluf_(a) * b; }
                pg8::u32x4 w; w.x = pg8::cvt_pk_bf16(r[0], r[1]); w.y = pg8::cvt_pk_bf16(r[2], r[3]); w.z = pg8::cvt_pk_bf16(r[4], r[5]); w.w = pg8::cvt_pk_bf16(r[6], r[7]);
                *(pg8::u32x4*)rowp = w; }
    }
};
struct EpiDown {
    static constexpr bool PERM = true, AFTER_DRAIN = false;
    bf16* Yo; const float* slotw;
    __device__ __forceinline__ void operator()(const pg8::f32x4 (&acc)[2][2][4][2], const pg8::Unit& u, int wr, int wc, int fr, int fq) const {
        const int row0 = u.pm * 256 + wr * 64 + fr, col0 = (u.pn & 7) * 256 + wc * 32 + 8 * fq;
#pragma unroll
        for (int ai = 0; ai < 2; ++ai)
#pragma unroll
            for (int m = 0; m < 4; ++m) { const int row = row0 + ai * 128 + m * 16; const float sw = slotw[row]; bf16* rowp = Yo + (size_t)row * DM + col0;
#pragma unroll
                for (int bj = 0; bj < 2; ++bj) { const pg8::f32x4 v0 = acc[ai][bj][m][0] * sw, v1 = acc[ai][bj][m][1] * sw;
                    pg8::u32x4 w; w.x = pg8::cvt_pk_bf16(v0[0], v0[1]); w.y = pg8::cvt_pk_bf16(v0[2], v0[3]); w.z = pg8::cvt_pk_bf16(v1[0], v1[1]); w.w = pg8::cvt_pk_bf16(v1[2], v1[3]);
                    *(pg8::u32x4*)(rowp + bj * 128) = w; } }
    }
};
struct MoeOrder {
    int nsh, ntiles, nN, G, c; const LAS int* tile_e;
    __device__ __forceinline__ bool next(int i, pg8::Unit& u) const {
        const int L = i * G + c; if (L >= ntiles * nN) return false;
        const int pm = L / nN, pnl = L - pm * nN; const int e = pm < nsh ? NE : tile_e[pm - nsh];
        u.pm = pm; u.pn = e * nN + pnl; return true;
    }
    __device__ __forceinline__ void a_ready(const pg8::Unit&) const {}
    __device__ __forceinline__ void done(const pg8::Unit&) const {}
};

template <int LAYER> __device__ __forceinline__ void phase_route(Frame& F, const Args& A) {
    constexpr int T = LAYER ? TL : TT;
    const float* modv = (const float*)(F.ws + WS_MODV * MiB) + (size_t)LAYER * 5 * 12288;
    const float* XR = (const float*)(F.ws + WS_XR * MiB); bf16* HA = (bf16*)(F.ws + WS_HA * MiB);
    const float* nw = ARG(LAYER ? 25 : 8); const float* rw = ARG(LAYER ? 32 : 16); const float* rbias = ARG(LAYER ? 33 : 17);
    int* cnt = (int*)(F.ctl + CW_CNT + LAYER * 64);
    int* ltok = (int*)(F.ws + WS_LTOK * MiB); float* lw = (float*)(F.ws + WS_LW * MiB); int* sele = (int*)(F.ws + WS_SELE * MiB); int* selp = (int*)(F.ws + WS_SELP * MiB);
    LAS float* h2s = (LAS float*)(F.lds);
    LAS float* parts = (LAS float*)(F.lds + 65536);
    const int lane = F.lane, w = F.wave;
    for (int grp = F.bid; grp < T / 8; grp += F.G) {
        const int row = grp * 8 + w;
        { const float* mv = modv + (size_t)bidx_of_row(row) * 12288; f32x4 o[8]; norm_row_regs(XR + (size_t)row * DM, nw, mv + 6144, mv + 8192, lane, o);
#pragma unroll
          for (int j = 0; j < 8; ++j) { *(LAS f32x4*)(h2s + w * 2048 + j * 256 + lane * 4) = o[j];
              uint2 pw; pw.x = pk2(o[j].x, o[j].y); pw.y = pk2(o[j].z, o[j].w); *(uint2*)(HA + (size_t)row * DM + j * 256 + lane * 4) = pw; } }
        __syncthreads();
        float acc[8];
#pragma unroll
        for (int r = 0; r < 8; ++r) acc[r] = 0.f;
#pragma unroll 2
        for (int kk = 0; kk < 256; kk += 4) { const int k = w * 256 + kk;
            const float w0 = rw[(size_t)k * 64 + lane], w1 = rw[(size_t)(k + 1) * 64 + lane], w2 = rw[(size_t)(k + 2) * 64 + lane], w3 = rw[(size_t)(k + 3) * 64 + lane];
#pragma unroll
            for (int r = 0; r < 8; ++r) { const f32x4 hv = *(const LAS f32x4*)(h2s + r * 2048 + k); acc[r] += (hv.x * w0 + hv.y * w1) + (hv.z * w2 + hv.w * w3); } }
#pragma unroll
        for (int r = 0; r < 8; ++r) parts[(w * 8 + r) * 64 + lane] = acc[r];
        __syncthreads();
        float logit = 0.f;
#pragma unroll
        for (int ww = 0; ww < 8; ++ww) logit += parts[(ww * 8 + w) * 64 + lane];
        const float score = 1.f / (1.f + expf(-logit)); const float biased = score + rbias[lane];
        int rg = 0;
#pragma unroll
        for (int j = 1; j < 8; ++j) { const int ol = (lane & ~7) | ((lane + j) & 7); const float ob = __shfl(biased, ol); rg += (ob > biased || (ob == biased && ol < lane)) ? 1 : 0; }
        float gsum = rg < 2 ? biased : 0.f; gsum += __shfl_xor(gsum, 1); gsum += __shfl_xor(gsum, 2); gsum += __shfl_xor(gsum, 4);
        const int g = lane >> 3; int gr = 0;
#pragma unroll
        for (int j = 0; j < 8; ++j) { const float og = __shfl(gsum, j * 8); gr += (j != g && (og > gsum || (og == gsum && j < g))) ? 1 : 0; }
        const bool gsel = gr < 4; const float mb = gsel ? biased : -__builtin_inff();
        int er = 0;
#pragma unroll 1
        for (int j = 0; j < 64; ++j) { const float ob = __uint_as_float(__builtin_amdgcn_readlane(__float_as_uint(mb), j)); er += (ob > mb || (ob == mb && j < lane)) ? 1 : 0; }
        const bool sel = gsel && er < 8;
        const float wsum = wave_sum(sel ? score : 0.f); const float wt = score / wsum * 2.5f;
        const unsigned long long m = __ballot(sel); const int kidx = __popcll(m & ((1ull << lane) - 1ull));
        if (sel) { const int pos = atomicAdd(&cnt[lane], 1); ltok[(size_t)lane * TCAP + pos] = row; lw[(size_t)lane * TCAP + pos] = wt; sele[(size_t)row * 8 + kidx] = lane; selp[(size_t)row * 8 + kidx] = pos; }
        __syncthreads();
    }
}
template <int LAYER> __device__ __forceinline__ int moe_tables(Frame& F) {
    LAS int* lcnt = (LAS int*)(F.lds + L_CNT); LAS int* rstart = (LAS int*)(F.lds + L_RSTART); LAS int* tile_e = (LAS int*)(F.lds + L_TILEE);
    const int* cnt = (const int*)(F.ctl + CW_CNT + LAYER * 64);
    __syncthreads();
    if (F.tid < 64) { const int c = __hip_atomic_load(cnt + F.tid, __ATOMIC_RELAXED, __HIP_MEMORY_SCOPE_AGENT); const int p = (c + 255) & ~255; int incl = p;
#pragma unroll
        for (int o = 1; o < 64; o <<= 1) { const int v = __shfl_up(incl, o); if (F.lane >= o) incl += v; }
        lcnt[F.tid] = c; rstart[F.tid] = incl - p; if (F.tid == 63) rstart[64] = incl; }
    __syncthreads();
    const int total = rstart[64];
    for (int t = F.tid; t < (total >> 8); t += 512) { const int r = t << 8; int e = 0;
#pragma unroll 1
        for (int q = 1; q < 64; ++q) e += (rstart[q] <= r) ? 1 : 0;
        tile_e[t] = e; }
    __syncthreads();
    return total;
}
template <int LAYER> __device__ __forceinline__ void phase_gather(Frame& F) {
    constexpr int T = LAYER ? TL : TT;
    const int total = moe_tables<LAYER>(F);
    const LAS int* lcnt = (const LAS int*)(F.lds + L_CNT); const LAS int* rstart = (const LAS int*)(F.lds + L_RSTART); const LAS int* tile_e = (const LAS int*)(F.lds + L_TILEE);
    bf16* HA = (bf16*)(F.ws + WS_HA * MiB); float* slotw = (float*)(F.ws + WS_SLOTW * MiB);
    const int* ltok = (const int*)(F.ws + WS_LTOK * MiB); const float* lw = (const float*)(F.ws + WS_LW * MiB);
    const int gw = F.bid * NWAVES + F.wave, NGW = F.G * NWAVES, lane = F.lane;
    for (int r = gw; r < total; r += NGW) {
        const int e = tile_e[r >> 8], pos = r - rstart[e];
        GAS v4u* dst = (GAS v4u*)(HA + (size_t)(T + r) * DM);
        if (pos < lcnt[e]) { const int tok = ltok[(size_t)e * TCAP + pos]; const GAS v4u* src = (const GAS v4u*)(HA + (size_t)tok * DM);
#pragma unroll
            for (int j = 0; j < 4; ++j) dst[j * 64 + lane] = src[j * 64 + lane];
            if (lane == 0) slotw[T + r] = lw[(size_t)e * TCAP + pos]; }
        else { v4u z; z.x = z.y = z.z = z.w = 0u;
#pragma unroll
            for (int j = 0; j < 4; ++j) dst[j * 64 + lane] = z;
            if (lane == 0) slotw[T + r] = 0.f; }
    }
    for (int r = F.bid * 512 + F.tid; r < T; r += F.G * 512) slotw[r] = 1.f;
}
template <int LAYER> __device__ __forceinline__ void phase_moe_gemm1(Frame& F) {
    constexpr int T = LAYER ? TL : TT;
    const int total = moe_tables<LAYER>(F);
    pg8::Gemm g{(const bf16*)(F.ws + WS_HA * MiB), (const bf16*)(F.ws + (LAYER ? WS_GU1 : WS_GU0) * MiB), 0, 1024, 2048};
    MoeOrder S{T / 256, T / 256 + (total >> 8), 4, F.G, F.bid, (const LAS int*)(F.lds + L_TILEE)};
    EpiSwiGLU E{(bf16*)(F.ws + WS_ACT * MiB)};
    pg8::gemm_phase<EpiSwiGLU, MoeOrder, true, true>(F.lds, g, S, E);
}
template <int LAYER> __device__ __forceinline__ void phase_moe_gemm2(Frame& F) {
    constexpr int T = LAYER ? TL : TT;
    const int total = moe_tables<LAYER>(F);
    pg8::Gemm g{(const bf16*)(F.ws + WS_ACT * MiB), (const bf16*)(F.ws + (LAYER ? WS_DN1 : WS_DN0) * MiB), 0, 2048, 512};
    MoeOrder S{T / 256, T / 256 + (total >> 8), 8, F.G, F.bid, (const LAS int*)(F.lds + L_TILEE)};
    EpiDown E{(bf16*)(F.ws + WS_HA * MiB), (const float*)(F.ws + WS_SLOTW * MiB)};
    pg8::gemm_phase<EpiDown, MoeOrder, true, true>(F.lds, g, S, E);
}
template <int LAYER> __device__ __forceinline__ void phase_combine(Frame& F, const Args& A) {
    constexpr int T = LAYER ? TL : TT;
    (void)moe_tables<LAYER>(F);
    const LAS int* rstart = (const LAS int*)(F.lds + L_RSTART);
    const bf16* Yb = (const bf16*)(F.ws + WS_HA * MiB); float* XR = (float*)(F.ws + WS_XR * MiB); bf16* H = (bf16*)(F.ws + WS_H * MiB);
    const int* sele = (const int*)(F.ws + WS_SELE * MiB); const int* selp = (const int*)(F.ws + WS_SELP * MiB);
    const float* modv = (const float*)(F.ws + WS_MODV * MiB);
    const int gw = F.bid * NWAVES + F.wave, NGW = F.G * NWAVES, lane = F.lane;
    for (int row = gw; row < T; row += NGW) {
        int rws[9]; rws[0] = row;
#pragma unroll
        for (int k = 0; k < 8; ++k) rws[k + 1] = T + rstart[sele[(size_t)row * 8 + k]] + selp[(size_t)row * 8 + k];
        const float* gate = modv + (size_t)(LAYER * 5 + bidx_of_row(row)) * 12288 + 10240;
        float xv[4][8]; float ss = 0.f;
#pragma unroll
        for (int j = 0; j < 4; ++j) { const int c0 = j * 512 + lane * 8; float s[8];
#pragma unroll
            for (int e = 0; e < 8; ++e) s[e] = 0.f;
#pragma unroll
            for (int k = 0; k < 9; ++k) { const v4u yw = *(const v4u*)(Yb + (size_t)rws[k] * DM + c0); float yf[8]; unpack8(yw, yf);
#pragma unroll
                for (int e = 0; e < 8; ++e) s[e] += yf[e]; }
            const f32x4 x0 = *(const f32x4*)(XR + (size_t)row * DM + c0), x1 = *(const f32x4*)(XR + (size_t)row * DM + c0 + 4);
            const f32x4 g0 = *(const f32x4*)(gate + c0), g1 = *(const f32x4*)(gate + c0 + 4);
            xv[j][0] = x0.x + g0.x * s[0]; xv[j][1] = x0.y + g0.y * s[1]; xv[j][2] = x0.z + g0.z * s[2]; xv[j][3] = x0.w + g0.w * s[3];
            xv[j][4] = x1.x + g1.x * s[4]; xv[j][5] = x1.y + g1.y * s[5]; xv[j][6] = x1.z + g1.z * s[6]; xv[j][7] = x1.w + g1.w * s[7];
#pragma unroll
            for (int e = 0; e < 8; ++e) ss += xv[j][e] * xv[j][e];
            float* op = LAYER ? ARG_OUT() + (size_t)row * DM + c0 : XR + (size_t)row * DM + c0;
            *(f32x4*)op = (f32x4){xv[j][0], xv[j][1], xv[j][2], xv[j][3]}; *(f32x4*)(op + 4) = (f32x4){xv[j][4], xv[j][5], xv[j][6], xv[j][7]};
        }
        if (LAYER == 0) {
            const float rstd = 1.f / sqrtf(wave_sum(ss) * (1.f / 2048.f) + EPS);
            const float* mv = modv + (size_t)(5 + bidx_of_row(row)) * 12288; const float* nw = ARG(24);
#pragma unroll
            for (int j = 0; j < 4; ++j) { const int c0 = j * 512 + lane * 8; float o[8];
#pragma unroll
                for (int e = 0; e < 8; ++e) o[e] = xv[j][e] * rstd * nw[c0 + e] * (1.f + mv[2048 + c0 + e]) + mv[c0 + e];
                *(v4u*)(H + (size_t)row * DM + c0) = pack8(o); }
        }
    }
}

__device__ __forceinline__ void phase_qkprep1(Frame& F, const Args& A) {
    const bf16* QKV = (const bf16*)(F.ws + WS_QKV * MiB); bf16* Qo = (bf16*)(F.ws + WS_Q * MiB); bf16* Ko = (bf16*)(F.ws + WS_K * MiB); bf16* Vo = (bf16*)(F.ws + WS_V * MiB);
    const int gw = F.bid * NWAVES + F.wave, NGW = F.G * NWAVES, lane = F.lane;
    const int j16 = lane & 15;
    for (int row = gw; row < TT; row += NGW) {
        const bool lat = row < TL; int b, t, key;
        if (lat) { b = row >> 11; t = row & 2047; key = t; } else { const int rr = row - TL; b = rr >> 8; t = rr & 255; key = SEQ + t; }
        const float prow = (float)(t >> 6), pcol = (float)(t & 63);
#pragma unroll 1
        for (int p = (lat ? 0 : 4); p < 8; ++p) {
            const int isk = p >> 2, c0 = (p & 3) * 512 + lane * 8; const int hs = (p & 3) * 4 + (lane >> 4), h = hs >> 1, s = hs & 1;
            const v4u xw = *(const v4u*)(QKV + (size_t)row * N1 + isk * 2048 + c0); float x[8]; unpack8(xw, x);
            float ss = 0.f;
#pragma unroll
            for (int e = 0; e < 8; ++e) ss += x[e] * x[e];
            ss += __shfl_xor(ss, 1); ss += __shfl_xor(ss, 2); ss += __shfl_xor(ss, 4); ss += __shfl_xor(ss, 8);
            const float rstd = 1.f / sqrtf(ss * (1.f / 128.f) + EPS);
            const float* nw = ARG(isk ? 28 : 27) + j16 * 8;
#pragma unroll
            for (int e = 0; e < 8; ++e) x[e] = x[e] * rstd * nw[e];
            if (lat) {
                const float pos = (j16 & 8) ? pcol : prow; const bool second = (j16 & 4) != 0;
#pragma unroll
                for (int e = 0; e < 8; ++e) { const float other = __shfl_xor(x[e], 4); const int fi = 8 * (j16 & 3) + e;
                    const float inv_freq = __expf(-(float)fi * (9.210340371976184f / 32.f)); const float ang = pos * inv_freq; const float cs = __cosf(ang), sn = __sinf(ang);
                    x[e] = second ? (x[e] * cs + other * sn) : (x[e] * cs - other * sn); }
            }
            bf16* dst = isk ? Ko + ((size_t)((b * 8 + h) * 2 + s) * 2304 + key) * 128 + j16 * 8 : Qo + ((size_t)((b * 8 + h) * 2 + s) * 2048 + t) * 128 + j16 * 8;
            *(v4u*)dst = pack8(x);
        }
#pragma unroll 1
        for (int p = 0; p < 4; ++p) { const int c0 = p * 512 + lane * 8, h = c0 >> 8, dv = c0 & 255;
            *(v4u*)(Vo + ((size_t)((b * 8 + h) * 2 + (dv >> 7)) * 2304 + key) * 128 + (dv & 127)) = *(const v4u*)(QKV + (size_t)row * N1 + 4096 + c0); }
    }
}
__device__ __forceinline__ void phase_attn1(Frame& F) {
    const att::bf16* Qo = (const att::bf16*)(F.ws + WS_Q * MiB); const att::bf16* Ko = (const att::bf16*)(F.ws + WS_K * MiB); const att::bf16* Vo = (const att::bf16*)(F.ws + WS_V * MiB);
    float* OA = (float*)(F.ws + WS_OATT * MiB);
#pragma unroll 1
    for (int i = 0; i < 4; ++i) {
        const int x = F.bid & 7, j = F.bid >> 3; const int unit = ((16 * x + 4 * i + (j >> 3)) * 8 + (j & 7)) & 1023;
        const int qb = unit & 7, grp = unit >> 3, vh = grp & 1, s = (grp >> 1) & 1, bh = grp >> 2;
        att::attn_dense_body<128, 128, 128, 128>(Qo + ((size_t)(bh * 2 + s) * 2048 + qb * 256) * 128, Ko + (size_t)(bh * 2 + s) * 2304 * 128, Vo + (size_t)(bh * 2 + vh) * 2304 * 128,
                                                OA + ((size_t)((s * 32 + bh) * 2 + vh) * 2048 + qb * 256) * 128, 2304, (char*)F.ldsg);
        __syncthreads();
    }
}
__device__ __forceinline__ void phase_attncomb1(Frame& F, const Args& A) {
    const float* OA = (const float*)(F.ws + WS_OATT * MiB); bf16* Y = (bf16*)(F.ws + WS_Y * MiB);
    const int gw = F.bid * NWAVES + F.wave, NGW = F.G * NWAVES, lane = F.lane;
    const float* lam = ARG(29);
    const float s01 = wave_sum(lam[lane] * lam[128 + lane] + lam[64 + lane] * lam[192 + lane]);
    const float s23 = wave_sum(lam[256 + lane] * lam[384 + lane] + lam[320 + lane] * lam[448 + lane]);
    const float lmbda = expf(s01) - expf(s23) + LAM_INIT;
    const f32x4 sn = *(const f32x4*)(ARG(30) + lane * 4);
    for (int row = gw; row < TL; row += NGW) { const int b = row >> 11, t = row & 2047;
#pragma unroll 1
        for (int h = 0; h < 8; ++h) {
            const size_t oo = ((size_t)((b * 8 + h) * 2 + (lane >> 5)) * 2048 + t) * 128 + (lane & 31) * 4;
            const f32x4 o0 = *(const f32x4*)(OA + oo), o1 = *(const f32x4*)(OA + (size_t)64 * 2048 * 128 + oo);
            const f32x4 o = o0 - o1 * lmbda;
            const float ss = wave_sum((o.x * o.x + o.y * o.y) + (o.z * o.z + o.w * o.w));
            const float rstd = 1.f / sqrtf(ss * (1.f / 256.f) + EPS) * (1.f - LAM_INIT);
            uint2 w; w.x = pk2(o.x * rstd * sn.x, o.y * rstd * sn.y); w.y = pk2(o.z * rstd * sn.z, o.w * rstd * sn.w);
            *(uint2*)(Y + (size_t)row * DM + h * 256 + lane * 4) = w;
        }
    }
}

#ifndef PHM
#define PHM 0xffffffffu
#endif
__global__ void __launch_bounds__(NWAVES * 64, 2) mega_fwd(Args args) {
    extern __shared__ __attribute__((aligned(16))) unsigned char lds[];
    Frame F;
    F.lds = (LAS unsigned char*)lds; F.ldsg = lds;
    F.tid = threadIdx.x; F.lane = F.tid & 63; F.wave = __builtin_amdgcn_readfirstlane(F.tid >> 6);
    F.G = gridDim.x; F.bid = blockIdx.x; F.ws = args.ws; F.ctl = (gu32*)(args.ws + WS_CTL);
    for (int u = F.tid; u < (LDS_BYTES - LDSCTL_OFF) / 4; u += NWAVES * 64) ((LAS unsigned*)(F.lds + LDSCTL_OFF))[u] = 0u;
    __syncthreads();
    XcdBarrier bar = xcd_barrier_post((unsigned*)(F.ctl + CW_BAR), (volatile LAS unsigned*)(F.lds + L_MISC));
    unsigned char* ws = args.ws;
#define GRID_BAR() do { xcd_barrier(bar); int t_ = threadIdx.x; asm volatile("" : "+v"(t_)); F.tid = t_; F.lane = t_ & 63; F.wave = __builtin_amdgcn_readfirstlane(t_ >> 6); } while (0)

#if (PHM >> 0) & 1
    phase_mod(F, args);
    __syncthreads();
    phase_convert(F, args);
#endif
    GRID_BAR();
#if (PHM >> 1) & 1
    phase_norm0(F, args);
#endif
    GRID_BAR();
#if (PHM >> 2) & 1
    { pg8::Gemm g{(const bf16*)(ws + WS_H * MiB), (const bf16*)(ws + WS_WIN0 * MiB), TT, N0P, 2048}; pg8::StaticOrder S; S.init(TT, N0P, F.G, F.bid);
      EpiProj0 E{(bf16*)(ws + WS_PROJ0 * MiB)};
      pg8::gemm_phase<EpiProj0, pg8::StaticOrder, true, true>(F.lds, g, S, E); }
#endif
    GRID_BAR();
#if (PHM >> 3) & 1
    phase_prep0(F, args);
#endif
    GRID_BAR();
#if (PHM >> 4) & 1
    phase_scan0(F, args);
#endif
    GRID_BAR();
#if (PHM >> 5) & 1
    phase_outnorm0(F, args);
#endif
    GRID_BAR();
#if (PHM >> 6) & 1
    { pg8::Gemm g{(const bf16*)(ws + WS_Y * MiB), (const bf16*)(ws + WS_WOUT0 * MiB), TT, 2048, 2048}; pg8::StaticOrder S; S.init(TT, 2048, F.G, F.bid);
      EpiResid E{ARG(0), ARG(2), (float*)(ws + WS_XR * MiB), (const float*)(ws + WS_MODV * MiB) + 4096};
      pg8::gemm_phase<EpiResid, pg8::StaticOrder, true, true>(F.lds, g, S, E); }
#endif
    GRID_BAR();
#if (PHM >> 7) & 1
    phase_route<0>(F, args);
#endif
    GRID_BAR();
#if (PHM >> 8) & 1
    phase_gather<0>(F);
#endif
    GRID_BAR();
#if (PHM >> 9) & 1
    phase_moe_gemm1<0>(F);
#endif
    GRID_BAR();
#if (PHM >> 10) & 1
    phase_moe_gemm2<0>(F);
#endif
    GRID_BAR();
#if (PHM >> 11) & 1
    phase_combine<0>(F, args);
#endif
    GRID_BAR();
#if (PHM >> 12) & 1
    { pg8::Gemm g{(const bf16*)(ws + WS_H * MiB), (const bf16*)(ws + WS_WIN1 * MiB), TT, N1, 2048}; pg8::StaticOrder S; S.init(TT, N1, F.G, F.bid);
      pg8::EpiBf16<0> E{(bf16*)(ws + WS_QKV * MiB), N1, nullptr, 0, 0, 1.f};
      pg8::gemm_phase<pg8::EpiBf16<0>, pg8::StaticOrder, true, true>(F.lds, g, S, E); }
#endif
    GRID_BAR();
#if (PHM >> 13) & 1
    phase_qkprep1(F, args);
#endif
    GRID_BAR();
#if (PHM >> 14) & 1
    phase_attn1(F);
#endif
    GRID_BAR();
#if (PHM >> 15) & 1
    phase_attncomb1(F, args);
#endif
    GRID_BAR();
#if (PHM >> 16) & 1
    { pg8::Gemm g{(const bf16*)(ws + WS_Y * MiB), (const bf16*)(ws + WS_WOUT1 * MiB), TL, 2048, 2048}; pg8::StaticOrder S; S.init(TL, 2048, F.G, F.bid);
      EpiResid E{(const float*)(ws + WS_XR * MiB), (const float*)(ws + WS_XR * MiB) + (size_t)TL * DM, (float*)(ws + WS_XR * MiB), (const float*)(ws + WS_MODV * MiB) + (size_t)5 * 12288 + 4096};
      pg8::gemm_phase<EpiResid, pg8::StaticOrder, true, true>(F.lds, g, S, E); }
#endif
    GRID_BAR();
#if (PHM >> 17) & 1
    phase_route<1>(F, args);
#endif
    GRID_BAR();
#if (PHM >> 18) & 1
    phase_gather<1>(F);
#endif
    GRID_BAR();
#if (PHM >> 19) & 1
    phase_moe_gemm1<1>(F);
#endif
    GRID_BAR();
#if (PHM >> 20) & 1
    phase_moe_gemm2<1>(F);
#endif
    GRID_BAR();
#if (PHM >> 21) & 1
    phase_combine<1>(F, args);

#endif
#undef GRID_BAR
}

extern "C" void kernel_launch(void* const* d_in, const int* in_sizes, int n_in, void* d_out, int out_size, void* d_ws, size_t ws_size, hipStream_t stream) {
    static int grid = 0;
    if (grid == 0) {
        if (n_in != 38 || out_size != TL * DM || ws_size < WS_END * MiB) { fprintf(stderr, "kernel_launch: shape mismatch n_in %d out %d ws %zu\n", n_in, out_size, ws_size); grid = -1; return; }
        int dev = 0, cus = 0, per_cu = 0;
        if (hipGetDevice(&dev) != hipSuccess || hipDeviceGetAttribute(&cus, hipDeviceAttributeMultiprocessorCount, dev) != hipSuccess) { grid = -1; return; }
        if (hipFuncSetAttribute((const void*)mega_fwd, hipFuncAttributeMaxDynamicSharedMemorySize, LDS_BYTES) != hipSuccess) { fprintf(stderr, "kernel_launch: hipFuncSetAttribute failed\n"); grid = -1; return; }
        if (hipOccupancyMaxActiveBlocksPerMultiprocessor(&per_cu, (const void*)mega_fwd, NWAVES * 64, LDS_BYTES) != hipSuccess || per_cu < 1)
            fprintf(stderr, "kernel_launch: occupancy query reports %d workgroups per CU\n", per_cu);
        (void)hipGetLastError();
        grid = cus;
    }
    if (grid < 0) return;
    if (hipMemsetAsync((char*)d_ws + WS_CTL, 0, CTL_ZERO_BYTES, stream) != hipSuccess) return;
    Args a{};
    for (int i = 0; i < 38; ++i) a.in[i] = (const float*)d_in[i];
    a.out = (float*)d_out; a.ws = (unsigned char*)d_ws;
    hipLaunchKernelGGL(mega_fwd, dim3(grid), dim3(NWAVES * 64), LDS_BYTES, stream, a);
}
```

```cpp
#define Y8MASK 3
#include <hip/hip_bf16.h>
#include <hip/hip_runtime.h>
#include <cstdio>
#include <cstdint>
namespace pg8 {
#define PG8_LAS __attribute__((address_space(3)))
typedef unsigned short bf16_t;
typedef short bf16x8 __attribute__((ext_vector_type(8)));
typedef float f32x4 __attribute__((ext_vector_type(4)));
typedef unsigned u32x4 __attribute__((ext_vector_type(4)));
constexpr int BM = 256, BK = 64, HALF = 128, HTB = HALF * BK * 2  , STAGE_BYTES = 8 * HTB, NXCD = 8, WGM = 8;

__host__ __device__ __forceinline__ int lds_byte(int r, int c) { const int st = (r >> 4) * 2 + (c >> 5), rr = r & 15, cc = c & 31, ob = rr * 64 + cc * 2; return st * 1024 + (ob ^ (((ob >> 9) & 1) << 5)); }
__host__ __device__ __forceinline__ void stage_rc(int b, int& R, int& C) { const int st = b / 1024, sb = b % 1024, swz = sb ^ (((sb >> 9) & 1) << 5); R = (st >> 1) * 16 + swz / 64; C = (st & 1) * 32 + (swz % 64) / 2; }
__host__ __device__ __forceinline__ int perm32(int rho) { const int n = rho >> 4, i = rho & 15; return 8 * (i >> 2) + 4 * n + (i & 3); }

struct Unit { int pm, pn, half; };
struct Gemm { const bf16_t* A; const bf16_t* Bt; int M, N, K; };

struct StaticOrder {
    int nM, nN, nwg, G, c;
    __host__ __device__ void init(int M, int N, int G_, int c_) { nM = M / BM; nN = N / BM; nwg = nM * nN; G = G_; c = c_; }
    __host__ __device__ bool next(int i, Unit& u) const {
        const long L = (long)i * G + c; if (L >= nwg) return false;
        int wgid = (int)L; { const int q = nwg / NXCD, r = nwg % NXCD, xcd = wgid % NXCD, off = wgid / NXCD; wgid = (xcd < r ? xcd * (q + 1) : r * (q + 1) + (xcd - r) * q) + off; }
        const int nig = WGM * nN, gid = wgid / nig, fm = gid * WGM, gsz = (nM - fm) < WGM ? (nM - fm) : WGM;
        u.pm = fm + ((wgid % nig) % gsz); u.pn = (wgid % nig) / gsz; u.half = 0; return true;
    }
    __device__ __forceinline__ void a_ready(const Unit&) const {}
    __device__ __forceinline__ void done(const Unit&) const {}
};

__device__ __forceinline__ unsigned cvt_pk_bf16(float lo, float hi) { unsigned r; asm volatile("v_cvt_pk_bf16_f32 %0, %1, %2" : "=v"(r) : "v"(lo), "v"(hi)); return r; }
typedef float f32x2 __attribute__((ext_vector_type(2)));
__device__ __forceinline__ f32x2 gelu_pk(f32x2 v) {
    const f32x2 av = __builtin_elementwise_abs(v), d = av * 0.2316418882f + 1.0f;
    f32x2 t; t.x = __builtin_amdgcn_rcpf(d.x); t.y = __builtin_amdgcn_rcpf(d.y);
    f32x2 q = t * 0.5307027145f + (-0.7265760135f); q = q * t + 0.7107068705f; q = q * t + (-0.142248368f); q = q * t + 0.127414796f; q = q * t;
    const f32x2 s = (v * v) * (-0.72134752044f);
    f32x2 e; e.x = __builtin_amdgcn_exp2f(s.x); e.y = __builtin_amdgcn_exp2f(s.y);
    const f32x2 m = v * (q * e), r = v - m;
    f32x2 o; o.x = v.x < 0.f ? m.x : r.x; o.y = v.y < 0.f ? m.y : r.y; return o;
}

template <int ACT  > struct EpiBf16 {
    static constexpr bool PERM = true, AFTER_DRAIN = false; static_assert(ACT == 0 || ACT == 1, "EpiBf16: ACT is 0 (none) or 1 (gelu_pk)");
    bf16_t* O; int ldc; const float* bias; int split_cols; size_t split_stride; float scale0;
    __device__ __forceinline__ void operator()(const f32x4 (&acc)[2][2][4][2], const Unit& u, int wr, int wc, int fr, int fq) const {
        const int row0 = u.pm * BM + wr * 64 + fr; int colt = u.pn * BM; bf16_t* base = O;
        float sc = 1.f; if (split_cols) { const int t = colt / split_cols; base += (size_t)t * split_stride; colt -= t * split_cols; if (t == 0) sc = scale0; }
        const int col0 = colt + wc * 32 + 8 * fq, bcol0 = u.pn * BM + wc * 32 + 8 * fq;
        f32x4 bv[2][2];
#pragma unroll
        for (int bj = 0; bj < 2; ++bj)
#pragma unroll
            for (int n = 0; n < 2; ++n) bv[bj][n] = bias ? *(const f32x4*)(bias + bcol0 + bj * HALF + 4 * n) : (f32x4){0.f, 0.f, 0.f, 0.f};
#pragma unroll
        for (int ai = 0; ai < 2; ++ai)
#pragma unroll
            for (int m = 0; m < 4; ++m) { bf16_t* rowp = base + (size_t)(row0 + ai * HALF + m * 16) * ldc + col0;
#pragma unroll
                for (int bj = 0; bj < 2; ++bj) { f32x4 v0 = acc[ai][bj][m][0] + bv[bj][0], v1 = acc[ai][bj][m][1] + bv[bj][1];
                    if (ACT == 1) { f32x2 a = gelu_pk((f32x2){v0[0], v0[1]}), b = gelu_pk((f32x2){v0[2], v0[3]}), c = gelu_pk((f32x2){v1[0], v1[1]}), d = gelu_pk((f32x2){v1[2], v1[3]});
                        v0 = (f32x4){a.x, a.y, b.x, b.y}; v1 = (f32x4){c.x, c.y, d.x, d.y}; }
                    v0 = v0 * sc; v1 = v1 * sc; u32x4 w; w.x = cvt_pk_bf16(v0[0], v0[1]); w.y = cvt_pk_bf16(v0[2], v0[3]); w.z = cvt_pk_bf16(v1[0], v1[1]); w.w = cvt_pk_bf16(v1[2], v1[3]);
                    *(u32x4*)(rowp + bj * HALF) = w; } }
    }
};

struct ADirect { static constexpr bool GATHER = false; __device__ __forceinline__ unsigned rowoff(int, int) const { return 0u; } };
template <class Epi, class Sched, bool ALIGN_EPI = false, bool SP2 = false, class AMap = ADirect>
__device__ __forceinline__ void gemm_phase(PG8_LAS unsigned char* lds, const Gemm g, const Sched& S, const Epi& E, const AMap& AM = AMap()) {
    static_assert(!AMap::GATHER || SP2, "gathered A rows: SP2 loop only");
    int tid_l = threadIdx.x; asm volatile("" : "+v"(tid_l));
    const int tid = tid_l, wid = __builtin_amdgcn_readfirstlane(tid >> 6), lane = tid & 63, wr = wid >> 2, wc = wid & 3, fr = lane & 15, fq = lane >> 4;
    const int K = g.K, nt = K / BK;
    unsigned voffA[2], voffB[2]; int gR[2]; unsigned gC2[2];
#pragma unroll
    for (int i = 0; i < 2; ++i) { int R, C; stage_rc(tid * 16 + i * 8192, R, C); const int Rb = Epi::PERM ? ((R & ~31) + perm32(R & 31)) : R;
        voffA[i] = (unsigned)(R * K + C) * 2u; voffB[i] = (unsigned)(Rb * K + C) * 2u; gR[i] = R; gC2[i] = (unsigned)C * 2u; }
    unsigned vc[2][2], vn[2][2];
    const size_t kstep = (size_t)(BK * 2);
    const size_t hstep = (size_t)HALF * K * 2;
    const size_t tstep = 2 * hstep;
    const unsigned ldsw = (unsigned)wid * 1024u;
    const int aoff = lds_byte(wr * 64 + fr, fq * 8), boff = lds_byte(wc * 32 + fr, fq * 8);
#define PG8_SA(b, h) (((b) * 2 + (h)) * HTB)
#define PG8_SB(b, h) ((4 + (b) * 2 + (h)) * HTB)
#define PG8_STAGE(bufoff, gbase, voff) do { _Pragma("unroll") for (int _i = 0; _i < 2; ++_i) \
        __builtin_amdgcn_global_load_lds((const unsigned*)((const char*)(gbase) + (voff)[_i]), (PG8_LAS unsigned*)(lds + (bufoff) + ldsw + _i * 8192), 16, 0, 0); } while (0)
#define PG8_GOFF(dst, pm_) do { _Pragma("unroll") for (int _h = 0; _h < 2; ++_h) _Pragma("unroll") for (int _i = 0; _i < 2; ++_i) dst[_h][_i] = AM.rowoff((pm_), _h * HALF + gR[_i]) + gC2[_i]; } while (0)
#define PG8_STAGE_A(b, h, gptr, NX) do { if constexpr (AMap::GATHER) { unsigned v_[2]; v_[0] = (NX) ? vn[h][0] : vc[h][0]; v_[1] = (NX) ? vn[h][1] : vc[h][1]; PG8_STAGE(PG8_SA(b, h), gptr, v_); } \
        else { PG8_STAGE(PG8_SA(b, h), (gptr) + (h) * hstep, voffA); } } while (0)
#define PG8_LDA(dst, b, h) do { _Pragma("unroll") for (int m = 0; m < 4; ++m) _Pragma("unroll") for (int k = 0; k < 2; ++k) dst[m][k] = *(const PG8_LAS bf16x8*)(lds + PG8_SA(b, h) + aoff + m * 2048 + k * 1024); } while (0)
#define PG8_LDB(dst, b, h) do { _Pragma("unroll") for (int n = 0; n < 2; ++n) _Pragma("unroll") for (int k = 0; k < 2; ++k) dst[n][k] = *(const PG8_LAS bf16x8*)(lds + PG8_SB(b, h) + boff + n * 2048 + k * 1024); } while (0)
#define PG8_MMA(ai, bj, At, Bt) do { __builtin_amdgcn_s_setprio(1); _Pragma("unroll") for (int m = 0; m < 4; ++m) _Pragma("unroll") for (int n = 0; n < 2; ++n) _Pragma("unroll") for (int k = 0; k < 2; ++k) \
        acc[ai][bj][m][n] = __builtin_amdgcn_mfma_f32_16x16x32_bf16(Bt[n][k], At[m][k], acc[ai][bj][m][n], 0, 0, 0); __builtin_amdgcn_s_setprio(0); } while (0)
#define PG8_WAIT_V(n) asm volatile("s_waitcnt vmcnt(" #n ")" ::: "memory")
#define PG8_WAIT_L(n) asm volatile("s_waitcnt lgkmcnt(" #n ")" ::: "memory")
#define PG8_BAR __builtin_amdgcn_s_barrier()
#define PG8_SCHED __builtin_amdgcn_sched_barrier(0)
    Unit cur, nxt; int ui = 0;
    if (!S.next(0, cur)) return;
    f32x4 acc[2][2][4][2];
#pragma unroll
    for (int a = 0; a < 2; ++a)
#pragma unroll
        for (int b = 0; b < 2; ++b)
#pragma unroll
            for (int m = 0; m < 4; ++m)
#pragma unroll
                for (int n = 0; n < 2; ++n) acc[a][b][m][n] = (f32x4){0.f, 0.f, 0.f, 0.f};
    bf16x8 At[4][2], B0[2][2], B1[2][2];
    const char* cA = (const char*)g.A + (AMap::GATHER ? (size_t)0 : (size_t)cur.pm * tstep); const char* cB = (const char*)g.Bt + (size_t)cur.pn * tstep;
    if constexpr (AMap::GATHER) { PG8_GOFF(vc, cur.pm); }
    S.a_ready(cur);
    if constexpr (SP2) {
        PG8_STAGE(PG8_SB(0, 0), cB, voffB); PG8_STAGE(PG8_SB(0, 1), cB + hstep, voffB); PG8_STAGE_A(0, 0, cA, false); PG8_STAGE_A(0, 1, cA, false);
        if (wr == 1) PG8_BAR;
        PG8_WAIT_V(2); PG8_BAR;
        PG8_STAGE(PG8_SB(1, 0), cB + kstep, voffB); PG8_STAGE_A(1, 0, cA + kstep, false); PG8_STAGE(PG8_SB(1, 1), cB + hstep + kstep, voffB);
        PG8_WAIT_V(6); PG8_BAR;
    } else {
        PG8_STAGE(PG8_SB(0, 0), cB, voffB); PG8_STAGE(PG8_SA(0, 0), cA, voffA); PG8_STAGE(PG8_SB(0, 1), cB + hstep, voffB); PG8_STAGE(PG8_SA(0, 1), cA + hstep, voffA);
        if (wr == 1) PG8_BAR;
        PG8_WAIT_V(4); PG8_BAR;
        PG8_STAGE(PG8_SB(1, 0), cB + kstep, voffB); PG8_STAGE(PG8_SA(1, 0), cA + kstep, voffA); PG8_STAGE(PG8_SB(1, 1), cB + hstep + kstep, voffB);
        PG8_WAIT_V(6); PG8_BAR;
    }
    for (;;) {
        const bool has_next = S.next(ui + 1, nxt);
        const char* nA = (has_next && !AMap::GATHER) ? (const char*)g.A + (size_t)nxt.pm * tstep : cA; const char* nB = has_next ? (const char*)g.Bt + (size_t)nxt.pn * tstep : cB;
        if constexpr (AMap::GATHER) { if (has_next) { PG8_GOFF(vn, nxt.pm); } else { vn[0][0] = vc[0][0]; vn[0][1] = vc[0][1]; vn[1][0] = vc[1][0]; vn[1][1] = vc[1][1]; } }
        for (int t = 0; t < nt; t += 2) {
            const bool last = (t == nt - 2);
            const char* a1 = cA + (size_t)(t + 1) * kstep;
            const char* a2 = last ? nA : cA + (size_t)(t + 2) * kstep; const char* b2 = last ? nB : cB + (size_t)(t + 2) * kstep;
            const char* a3 = a2 + kstep; const char* b3 = b2 + kstep;
            if (last && has_next) S.a_ready(nxt);
            if constexpr (SP2) {
            PG8_LDB(B0, 0, 0); PG8_LDB(B1, 0, 1); PG8_SCHED; PG8_LDA(At, 0, 0); PG8_STAGE_A(1, 1, a1, false);
            PG8_WAIT_V(8); PG8_WAIT_L(0); PG8_BAR; PG8_MMA(0, 0, At, B0); PG8_MMA(0, 1, At, B1); PG8_BAR; PG8_SCHED;
            PG8_LDA(At, 0, 1); PG8_STAGE(PG8_SB(0, 0), b2, voffB); PG8_STAGE(PG8_SB(0, 1), b2 + hstep, voffB); PG8_STAGE_A(0, 0, a2, last);
            PG8_WAIT_V(8); PG8_WAIT_L(0); PG8_BAR; if (!cur.half) { PG8_MMA(1, 0, At, B0); PG8_MMA(1, 1, At, B1); } PG8_BAR; PG8_SCHED;
            PG8_LDB(B0, 1, 0); PG8_LDB(B1, 1, 1); PG8_SCHED; PG8_LDA(At, 1, 0); PG8_STAGE_A(0, 1, a2, last);
            PG8_WAIT_V(8); PG8_WAIT_L(0); PG8_BAR; PG8_MMA(0, 0, At, B0); PG8_MMA(0, 1, At, B1); PG8_BAR; PG8_SCHED;
            PG8_LDA(At, 1, 1); PG8_STAGE(PG8_SB(1, 0), b3, voffB); PG8_STAGE(PG8_SB(1, 1), b3 + hstep, voffB); PG8_STAGE_A(1, 0, a3, last);
            PG8_WAIT_V(8); PG8_WAIT_L(0); PG8_BAR; if (!cur.half) { PG8_MMA(1, 0, At, B0); PG8_MMA(1, 1, At, B1); } PG8_BAR; PG8_SCHED;
            } else {
            PG8_LDB(B0, 0, 0); PG8_SCHED; PG8_LDA(At, 0, 0); PG8_STAGE(PG8_SA(1, 1), a1 + hstep, voffA);
            PG8_WAIT_L(8); PG8_BAR; PG8_WAIT_L(0); PG8_MMA(0, 0, At, B0); PG8_BAR; PG8_SCHED;
            PG8_LDB(B1, 0, 1); PG8_STAGE(PG8_SB(0, 0), b2, voffB);
            PG8_BAR; PG8_WAIT_L(0); PG8_MMA(0, 1, At, B1); PG8_BAR;
            PG8_LDA(At, 0, 1); PG8_STAGE(PG8_SA(0, 0), a2, voffA);
            PG8_BAR; PG8_WAIT_L(0); PG8_MMA(1, 0, At, B0); PG8_BAR; PG8_SCHED;
            PG8_STAGE(PG8_SB(0, 1), b2 + hstep, voffB);
            PG8_WAIT_V(6); PG8_BAR; PG8_MMA(1, 1, At, B1); PG8_BAR;
            PG8_LDB(B0, 1, 0); PG8_SCHED; PG8_LDA(At, 1, 0); PG8_STAGE(PG8_SA(0, 1), a2 + hstep, voffA);
            PG8_WAIT_L(8); PG8_BAR; PG8_WAIT_L(0); PG8_MMA(0, 0, At, B0); PG8_BAR; PG8_SCHED;
            PG8_LDB(B1, 1, 1); PG8_STAGE(PG8_SB(1, 0), b3, voffB);
            PG8_BAR; PG8_WAIT_L(0); PG8_MMA(0, 1, At, B1); PG8_BAR;
            PG8_LDA(At, 1, 1); PG8_STAGE(PG8_SA(1, 0), a3, voffA);
            PG8_BAR; PG8_WAIT_L(0); PG8_MMA(1, 0, At, B0); PG8_BAR; PG8_SCHED;
            PG8_STAGE(PG8_SB(1, 1), b3 + hstep, voffB);
            PG8_WAIT_V(6); PG8_BAR; PG8_MMA(1, 1, At, B1); PG8_BAR;
            }
        }
        if constexpr (ALIGN_EPI) { if (wr == 0) PG8_BAR; }
        if constexpr (!Epi::AFTER_DRAIN) { E(acc, cur, wr, wc, fr, fq); S.done(cur); }
        if (!has_next) break;
#pragma unroll
        for (int a = 0; a < 2; ++a)
#pragma unroll
            for (int b = 0; b < 2; ++b)
#pragma unroll
                for (int m = 0; m < 4; ++m)
#pragma unroll
                    for (int n = 0; n < 2; ++n) acc[a][b][m][n] = (f32x4){0.f, 0.f, 0.f, 0.f};
        cur = nxt; cA = nA; cB = nB; ++ui;
        if constexpr (AMap::GATHER) { vc[0][0] = vn[0][0]; vc[0][1] = vn[0][1]; vc[1][0] = vn[1][0]; vc[1][1] = vn[1][1]; }
        if constexpr (ALIGN_EPI) { if (wr == 1) PG8_BAR; }
    }
    PG8_WAIT_V(0);
    if constexpr (!ALIGN_EPI) { if (wr == 0) PG8_BAR; }
    PG8_BAR;
    if constexpr (Epi::AFTER_DRAIN) { E.fused(acc, cur, wr, wc, fr, fq, lds, wid, lane); S.done(cur); }
#undef PG8_SA
#undef PG8_SB
#undef PG8_STAGE
#undef PG8_LDA
#undef PG8_GOFF
#undef PG8_STAGE_A
#undef PG8_LDB
#undef PG8_MMA
#undef PG8_WAIT_V
#undef PG8_WAIT_L
#undef PG8_BAR
#undef PG8_SCHED
}
}
#define GAS __attribute__((address_space(1)))
#define LAS __attribute__((address_space(3)))
typedef unsigned short bf16;
typedef unsigned v4u __attribute__((ext_vector_type(4)));
typedef float f32x4 __attribute__((ext_vector_type(4)));
typedef short bf16x8 __attribute__((ext_vector_type(8)));
typedef GAS unsigned gu32;
typedef GAS unsigned long long gu64;
#define RLX_AGENT __ATOMIC_RELAXED, __HIP_MEMORY_SCOPE_AGENT
#define LDS_WAIT() asm volatile("s_waitcnt lgkmcnt(0)" ::: "memory")
#define VM_WAIT() asm volatile("s_waitcnt vmcnt(0)" ::: "memory")
__device__ __forceinline__ unsigned long long rt() { return __builtin_amdgcn_s_memrealtime(); }
__device__ __forceinline__ unsigned f2bf(float f) { unsigned u = __builtin_bit_cast(unsigned, f); return (u + 0x7fffu + ((u >> 16) & 1u)) >> 16; }
__device__ __forceinline__ unsigned pk2(float lo, float hi) { return f2bf(lo) | (f2bf(hi) << 16); }

#define XB_TMO      128
#define XB_XCNT(j)  (256  + 64 * (j))
#define XB_XSUB(j)  (1280 + 64 * (j))
#define XB_XGEN(j)  (2304 + 64 * (j))
#define XB_TOP      3328
#define XB_TOPGEN   3392
#define XCD_BAR_WORDS 3456
#define XB_SPIN_CAP (1u << 18)

__device__ __forceinline__ unsigned xb_ld(unsigned* p)              { return __hip_atomic_load(p, __ATOMIC_RELAXED, __HIP_MEMORY_SCOPE_AGENT); }
__device__ __forceinline__ unsigned xb_add(unsigned* p, unsigned v) { return __hip_atomic_fetch_add(p, v, __ATOMIC_RELAXED, __HIP_MEMORY_SCOPE_AGENT); }
__device__ __forceinline__ unsigned xb_xcc_id() { return (unsigned)__builtin_amdgcn_s_getreg((3 << 11) | 20) & 0xFu; }
#define XB_SPIN(cond, bar) do { unsigned _sp = 0; while (cond) { __builtin_amdgcn_s_sleep(1); \
    if ((++_sp & 255u) == 0u) { if (xb_ld(&(bar)[XB_TMO])) break; if (_sp > XB_SPIN_CAP) { atomicAdd(&(bar)[XB_TMO], 1u); break; } } } } while (0)

struct XcdBarrier {
    unsigned* bar; unsigned x;
    volatile LAS unsigned* st;
};

__device__ __forceinline__ XcdBarrier xcd_barrier_post(unsigned* bar, volatile LAS unsigned* st) {
    XcdBarrier b; b.bar = bar; b.x = xb_xcc_id(); b.st = st;
    if (threadIdx.x == 0) (void)xb_add(&bar[XB_XCNT(b.x)], 1u);
    return b;
}
__device__ __forceinline__ void xcd_barrier_complete(unsigned* bar, unsigned x, unsigned& nloc, unsigned& nx) {
    const unsigned G = gridDim.x * gridDim.y * gridDim.z;
    unsigned sum, cnt, mine, sp = 0u;
    for (;;) {
        sum = 0u; cnt = 0u; mine = 0u;
#pragma unroll
        for (unsigned j = 0; j < 16; ++j) { const unsigned c = xb_ld(&bar[XB_XCNT(j)]); sum += c; cnt += (c > 0u) ? 1u : 0u; mine = (j == x) ? c : mine; }
        if (sum == G) break;
        __builtin_amdgcn_s_sleep(1);
        if ((++sp & 255u) == 0u) { if (xb_ld(&bar[XB_TMO])) break; if (sp > XB_SPIN_CAP) { atomicAdd(&bar[XB_TMO], 1u); break; } }
    }
    nloc = mine > 0u ? mine : 1u; nx = cnt > 0u ? cnt : 1u;
}

__device__ __forceinline__ void xcd_barrier(const XcdBarrier& b) {
    asm volatile("s_waitcnt vmcnt(0)" ::: "memory");
    __syncthreads();
    if (threadIdx.x == 0) {
        unsigned* bar = b.bar;
        __builtin_amdgcn_s_waitcnt(0);
        unsigned nloc = b.st[0], nx = b.st[1];
        if (nloc == 0u) { xcd_barrier_complete(bar, b.x, nloc, nx); b.st[0] = nloc; b.st[1] = nx; }
        const unsigned old = xb_add(&bar[XB_XSUB(b.x)], 1u);
        const unsigned gen = old / nloc;
        if (old + 1u == (gen + 1u) * nloc) {
            __builtin_amdgcn_fence(__ATOMIC_RELEASE, "agent");
            asm volatile("s_waitcnt vmcnt(0)" ::: "memory");
            const unsigned og = xb_add(&bar[XB_TOP], 1u);
            const unsigned tg = og / nx;
            if (og + 1u == (tg + 1u) * nx) xb_add(&bar[XB_TOPGEN], 1u);
            else XB_SPIN(xb_ld(&bar[XB_TOPGEN]) == tg, bar);
            __builtin_amdgcn_fence(__ATOMIC_ACQUIRE, "agent");
            xb_add(&bar[XB_XGEN(b.x)], 1u);
            asm volatile("s_waitcnt vmcnt(0)" ::: "memory");
        } else {
            XB_SPIN(xb_ld(&bar[XB_XGEN(b.x)]) == gen, bar);
            __builtin_amdgcn_fence(__ATOMIC_ACQUIRE, "agent");
            asm volatile("s_waitcnt vmcnt(0)" ::: "memory");
        }
    }
    __syncthreads();
}
namespace att {
using bf16 = __hip_bfloat16;
constexpr int   D = 128, NW = 8, QBLK = 32, KVBLK = 64;
constexpr float SCALE = 0.088388347648318440f;
constexpr float THR = 8.f;
#ifndef ATT_SDEPTH
#define ATT_SDEPTH 1
#endif
constexpr int SDEPTH = ATT_SDEPTH;
constexpr size_t SHM_V = KVBLK * D * 2, SHM_K = KVBLK * D * 2, SHM_ATTN = 2 * SHM_V + 2 * SHM_K + NW * 64 * 4;
using bf16x8 = __attribute__((ext_vector_type(8))) short;
using s16x4  = __attribute__((ext_vector_type(4))) short;
using f32x16 = __attribute__((ext_vector_type(16))) float;
using u32x4  = __attribute__((ext_vector_type(4))) unsigned;
#define KSWZ(row, colB) ((row) * 256 + ((colB) ^ (((row) & 7) << 4)))
#define SBAR() __builtin_amdgcn_sched_barrier(0)
__device__ __forceinline__ int crow(int r, int hi) { return (r & 3) + 8 * (r >> 2) + 4 * hi; }
__device__ __forceinline__ unsigned cvtpk(float lo, float hi) {
  unsigned r; asm volatile("v_cvt_pk_bf16_f32 %0, %1, %2" : "=v"(r) : "v"(lo), "v"(hi)); return r;
}
__device__ __forceinline__ bf16x8 ld8(const bf16* p) { return *reinterpret_cast<const bf16x8*>(p); }
__device__ __forceinline__ void partialSM(f32x16& p0, f32x16& p1, float& m_reg, float& mn, float& alpha) {
  constexpr float C = SCALE * 1.4426950408889634f;
  float pmax = p0[0]; for (int r = 1; r < 16; ++r) pmax = fmaxf(pmax, p0[r]); for (int r = 0; r < 16; ++r) pmax = fmaxf(pmax, p1[r]);
  { auto rr = __builtin_amdgcn_permlane32_swap(__float_as_uint(pmax), __float_as_uint(pmax), false, false);
    pmax = fmaxf(__uint_as_float(rr[0]), __uint_as_float(rr[1])); }
  if (__builtin_expect(__all(pmax - m_reg <= THR / SCALE), 1)) { mn = m_reg; alpha = 1.f; }
  else { mn = fmaxf(m_reg, pmax); alpha = __builtin_amdgcn_exp2f((m_reg - mn) * C); m_reg = mn; }
  float mnC = -mn * C;
  for (int r = 0; r < 16; ++r) p0[r] = fmaf(p0[r], C, mnC); for (int r = 0; r < 16; ++r) p1[r] = fmaf(p1[r], C, mnC);
  for (int r = 0; r < 16; ++r) p0[r] = __builtin_amdgcn_exp2f(p0[r]);
}
__device__ __forceinline__ void finishSM(f32x16& p0, f32x16& p1, float alpha, float& l_reg, bf16x8& pa0, bf16x8& pa1, bf16x8& pa2, bf16x8& pa3) {
  for (int r = 0; r < 16; ++r) p1[r] = __builtin_amdgcn_exp2f(p1[r]);
  float ps = 0; for (int r = 0; r < 16; ++r) ps += p0[r]; for (int r = 0; r < 16; ++r) ps += p1[r];
  { auto rr = __builtin_amdgcn_permlane32_swap(__float_as_uint(ps), __float_as_uint(ps), false, false);
    ps = __uint_as_float(rr[0]) + __uint_as_float(rr[1]); }
  l_reg = l_reg * alpha + ps;
#define PK4(P, BASE, OUT) do { unsigned a0 = cvtpk(P[BASE + 0], P[BASE + 1]), a1 = cvtpk(P[BASE + 2], P[BASE + 3]);   \
    unsigned b0 = cvtpk(P[BASE + 4], P[BASE + 5]), b1 = cvtpk(P[BASE + 6], P[BASE + 7]);                              \
    auto r0 = __builtin_amdgcn_permlane32_swap(a0, b0, false, false); auto r1 = __builtin_amdgcn_permlane32_swap(a1, b1, false, false); \
    u32x4 w = {r0[0], r1[0], r0[1], r1[1]}; OUT = *reinterpret_cast<bf16x8*>(&w); } while (0)
  PK4(p0, 0, pa0); PK4(p0, 8, pa1); PK4(p1, 0, pa2); PK4(p1, 8, pa3);
#undef PK4
}
__device__ __forceinline__ void qkt(f32x16& p0, f32x16& p1, const bf16* Ks, const bf16x8* qr, int r32, int hi) {
  p0 = f32x16{}; p1 = f32x16{};
  for (int d0 = 0; d0 < 8; ++d0) { int cb = (d0 * 16 + hi * 8) * 2;
    bf16x8 b0 = *reinterpret_cast<const bf16x8*>((const char*)Ks + KSWZ(r32, cb));
    bf16x8 b1 = *reinterpret_cast<const bf16x8*>((const char*)Ks + KSWZ(32 + r32, cb));
    p0 = __builtin_amdgcn_mfma_f32_32x32x16_bf16(b0, qr[d0], p0, 0, 0, 0);
    p1 = __builtin_amdgcn_mfma_f32_32x32x16_bf16(b1, qr[d0], p1, 0, 0, 0); }
}
__device__ __forceinline__ int v_st(int k, int c) { const int kk = (k & ~0xC) | ((k & 4) << 1) | ((k & 8) >> 1); return ((kk >> 3) * 4 + (c >> 5)) * 512 + ((kk & 7) * 32 + (c & 31)) * 2; }
__device__ __forceinline__ int v_rd_base(int lane) { return ((lane & 3) << 3) | (((lane >> 2) & 3) << 6) | (((lane >> 4) & 1) << 5) | (((lane >> 5) & 1) << 8); }
constexpr int v_rd_off(int d0, int ks, int half) { return d0 * 512 + ks * 4096 + half * 2048; }
template <int OFF> __device__ __forceinline__ s16x4 tr_read(int vb) {
  s16x4 r; asm volatile("ds_read_b64_tr_b16 %0, %1 offset:%2" : "=&v"(r) : "v"(vb), "i"(OFF) : "memory"); return r;
}
template <int D0> __device__ __forceinline__ void pv_one(f32x16& od, int vb, bf16x8 pa0, bf16x8 pa1, bf16x8 pa2, bf16x8 pa3) {
  const s16x4 l0 = tr_read<v_rd_off(D0, 0, 0)>(vb), h0 = tr_read<v_rd_off(D0, 0, 1)>(vb), l1 = tr_read<v_rd_off(D0, 1, 0)>(vb), h1 = tr_read<v_rd_off(D0, 1, 1)>(vb);
  const s16x4 l2 = tr_read<v_rd_off(D0, 2, 0)>(vb), h2 = tr_read<v_rd_off(D0, 2, 1)>(vb), l3 = tr_read<v_rd_off(D0, 3, 0)>(vb), h3 = tr_read<v_rd_off(D0, 3, 1)>(vb);
  asm volatile("s_waitcnt lgkmcnt(0)" ::: "memory"); SBAR();
#define PK(L, H) (bf16x8){L[0], L[1], L[2], L[3], H[0], H[1], H[2], H[3]}
  od = __builtin_amdgcn_mfma_f32_32x32x16_bf16(pa0, PK(l0, h0), od, 0, 0, 0);
  od = __builtin_amdgcn_mfma_f32_32x32x16_bf16(pa1, PK(l1, h1), od, 0, 0, 0);
  od = __builtin_amdgcn_mfma_f32_32x32x16_bf16(pa2, PK(l2, h2), od, 0, 0, 0);
  od = __builtin_amdgcn_mfma_f32_32x32x16_bf16(pa3, PK(l3, h3), od, 0, 0, 0);
#undef PK
}
__device__ __forceinline__ void pv_d0(f32x16* o, int vb, bf16x8 pa0, bf16x8 pa1, bf16x8 pa2, bf16x8 pa3) {
  pv_one<0>(o[0], vb, pa0, pa1, pa2, pa3); pv_one<1>(o[1], vb, pa0, pa1, pa2, pa3); pv_one<2>(o[2], vb, pa0, pa1, pa2, pa3); pv_one<3>(o[3], vb, pa0, pa1, pa2, pa3);
}
template <int LDQ, int LDKK, int LDV, int LDO>
__device__ __forceinline__ void attn_dense_body(const bf16* __restrict__ Qb, const bf16* __restrict__ Kh, const bf16* __restrict__ Vh,
                                                bf16* __restrict__ Ob, int seq, char* lds) {
  const int tid = threadIdx.x, wid = tid >> 6, lane = tid & 63, r32 = lane & 31, hi = lane >> 5;
  bf16* V_lds = (bf16*)lds; bf16* K_lds = (bf16*)(lds + 2 * SHM_V);
  float* ws = (float*)(lds + 2 * SHM_V + 2 * SHM_K) + wid * 64; float* li_l = ws; float* al_l = ws + 32;
  float m_reg = -1e30f, l_reg = 0; f32x16 o[4] = {}; bf16x8 qr[8];
  const bf16* Qw = Qb + (long)(wid * QBLK + r32) * LDQ + hi * 8;
#pragma unroll
  for (int d0 = 0; d0 < 8; ++d0) qr[d0] = ld8(Qw + d0 * 16);
  const int sr = tid >> 4, sc = (tid & 15) * 8, vst0 = v_st(sr, sc), vst1 = v_st(32 + sr, sc);
  const int vb0 = (int)(uintptr_t)V_lds + v_rd_base(lane);
  struct { bf16x8 vs0, vs1, ks0, ks1; } sr_[SDEPTH];
#define SLOAD(i, k0) do { sr_[i].vs0 = ld8(&Vh[(long)((k0) + sr) * LDV + sc]); sr_[i].vs1 = ld8(&Vh[(long)((k0) + 32 + sr) * LDV + sc]); \
    sr_[i].ks0 = ld8(&Kh[(long)((k0) + sr) * LDKK + sc]); sr_[i].ks1 = ld8(&Kh[(long)((k0) + 32 + sr) * LDKK + sc]); } while (0)
#define SWRITE(b, i) do { *(bf16x8*)((char*)V_lds + (b) * SHM_V + vst0) = sr_[i].vs0;          \
    *(bf16x8*)((char*)V_lds + (b) * SHM_V + vst1) = sr_[i].vs1; int kc = sc * 2;               \
    *(bf16x8*)((char*)K_lds + (b) * SHM_K + KSWZ(sr, kc)) = sr_[i].ks0;                       \
    *(bf16x8*)((char*)K_lds + (b) * SHM_K + KSWZ(32 + sr, kc)) = sr_[i].ks1; } while (0)
#define SWAIT() do { if constexpr (SDEPTH == 2) asm volatile("s_waitcnt vmcnt(4)" ::: "memory"); else asm volatile("s_waitcnt vmcnt(0)" ::: "memory"); } while (0)
#define RESC(a) do { if (__any((a) < 1.f)) { if (hi == 0) al_l[r32] = (a); asm volatile("s_waitcnt lgkmcnt(0)" ::: "memory"); \
    for (int d = 0; d < 4; ++d) for (int r = 0; r < 16; ++r) o[d][r] *= al_l[crow(r, hi)]; } } while (0)
  f32x16 pA0, pA1, pB0, pB1; float mnA, mnB, alA, alB; bf16x8 pa0, pa1, pa2, pa3; const int NT = seq / KVBLK;
  constexpr int SE = 0, SO = SDEPTH - 1;
  SLOAD(SE, 0); asm volatile("s_waitcnt vmcnt(0)" ::: "memory"); SWRITE(0, SE); __syncthreads();
  qkt(pA0, pA1, K_lds, qr, r32, hi); partialSM(pA0, pA1, m_reg, mnA, alA);
  SLOAD(SO, KVBLK); if constexpr (SDEPTH == 2) { if (2 < NT) SLOAD(SE, 2 * KVBLK); }
  SWAIT(); SWRITE(1, SO); __syncthreads();
  for (int j = 1; j + 1 < NT; j += 2) {
    SBAR(); qkt(pB0, pB1, (bf16*)((char*)K_lds + SHM_K), qr, r32, hi);
    finishSM(pA0, pA1, alA, l_reg, pa0, pa1, pa2, pa3); SBAR();
    SLOAD(SO, (j + SDEPTH) * KVBLK); SBAR();
    pv_d0(o, vb0, pa0, pa1, pa2, pa3); partialSM(pB0, pB1, m_reg, mnB, alB);
    __syncthreads(); SWAIT(); SWRITE(0, SE);
    RESC(alB); __syncthreads();
    SBAR(); qkt(pA0, pA1, K_lds, qr, r32, hi);
    finishSM(pB0, pB1, alB, l_reg, pa0, pa1, pa2, pa3); SBAR();
    if (SDEPTH == 1 || j + 3 < NT) SLOAD(SE, (j + 1 + SDEPTH) * KVBLK); SBAR();
    pv_d0(o, vb0 + (int)SHM_V, pa0, pa1, pa2, pa3); partialSM(pA0, pA1, m_reg, mnA, alA);
    __syncthreads(); SWAIT(); SWRITE(1, SO);
    RESC(alA); __syncthreads();
  }
  SBAR(); qkt(pB0, pB1, (bf16*)((char*)K_lds + SHM_K), qr, r32, hi);
  finishSM(pA0, pA1, alA, l_reg, pa0, pa1, pa2, pa3); SBAR();
  pv_d0(o, vb0, pa0, pa1, pa2, pa3); partialSM(pB0, pB1, m_reg, mnB, alB);
  __syncthreads(); RESC(alB);
  finishSM(pB0, pB1, alB, l_reg, pa0, pa1, pa2, pa3); SBAR();
  pv_d0(o, vb0 + (int)SHM_V, pa0, pa1, pa2, pa3);
  if (hi == 0) li_l[r32] = l_reg; asm volatile("s_waitcnt lgkmcnt(0)" ::: "memory");
  float rli[16];
#pragma unroll
  for (int r = 0; r < 16; ++r) rli[r] = __builtin_amdgcn_rcpf(li_l[crow(r, hi)]);
  bf16* Ow = Ob + (long)(wid * QBLK) * LDO;
#pragma unroll
  for (int r = 0; r < 16; ++r) { int orow = crow(r, hi);
    for (int d0 = 0; d0 < 4; ++d0) Ow[(long)orow * LDO + d0 * 32 + r32] = __float2bfloat16(o[d0][r] * rli[r]); }
#undef SLOAD
#undef SWRITE
#undef SWAIT
#undef RESC
}

constexpr int PV_OFF = 0, PK_OFF = 65536, PP_OFF = 98304, PMX_OFF = 143360, PAL_OFF = 145408, PLI_OFF = 146432;
#define LBAR() asm volatile("s_waitcnt vmcnt(0) lgkmcnt(0)\n\ts_barrier" ::: "memory")
#define GAP() __builtin_amdgcn_sched_barrier(0)
struct VF { s16x4 l0, h0, l1, h1, l2, h2, l3, h3; };
__device__ __forceinline__ void attn_pair_body(const bf16* __restrict__ Qb, const bf16* __restrict__ Kh, const bf16* __restrict__ V0, const bf16* __restrict__ V1,
                                               bf16* __restrict__ O0, bf16* __restrict__ O1, int seq, __attribute__((address_space(3))) unsigned char* L) {
  typedef __attribute__((address_space(3))) unsigned char lds_u8; typedef __attribute__((address_space(3))) float lds_f32; typedef __attribute__((address_space(3))) bf16x8 lds_b8;
  constexpr float C = SCALE * 1.4426950408889634f;
  int tid = threadIdx.x; asm volatile("" : "+v"(tid));
  const int wid = __builtin_amdgcn_readfirstlane(tid >> 6), lane = tid & 63, r32 = lane & 31, hi = lane >> 5, pr = wid & 3, kh = wid >> 2;
  lds_f32* mxb = (lds_f32*)(L + PMX_OFF); lds_f32* al_l = (lds_f32*)(L + PAL_OFF) + wid * 32; lds_f32* li = (lds_f32*)(L + PLI_OFF);
  float m_reg = -1e30f, l_reg = 0.f; f32x16 o[4] = {}; bf16x8 qr[8];
  const bf16* Qw = Qb + (long)(pr * 32 + r32) * 128 + hi * 8;
#pragma unroll
  for (int d0 = 0; d0 < 8; ++d0) qr[d0] = ld8(Qw + d0 * 16);
  const int krow = kh * 32 + r32, kx = (krow & 7) << 4;
  const int ka0 = PK_OFF + krow * 256 + ((0 * 32 + hi * 16) ^ kx), ka1 = PK_OFF + krow * 256 + ((1 * 32 + hi * 16) ^ kx), ka2 = PK_OFF + krow * 256 + ((2 * 32 + hi * 16) ^ kx), ka3 = PK_OFF + krow * 256 + ((3 * 32 + hi * 16) ^ kx);
  const int vo = PV_OFF + kh * 16384 + v_rd_base(lane) + kh * 8192, vp = PV_OFF + kh * 16384 + v_rd_base(lane) + (1 - kh) * 8192;
  lds_u8* Pown = L + PP_OFF + (wid * 2) * 1024 + lane * 16; const lds_u8* Ppar = L + PP_OFF + ((wid ^ 4) * 2) * 1024 + lane * 16;
  typedef __attribute__((address_space(3))) unsigned lds_u32;
  const int ldsw = wid * 2048; int koff[2], voff[2];
#pragma unroll
  for (int i = 0; i < 2; ++i) { const int c = wid * 2 + i, row = 4 * c + (lane >> 4), cc = (lane & 15) ^ (row & 7); koff[i] = row * 128 + cc * 8;
    const int kk = (c >> 1) * 8 + ((lane >> 2) & 7), kx = (kk & ~0xC) | ((kk & 4) << 1) | ((kk & 8) >> 1), col = ((lane >> 5) | ((c & 1) << 1)) * 32 + (lane & 3) * 8; voff[i] = kx * 128 + col; }
#define DMAK(k0, b) do { _Pragma("unroll") for (int i_ = 0; i_ < 2; ++i_) \
    __builtin_amdgcn_global_load_lds((const unsigned*)(Kh + (long)(k0) * 128 + koff[i_]), (lds_u32*)(L + PK_OFF + (b) * 16384 + ldsw + i_ * 1024), 16, 0, 0); } while (0)
#define DMAV(k0, b) do { _Pragma("unroll") for (int i_ = 0; i_ < 2; ++i_) { \
    __builtin_amdgcn_global_load_lds((const unsigned*)(V0 + (long)(k0) * 128 + voff[i_]), (lds_u32*)(L + PV_OFF + (b) * 32768 + ldsw + i_ * 1024), 16, 0, 0); \
    __builtin_amdgcn_global_load_lds((const unsigned*)(V1 + (long)(k0) * 128 + voff[i_]), (lds_u32*)(L + PV_OFF + (b) * 32768 + 16384 + ldsw + i_ * 1024), 16, 0, 0); } } while (0)
#define PK4(P, BASE, OUT) do { unsigned a0 = cvtpk(P[BASE + 0], P[BASE + 1]), a1 = cvtpk(P[BASE + 2], P[BASE + 3]);   \
    unsigned b0_ = cvtpk(P[BASE + 4], P[BASE + 5]), b1_ = cvtpk(P[BASE + 6], P[BASE + 7]);                              \
    auto r0 = __builtin_amdgcn_permlane32_swap(a0, b0_, false, false); auto r1 = __builtin_amdgcn_permlane32_swap(a1, b1_, false, false); \
    u32x4 w_ = {r0[0], r1[0], r0[1], r1[1]}; OUT = *reinterpret_cast<bf16x8*>(&w_); } while (0)
  f32x16 pm = {}, pq = {}; bf16x8 fo0 = {}, fo1 = {}, fp0 = {}, fp1 = {}; float pmax = 0.f, pmaxq = 0.f; const int NT = seq / KVBLK;
  DMAK(0, 0); LBAR();
  typedef __attribute__((address_space(3))) s16x4 lds_s4;
#define TRR(off) __builtin_amdgcn_ds_read_tr16_b64_v4i16((lds_s4*)(L + (off)))
#define PVREAD(f, D0, vo_, vp_) do { f.l0 = TRR(vo_ + v_rd_off(D0, 0, 0)); f.h0 = TRR(vo_ + v_rd_off(D0, 0, 1)); f.l1 = TRR(vo_ + v_rd_off(D0, 1, 0)); f.h1 = TRR(vo_ + v_rd_off(D0, 1, 1)); \
    f.l2 = TRR(vp_ + v_rd_off(D0, 0, 0)); f.h2 = TRR(vp_ + v_rd_off(D0, 0, 1)); f.l3 = TRR(vp_ + v_rd_off(D0, 1, 0)); f.h3 = TRR(vp_ + v_rd_off(D0, 1, 1)); } while (0)
#define PKF(L_, H_) (bf16x8){L_[0], L_[1], L_[2], L_[3], H_[0], H_[1], H_[2], H_[3]}
#define MMA(acc, a_, b_) acc = __builtin_amdgcn_mfma_f32_32x32x16_bf16(a_, b_, acc, 0, 0, 0)
#define KF(d0, B) (*(const lds_b8*)(L + kaa[(d0) & 3] + (1 - (B)) * 16384 + ((d0) >> 2) * 128))
#define EXP2(i) do { pm[i] = __builtin_amdgcn_exp2f(fmaf(pm[i], C, mnC)); pm[(i) + 1] = __builtin_amdgcn_exp2f(fmaf(pm[(i) + 1], C, mnC)); } while (0)
#define PSEG(k, B, HQ, HM, HP) do { \
    float pmP = 0.f, alpha = 1.f, mnC = 0.f, ps = 0.f; VF fa, fb; bf16x8 kf0, kf1, kf2, kf3, kf4, kf5, kf6, kf7, fn0 = fo0, fn1 = fo1; unsigned ca0, ca1, cb0, cb1; \
    const int vo_ = vo + (1 - (B)) * 32768, vp_ = vp + (1 - (B)) * 32768; const int kaa[4] = {ka0, ka1, ka2, ka3}; \
    if ((k) + 2 < NT) DMAK(((k) + 2) * KVBLK, B); \
    if ((k) >= 0 && (k) < NT) DMAV((k) * KVBLK, B); \
    if (HM) pmP = mxb[(B) * 256 + (wid ^ 4) * 32 + r32]; \
    if (HP) { fp0 = *(const lds_b8*)(Ppar + (1 - (B)) * 16384); fp1 = *(const lds_b8*)(Ppar + (1 - (B)) * 16384 + 1024); } \
    if (HQ) { kf0 = KF(0, B); kf1 = KF(1, B); kf2 = KF(2, B); kf3 = KF(3, B); } \
    if (HP) PVREAD(fa, 0, vo_, vp_); \
    GAP(); \
    if (HQ) pq = __builtin_amdgcn_mfma_f32_32x32x16_bf16(kf0, qr[0], f32x16{}, 0, 0, 0); \
    if (HM) { pmax = fmaxf(pmax, pmP); const bool ok_ = __all(pmax - m_reg <= THR / SCALE); const float mn = ok_ ? m_reg : fmaxf(m_reg, pmax); \
        alpha = __builtin_amdgcn_exp2f((m_reg - mn) * C); m_reg = mn; mnC = -mn * C; } \
    GAP(); \
    if (HQ) { MMA(pq, kf1, qr[1]); kf4 = KF(4, B); kf5 = KF(5, B); } if (HM) EXP2(0); \
    GAP(); \
    if (HQ) { MMA(pq, kf2, qr[2]); kf6 = KF(6, B); kf7 = KF(7, B); } if (HM) EXP2(2); \
    GAP(); \
    if (HQ) MMA(pq, kf3, qr[3]); if (HP) PVREAD(fb, 1, vo_, vp_); if (HM) EXP2(4); \
    GAP(); \
    if (HQ) MMA(pq, kf4, qr[4]); if (HM) EXP2(6); \
    GAP(); \
    if (HQ) MMA(pq, kf5, qr[5]); if (HM) EXP2(8); \
    GAP(); \
    if (HQ) MMA(pq, kf6, qr[6]); if (HM) EXP2(10); \
    GAP(); \
    if (HQ) MMA(pq, kf7, qr[7]); if (HM) EXP2(12); \
    GAP(); \
    if (HP) MMA(o[0], fo0, PKF(fa.l0, fa.h0)); if (HM) EXP2(14); \
    GAP(); \
    if (HP) MMA(o[0], fo1, PKF(fa.l1, fa.h1)); if (HM) ps = (pm[0] + pm[1]) + (pm[2] + pm[3]); \
    GAP(); \
    if (HP) MMA(o[0], fp0, PKF(fa.l2, fa.h2)); if (HM) ps += (pm[4] + pm[5]) + (pm[6] + pm[7]); \
    GAP(); \
    if (HP) { MMA(o[0], fp1, PKF(fa.l3, fa.h3)); PVREAD(fa, 2, vo_, vp_); } if (HM) ps += (pm[8] + pm[9]) + (pm[10] + pm[11]); \
    GAP(); \
    if (HP) MMA(o[1], fo0, PKF(fb.l0, fb.h0)); \
    if (HM) { ps += (pm[12] + pm[13]) + (pm[14] + pm[15]); \
        auto rr = __builtin_amdgcn_permlane32_swap(__float_as_uint(ps), __float_as_uint(ps), false, false); ps = __uint_as_float(rr[0]) + __uint_as_float(rr[1]); l_reg = l_reg * alpha + ps; } \
    GAP(); \
    if (HP) MMA(o[1], fo1, PKF(fb.l1, fb.h1)); \
    if (HQ) { pmaxq = fmaxf(fmaxf(pq[0], pq[1]), fmaxf(pq[2], pq[3])); pmaxq = fmaxf(pmaxq, fmaxf(fmaxf(pq[4], pq[5]), fmaxf(pq[6], pq[7]))); } \
    GAP(); \
    if (HP) MMA(o[1], fp0, PKF(fb.l2, fb.h2)); \
    if (HQ) { pmaxq = fmaxf(pmaxq, fmaxf(fmaxf(pq[8], pq[9]), fmaxf(pq[10], pq[11]))); pmaxq = fmaxf(pmaxq, fmaxf(fmaxf(pq[12], pq[13]), fmaxf(pq[14], pq[15]))); \
        auto rr = __builtin_amdgcn_permlane32_swap(__float_as_uint(pmaxq), __float_as_uint(pmaxq), false, false); pmaxq = fmaxf(__uint_as_float(rr[0]), __uint_as_float(rr[1])); } \
    GAP(); \
    if (HP) { MMA(o[1], fp1, PKF(fb.l3, fb.h3)); PVREAD(fb, 3, vo_, vp_); } \
    if (HQ) { if (hi == 0) mxb[(1 - (B)) * 256 + wid * 32 + r32] = pmaxq; } \
    GAP(); \
    if (HP) MMA(o[2], fo0, PKF(fa.l0, fa.h0)); if (HM) { ca0 = cvtpk(pm[0], pm[1]); ca1 = cvtpk(pm[2], pm[3]); cb0 = cvtpk(pm[4], pm[5]); cb1 = cvtpk(pm[6], pm[7]); } \
    GAP(); \
    if (HP) MMA(o[2], fo1, PKF(fa.l1, fa.h1)); \
    GAP(); \
    if (HP) MMA(o[3], fo0, PKF(fb.l0, fb.h0)); \
    GAP(); \
    if (HP) MMA(o[3], fo1, PKF(fb.l1, fb.h1)); \
    GAP(); \
    if (HM) { auto r0 = __builtin_amdgcn_permlane32_swap(ca0, cb0, false, false); auto r1 = __builtin_amdgcn_permlane32_swap(ca1, cb1, false, false); \
        u32x4 w_ = {r0[0], r1[0], r0[1], r1[1]}; fn0 = *reinterpret_cast<bf16x8*>(&w_); \
        ca0 = cvtpk(pm[8], pm[9]); ca1 = cvtpk(pm[10], pm[11]); cb0 = cvtpk(pm[12], pm[13]); cb1 = cvtpk(pm[14], pm[15]); } \
    if (HP) MMA(o[2], fp0, PKF(fa.l2, fa.h2)); \
    GAP(); \
    if (HM) { auto r0 = __builtin_amdgcn_permlane32_swap(ca0, cb0, false, false); auto r1 = __builtin_amdgcn_permlane32_swap(ca1, cb1, false, false); \
        u32x4 w_ = {r0[0], r1[0], r0[1], r1[1]}; fn1 = *reinterpret_cast<bf16x8*>(&w_); } \
    if (HP) MMA(o[2], fp1, PKF(fa.l3, fa.h3)); \
    GAP(); \
    if (HM) { *(lds_b8*)(Pown + (B) * 16384) = fn0; *(lds_b8*)(Pown + (B) * 16384 + 1024) = fn1; } \
    if (HP) MMA(o[3], fp0, PKF(fb.l2, fb.h2)); \
    GAP(); \
    if (HP) MMA(o[3], fp1, PKF(fb.l3, fb.h3)); \
    GAP(); \
    if (HM) { if (__any(alpha < 1.f)) { if (hi == 0) al_l[r32] = alpha; asm volatile("s_waitcnt lgkmcnt(0)" ::: "memory"); \
            _Pragma("unroll") for (int d = 0; d < 4; ++d) _Pragma("unroll") for (int r = 0; r < 16; ++r) o[d][r] *= al_l[crow(r, hi)]; } \
        fo0 = fn0; fo1 = fn1; } \
    LBAR(); \
    if (HQ) { pm = pq; pmax = pmaxq; } } while (0)
  PSEG(-1, 1, 1, 0, 0);
  PSEG(0, 0, 1, 1, 0);
#pragma unroll 1
  for (int k = 1; k < NT - 1; k += 2) { PSEG(k, 1, 1, 1, 1); PSEG(k + 1, 0, 1, 1, 1); }
  PSEG(NT - 1, 1, 0, 1, 1);
  PSEG(NT, 0, 0, 0, 1);
  if (hi == 0) li[wid * 32 + r32] = l_reg;
  LBAR();
  float rli[16];
#pragma unroll
  for (int r = 0; r < 16; ++r) rli[r] = __builtin_amdgcn_rcpf(li[wid * 32 + crow(r, hi)] + li[(wid ^ 4) * 32 + crow(r, hi)]);
  bf16* Ow = (kh ? O1 : O0) + (long)(pr * 32) * 128;
  typedef __attribute__((address_space(3))) unsigned short lds_u16; typedef __attribute__((address_space(3))) u32x4 lds_q;
  lds_u16* ost = (lds_u16*)(L + PV_OFF + wid * 8192);
#pragma unroll
  for (int r = 0; r < 16; r += 2)
#pragma unroll
    for (int d0 = 0; d0 < 4; ++d0) { const unsigned w = cvtpk(o[d0][r] * rli[r], o[d0][r + 1] * rli[r + 1]);
      ost[crow(r, hi) * 128 + d0 * 32 + r32] = (unsigned short)w; ost[crow(r + 1, hi) * 128 + d0 * 32 + r32] = (unsigned short)(w >> 16); }
  asm volatile("s_waitcnt lgkmcnt(0)" ::: "memory");
#pragma unroll
  for (int i = 0; i < 8; ++i) { const int row = i * 4 + (lane >> 4), c8 = lane & 15;
    const u32x4 v = *(const lds_q*)(L + PV_OFF + wid * 8192 + row * 256 + c8 * 16); *(u32x4*)(Ow + (long)row * 128 + c8 * 8) = v; }
#undef PK4
#undef PSEG
#undef TRR
#undef PVREAD
#undef PKF
#undef MMA
#undef KF
#undef EXP2
#undef DMAK
#undef DMAV
}
#undef LBAR
#undef GAP
#undef KSWZ
#undef SBAR
}
constexpr int NWAVES = 8;
constexpr int DM = 2048, NBATCH = 4, SEQ = 2048, CTXL = 256;
constexpr int TL = NBATCH * SEQ, TC = NBATCH * CTXL, TT = TL + TC;
constexpr int N0 = 9248, N0P = 9472, N1 = 6144;
constexpr int NE = 64, TCAP = TT;
constexpr int MAXROWS = 99328;
constexpr int C_Z = 3072, C_A = 4096, C_B = 4112, C_HQ = 4128, C_HF = 5152, C_HI = 7200, C_OG = 8224;
constexpr float EPS = 1e-6f;
constexpr float LAM_INIT = 0.35550906759310186f;
constexpr size_t MiB = 1u << 20;
constexpr size_t WS_CTL = 0, CTL_ZERO_BYTES = 1 * MiB;
constexpr size_t WS_MODV = 2, WS_LTOK = 3, WS_LW = 6, WS_SELE = 9, WS_SELP = 10, WS_SLOTW = 11, WS_G = 12, WS_BETA = 14;
constexpr size_t WS_WIN0 = 16, WS_WOUT0 = 53, WS_GU0 = 61, WS_DN0 = 321, WS_WIN1 = 451, WS_WOUT1 = 475, WS_GU1 = 483, WS_DN1 = 743;
constexpr size_t WS_XR = 873, WS_H = 945, WS_BIG = 981;
constexpr size_t WS_PROJ0 = WS_BIG, WS_SQD = 1144, WS_SKDT = 1216, WS_SATT = 1288, WS_SU0T = 1324, WS_SW = 1468, WS_SGLV = 1504, WS_OD = 1508, WS_OH = 1580, WS_Y = 1652;
constexpr size_t WS_QKV = WS_BIG, WS_Q = 1089, WS_K = 1121, WS_V = 1157, WS_OATT = 1193;
constexpr size_t WS_HA = WS_BIG, WS_ACT = 1369;
constexpr size_t WS_END = 1690;
constexpr int CW_TMO = 0, CW_BAR = 4096, CW_CNT = 8192, CW_QHEAD = 8448, CW_DONE = 8960;
constexpr int RING_BYTES = 131072, LDSCTL_OFF = RING_BYTES, LDS_BYTES = 147456;
constexpr int L_TILEE = LDSCTL_OFF;
constexpr int L_RSTART = LDSCTL_OFF + 2048;
constexpr int L_CNT = LDSCTL_OFF + 2048 + 512;
constexpr int L_MISC = LDSCTL_OFF + 4096;
constexpr int L_XT = LDSCTL_OFF + 8192;
constexpr int L_XTN = LDSCTL_OFF + 8192 + 2048;

struct Args { const float* in[38]; float* out; unsigned char* ws; };
struct Frame { LAS unsigned char* lds; unsigned char* ldsg; int tid, lane, wave, G, bid; unsigned char* ws; gu32* ctl; };

typedef const float* cfptr_t;
__device__ __forceinline__ const float* ARG(int i) {
    unsigned long long b = (unsigned long long)__builtin_amdgcn_kernarg_segment_ptr(); asm volatile("" : "+s"(b));
    return ((const __attribute__((address_space(4))) cfptr_t*)b)[i];
}
__device__ __forceinline__ float* ARG_OUT() { return (float*)ARG(38); }
__device__ __forceinline__ float wave_sum(float v) {
#pragma unroll
    for (int o = 1; o < 64; o <<= 1) v += __shfl_xor(v, o);
    return v;
}
__device__ __forceinline__ float bf2f(unsigned short b) { return __uint_as_float(((unsigned)b) << 16); }
__device__ __forceinline__ float bflo(unsigned w) { return __uint_as_float(w << 16); }
__device__ __forceinline__ float bfhi(unsigned w) { return __uint_as_float(w & 0xffff0000u); }
__device__ __forceinline__ float sigmoidf_(float x) { return 1.f / (1.f + __expf(-x)); }
__device__ __forceinline__ float siluf_(float x) { return x / (1.f + __expf(-x)); }
__device__ __forceinline__ void unpack8(const v4u w, float (&o)[8]) {
    o[0] = bflo(w.x); o[1] = bfhi(w.x); o[2] = bflo(w.y); o[3] = bfhi(w.y); o[4] = bflo(w.z); o[5] = bfhi(w.z); o[6] = bflo(w.w); o[7] = bfhi(w.w);
}
__device__ __forceinline__ v4u pack8(const float (&o)[8]) { v4u w; w.x = pk2(o[0], o[1]); w.y = pk2(o[2], o[3]); w.z = pk2(o[4], o[5]); w.w = pk2(o[6], o[7]); return w; }

__device__ __forceinline__ void phase_mod(Frame& F, const Args& A) {
    LAS float* sc = (LAS float*)(F.lds);
    LAS float* part = (LAS float*)(F.lds + 40960);
    float* modv = (float*)(F.ws + WS_MODV * MiB);
    for (int i = F.tid; i < 5 * 2048; i += 512) { const int r = i >> 11, k = i & 2047; const float v = (r < 4) ? ARG(1)[r * 2048 + k] : ARG(3)[k]; sc[i] = siluf_(v); }
    __syncthreads();
    const int kq = F.lane >> 4, c4 = F.lane & 15;
    for (int item = F.bid; item < 384; item += F.G) {
        const int l = item / 192, cb = item % 192;
        const float* W = l ? ARG(22) : ARG(5); const float* Bv = l ? ARG(23) : ARG(6);
        float acc[5][4];
#pragma unroll
        for (int r = 0; r < 5; ++r)
#pragma unroll
            for (int j = 0; j < 4; ++j) acc[r][j] = 0.f;
        const float* wp = W + (size_t)(F.wave * 256 + kq) * 12288 + cb * 64 + c4 * 4;
#pragma unroll 8
        for (int i = 0; i < 64; ++i) {
            const f32x4 w = *(const f32x4*)(wp + (size_t)i * 4 * 12288);
            const int k = F.wave * 256 + 4 * i + kq;
#pragma unroll
            for (int r = 0; r < 5; ++r) { const float s = sc[r * 2048 + k];
#pragma unroll
                for (int j = 0; j < 4; ++j) acc[r][j] += s * w[j]; }
        }
#pragma unroll
        for (int r = 0; r < 5; ++r)
#pragma unroll
            for (int j = 0; j < 4; ++j) { float a = acc[r][j]; a += __shfl_xor(a, 16); a += __shfl_xor(a, 32); acc[r][j] = a; }
        if (kq == 0) {
#pragma unroll
            for (int r = 0; r < 5; ++r)
#pragma unroll
                for (int j = 0; j < 4; ++j) part[(F.wave * 5 + r) * 64 + c4 * 4 + j] = acc[r][j];
        }
        __syncthreads();
        if (F.tid < 320) { const int r = F.tid >> 6, cc = F.tid & 63; float s = 0.f;
#pragma unroll
            for (int w = 0; w < 8; ++w) s += part[(w * 5 + r) * 64 + cc];
            modv[(size_t)(l * 5 + r) * 12288 + cb * 64 + cc] = s + Bv[cb * 64 + cc]; }
        __syncthreads();
    }
}

template <int MODE> __device__ __forceinline__ void transpose_item(const float* W, int K, int N, bf16* WT, LAS float* scr, int item, int lane) {
    const int nblk = N / 32, kb = item / nblk, nb = item % nblk, k0 = 64 * kb, n0 = 32 * nb;
    const int d0 = MODE ? (256 * ((n0 & 511) >> 7) + 128 * (n0 >> 9) + (n0 & 127)) : n0;
#pragma unroll 8
    for (int i = 0; i < 32; ++i) { const int kk = 2 * i + (lane >> 5); scr[kk * 33 + (lane & 31)] = W[(size_t)(k0 + kk) * N + n0 + (lane & 31)]; }
    LDS_WAIT(); asm volatile("" ::: "memory");
    const int c = lane & 7;
#pragma unroll
    for (int j = 0; j < 4; ++j) { const int n = (lane >> 3) + 8 * j; const LAS float* s = scr + (8 * c) * 33 + n;
        v4u o; o.x = pk2(s[0 * 33], s[1 * 33]); o.y = pk2(s[2 * 33], s[3 * 33]); o.z = pk2(s[4 * 33], s[5 * 33]); o.w = pk2(s[6 * 33], s[7 * 33]);
        *(GAS v4u*)(WT + (size_t)(d0 + n) * K + k0 + 8 * c) = o; }
    LDS_WAIT(); asm volatile("" ::: "memory");
}
constexpr int CV_IN0 = 32 * 289, CV_OUT = 32 * 64, CV_GU = 32 * 32, CV_DN = 8 * 64, CV_IN1 = 32 * 192;
constexpr int CV_PER_L = NE * CV_GU + CV_GU + NE * CV_DN + CV_DN;
constexpr int CVQ_L0END = CV_PER_L, CVQ_IN1END = CV_PER_L + CV_IN1 + CV_OUT, CVQ_END = CVQ_IN1END + CV_PER_L;
constexpr int CVB = 8;
__device__ __forceinline__ void convert_qitem(Frame& F, int q, LAS float* scr, int lane_) {
    unsigned char* ws = F.ws; int r = q, l = 0;
    if (r >= CVQ_L0END) { r -= CVQ_L0END;
        if (r < CV_IN1) { transpose_item<0>(ARG(26), 2048, N1, (bf16*)(ws + WS_WIN1 * MiB), scr, r, lane_); return; } r -= CV_IN1;
        if (r < CV_OUT) { transpose_item<0>(ARG(31), 2048, 2048, (bf16*)(ws + WS_WOUT1 * MiB), scr, r, lane_); return; } r -= CV_OUT;
        l = 1; }
    const float* egu = l ? ARG(34) : ARG(18); const float* edn = l ? ARG(35) : ARG(19);
    const float* sgu = l ? ARG(36) : ARG(20); const float* sdn = l ? ARG(37) : ARG(21);
    bf16* GU = (bf16*)(ws + (l ? WS_GU1 : WS_GU0) * MiB); bf16* DN = (bf16*)(ws + (l ? WS_DN1 : WS_DN0) * MiB);
    if (r < NE * CV_GU) { const int e = r / CV_GU; transpose_item<1>(egu + (size_t)e * 2048 * 1024, 2048, 1024, GU + (size_t)e * 1024 * 2048, scr, r % CV_GU, lane_); return; } r -= NE * CV_GU;
    if (r < CV_GU) { transpose_item<1>(sgu, 2048, 1024, GU + (size_t)NE * 1024 * 2048, scr, r, lane_); return; } r -= CV_GU;
    if (r < NE * CV_DN) { const int e = r / CV_DN; transpose_item<0>(edn + (size_t)e * 512 * 2048, 512, 2048, DN + (size_t)e * 2048 * 512, scr, r % CV_DN, lane_); return; } r -= NE * CV_DN;
    transpose_item<0>(sdn, 512, 2048, DN + (size_t)NE * 2048 * 512, scr, r, lane_);
}
__device__ __forceinline__ void convert_queue(Frame& F, int limit, const gu32* stop, unsigned target) {
    int tl = threadIdx.x; asm volatile("" : "+v"(tl));
    const int lane_ = tl & 63, wave_ = __builtin_amdgcn_readfirstlane(tl >> 6);
    LAS float* scr = (LAS float*)(F.lds + 51200 + wave_ * 8704);
    volatile LAS int* qc = (volatile LAS int*)(F.lds + L_MISC + 64);
    const int x = F.bid & 7;
    gu32* qhead = F.ctl + CW_QHEAD + 64 * x;
    const int lim_loc = (limit - x + 7) >> 3, end_loc = (CVQ_END - x + 7) >> 3;
    const int kb = stop ? 1 : 2;
    for (;;) {
        __syncthreads();
        if (tl == 0) { int base = -1;
            bool go = true; if (stop) go = __hip_atomic_load(stop, RLX_AGENT) < target;
            if (go) base = (int)__hip_atomic_fetch_add(qhead, (unsigned)(8 * kb), RLX_AGENT);
            qc[0] = base; }
        __syncthreads();
        const int base = qc[0];
        if (base < 0) break;
#pragma unroll 1
        for (int j = 0; j < kb; ++j) { const int li = base + j * 8 + wave_; if (li < end_loc) convert_qitem(F, 8 * li + x, scr, lane_); }
        if (base + 8 * kb >= lim_loc) break;
    }
}
__device__ __forceinline__ void phase_tail_fill(Frame& F, int ph, bool busy, unsigned nbusy) {
    gu32* done = F.ctl + CW_DONE + 64 * ph;
    if (busy) { asm volatile("" ::: "memory"); if (F.tid == 0) __hip_atomic_fetch_add(done, 1u, RLX_AGENT); }
    else { __syncthreads(); convert_queue(F, CVQ_END, done, nbusy); }
}
__device__ __forceinline__ void phase_convert(Frame& F, const Args& A) {
    LAS float* scr = (LAS float*)(F.lds + 51200 + F.wave * 8704);
    const int gw = F.bid * NWAVES + F.wave, NGW = F.G * NWAVES;
    unsigned char* ws = F.ws;
    for (int it = gw; it < CV_IN0 + CV_OUT; it += NGW) {
        if (it < CV_IN0) transpose_item<0>(ARG(9), 2048, N0, (bf16*)(ws + WS_WIN0 * MiB), scr, it, F.lane);
        else transpose_item<0>(ARG(15), 2048, 2048, (bf16*)(ws + WS_WOUT0 * MiB), scr, it - CV_IN0, F.lane);
    }
    { v4u z; z.x = z.y = z.z = z.w = 0u; GAS v4u* p = (GAS v4u*)(ws + WS_WIN0 * MiB + (size_t)N0 * 2048 * 2);
      for (int i = F.bid * 512 + F.tid; i < (N0P - N0) * 2048 * 2 / 16; i += F.G * 512) p[i] = z; }
}

__device__ __forceinline__ void norm_row_regs(const float* xr, const float* nw, const float* sh, const float* scl, int lane, f32x4 (&o)[8]) {
    f32x4 v[8]; float ss = 0.f;
#pragma unroll
    for (int j = 0; j < 8; ++j) { v[j] = *(const f32x4*)(xr + j * 256 + lane * 4); ss += (v[j].x * v[j].x + v[j].y * v[j].y) + (v[j].z * v[j].z + v[j].w * v[j].w); }
    const float rstd = 1.f / sqrtf(wave_sum(ss) * (1.f / 2048.f) + EPS);
#pragma unroll
    for (int j = 0; j < 8; ++j) { const int c = j * 256 + lane * 4; const f32x4 w = *(const f32x4*)(nw + c), s = *(const f32x4*)(sh + c), g = *(const f32x4*)(scl + c);
        o[j] = v[j] * rstd * w * (g + 1.f) + s; }
}
__device__ __forceinline__ int bidx_of_row(int row) { return row < TL ? (row >> 11) : 4; }
__device__ __forceinline__ void phase_norm0(Frame& F, const Args& A) {
    const float* modv = (const float*)(F.ws + WS_MODV * MiB); bf16* H = (bf16*)(F.ws + WS_H * MiB);
    const int gw = F.bid * NWAVES + F.wave, NGW = F.G * NWAVES;
    for (int row = gw; row < TT; row += NGW) {
        const float* xr = row < TL ? ARG(0) + (size_t)row * DM : ARG(2) + (size_t)(row - TL) * DM;
        const float* mv = modv + (size_t)bidx_of_row(row) * 12288;
        f32x4 o[8]; norm_row_regs(xr, ARG(7), mv, mv + 2048, F.lane, o);
#pragma unroll
        for (int j = 0; j < 8; ++j) { uint2 w; w.x = pk2(o[j].x, o[j].y); w.y = pk2(o[j].z, o[j].w); *(uint2*)(H + (size_t)row * DM + j * 256 + F.lane * 4) = w; }
    }
}

typedef float f32x16 __attribute__((ext_vector_type(16)));
typedef unsigned u32x2 __attribute__((ext_vector_type(2)));
__device__ __forceinline__ int crow16(int r, int hi) { return (r & 3) + 8 * (r >> 2) + 4 * hi; }
__device__ __forceinline__ size_t rec_of(int type, int b, int h, int dir, int ci) { return (size_t)((((type * 4 + b) * 8 + h) * 2 + dir) * 36 + ci); }
__device__ __forceinline__ int blk_row0(int b, int tb) { return tb < 4 ? TL + b * CTXL + tb * 64 : b * SEQ + (tb - 4) * 64; }
__device__ __forceinline__ int blk_ci(int tb, int dir) { return dir ? (tb < 4 ? 3 - tb : 4 + 35 - tb) : tb; }

template <int J> struct SubstCol {
    static __device__ __forceinline__ void run(float (&R)[64], const LAS float* At) {
        const float xj = R[J];
#pragma unroll
        for (int i4 = (J + 1) / 4; i4 < 16; ++i4) { const f32x4 a4 = *(const LAS f32x4*)(At + J * 64 + i4 * 4);
            if (i4 * 4 + 0 > J) R[i4 * 4 + 0] -= a4.x * xj;
            if (i4 * 4 + 1 > J) R[i4 * 4 + 1] -= a4.y * xj;
            if (i4 * 4 + 2 > J) R[i4 * 4 + 2] -= a4.z * xj;
            if (i4 * 4 + 3 > J) R[i4 * 4 + 3] -= a4.w * xj; }
        SubstCol<J + 1>::run(R, At);
    }
};
template <> struct SubstCol<63> { static __device__ __forceinline__ void run(float (&)[64], const LAS float*) {} };

__device__ __forceinline__ void phase_s1_dn(Frame& F) {
    const bf16* P = (const bf16*)(F.ws + WS_PROJ0 * MiB);
    bf16* QDg = (bf16*)(F.ws + WS_SQD * MiB); bf16* ATg = (bf16*)(F.ws + WS_SATT * MiB); bf16* KDg = (bf16*)(F.ws + WS_SKDT * MiB);
    bf16* U0g = (bf16*)(F.ws + WS_SU0T * MiB); float* GLg = (float*)(F.ws + WS_SGLV * MiB); bf16* Wg = (bf16*)(F.ws + WS_SW * MiB);
    const float* cw = ARG(10);
    LAS unsigned char* L = F.lds;
    constexpr int O_RAW = 0;
    constexpr int O_KK = 0, O_QK = 16640, O_AM = 33280;
    constexpr int O_QB = 66560, O_KB = 83968, O_VB = 101376;
    constexpr int O_GC = 118784, O_BT = 119296;
    constexpr int O_CW = 119808;
    constexpr int O_SC = 127488;
    const int tid = F.tid, lane = F.lane, w = F.wave, l16 = tid & 15;
    for (int unit = F.bid; unit < NBATCH * 8 * 36; unit += F.G) {
        const int tb = unit % 36, bh = unit / 36, h = bh & 7, b = bh >> 3;
        const int row0 = blk_row0(b, tb);
        const int tloc0 = tb < 4 ? tb * 64 : (tb - 4) * 64, Lseg = tb < 4 ? CTXL : SEQ;
        { v4u rr_[7]; f32x4 cwr = {0.f, 0.f, 0.f, 0.f}; int tl = tid; asm volatile("" : "+v"(tl));
#pragma unroll
          for (int q = 0; q < 7; ++q) { const int idx = tl + 512 * q, rr = idx / 48, pc = idx % 48, vec = pc >> 4, c16 = pc & 15; const int tt = tloc0 + rr - 2;
              rr_[q] = (v4u){0u, 0u, 0u, 0u};
              if (idx < 68 * 48 && tt >= 0 && tt < Lseg) rr_[q] = *(const v4u*)(P + (size_t)(row0 + rr - 2) * N0 + vec * 1024 + h * 128 + c16 * 8); }
          if (tid < 480) { const int vec = tid / 160, off = tid % 160; cwr = *(const f32x4*)(cw + (size_t)(vec * 1024 + h * 128) * 5 + off * 4); }
#pragma unroll
          for (int q = 0; q < 7; ++q) { const int idx = tl + 512 * q, rr = idx / 48, pc = idx % 48; if (idx < 68 * 48) *(LAS v4u*)(L + O_RAW + rr * 768 + pc * 16) = rr_[q]; }
          if (tid < 480) { const int vec = tid / 160, off = tid % 160; LAS float* cwl = (LAS float*)(L + O_CW) + vec * 640;
#pragma unroll
              for (int c = 0; c < 4; ++c) { const int f = off * 4 + c; cwl[(f % 5) * 128 + f / 5] = cwr[c]; } } }
        __syncthreads();
        if (tid < 384) { const int strip = (tid >> 4) & 7, vec = tid >> 7;
            float wv[40]; { const LAS float* wp = (const LAS float*)(L + O_CW) + vec * 640 + l16 * 8;
#pragma unroll
                for (int t5 = 0; t5 < 5; ++t5) { const f32x4 w0 = *(const LAS f32x4*)(wp + t5 * 128), w1 = *(const LAS f32x4*)(wp + t5 * 128 + 4);
                    wv[0 * 5 + t5] = w0.x; wv[1 * 5 + t5] = w0.y; wv[2 * 5 + t5] = w0.z; wv[3 * 5 + t5] = w0.w; wv[4 * 5 + t5] = w1.x; wv[5 * 5 + t5] = w1.y; wv[6 * 5 + t5] = w1.z; wv[7 * 5 + t5] = w1.w; } }
            v4u raw[12];
#pragma unroll
            for (int r = 0; r < 12; ++r) raw[r] = *(const LAS v4u*)(L + O_RAW + (strip * 8 + r) * 768 + (vec * 16 + l16) * 16);
#pragma unroll
            for (int r = 0; r < 8; ++r) { float acc[8];
#pragma unroll
                for (int e = 0; e < 8; ++e) acc[e] = 0.f;
#pragma unroll
                for (int t5 = 0; t5 < 5; ++t5) { float xf[8]; unpack8(raw[r + t5], xf);
#pragma unroll
                    for (int e = 0; e < 8; ++e) acc[e] += xf[e] * wv[e * 5 + t5]; }
#pragma unroll
                for (int e = 0; e < 8; ++e) acc[e] = siluf_(acc[e]);
                if (vec < 2) { float ss = 0.f;
#pragma unroll
                    for (int e = 0; e < 8; ++e) ss += acc[e] * acc[e];
                    ss += __shfl_xor(ss, 1); ss += __shfl_xor(ss, 2); ss += __shfl_xor(ss, 4); ss += __shfl_xor(ss, 8);
                    float inv = 1.f / sqrtf(ss + 1e-6f); if (vec == 0) inv *= 0.08838834764831845f;
#pragma unroll
                    for (int e = 0; e < 8; ++e) acc[e] *= inv; }
                *(LAS v4u*)(L + (vec == 0 ? O_QB : (vec == 1 ? O_KB : O_VB)) + (strip * 8 + r) * 272 + l16 * 16) = pack8(acc); }
        }
        if (w < 2) { const int dir = w, ti = dir ? 63 - lane : lane; const size_t prow = (size_t)(row0 + ti) * N0;
            const float a = bf2f(P[prow + C_A + dir * 8 + h]) + ARG(12)[dir * 8 + h];
            const float sp = fmaxf(a, 0.f) + log1pf(__expf(-fabsf(a)));
            float g = -__expf(ARG(11)[dir * 8 + h]) * sp;
#pragma unroll
            for (int o = 1; o < 64; o <<= 1) { const float v = __shfl_up(g, o); if (lane >= o) g += v; }
            ((LAS float*)(L + O_GC))[dir * 64 + lane] = g;
            ((LAS float*)(L + O_BT))[dir * 64 + lane] = sigmoidf_(bf2f(P[prow + C_B + dir * 8 + h])); }
        __syncthreads();
        { const int mat = w >> 2, rb = (w >> 1) & 1, cb = w & 1, l32 = lane & 31, hi = lane >> 5;
          f32x16 acc = {};
#pragma unroll
          for (int ks = 0; ks < 8; ++ks) { const bf16x8 a = *(const LAS bf16x8*)(L + (mat ? O_QB : O_KB) + (rb * 32 + l32) * 272 + (ks * 16 + hi * 8) * 2);
              const bf16x8 bb = *(const LAS bf16x8*)(L + O_KB + (cb * 32 + l32) * 272 + (ks * 16 + hi * 8) * 2);
              acc = __builtin_amdgcn_mfma_f32_32x32x16_bf16(a, bb, acc, 0, 0, 0); }
          LAS float* dstm = (LAS float*)(L + (mat ? O_QK : O_KK));
#pragma unroll
          for (int r = 0; r < 16; ++r) dstm[(rb * 32 + crow16(r, hi)) * 65 + cb * 32 + l32] = acc[r]; }
        __syncthreads();
        { int tl2 = tid; asm volatile("" : "+v"(tl2));
          const int dir = w >> 2, t = tl2 & 255, wl = w & 3, lane2 = tl2 & 63, l32 = lane2 & 31, hi = lane2 >> 5;
          const LAS float* gc = (const LAS float*)(L + O_GC) + dir * 64; const LAS float* bt = (const LAS float*)(L + O_BT) + dir * 64;
          const LAS float* KKs = (const LAS float*)(L + O_KK); const LAS float* QKs = (const LAS float*)(L + O_QK);
          LAS float* Am = (LAS float*)(L + O_AM) + dir * 4096;
          const int ci = blk_ci(tb, dir);
          const size_t rec = rec_of(0, b, h, dir, ci), recw = (size_t)(((b * 8 + h) * 2 + dir) * 36 + ci);
#pragma unroll 1
          for (int q = 0; q < 16; ++q) { const int idx = t + 256 * q, j = idx >> 6, i = idx & 63; const int ti = dir ? 63 - i : i, tj = dir ? 63 - j : j;
              Am[j * 64 + i] = (j < i) ? bt[i] * KKs[ti * 65 + tj] * __expf(gc[i] - gc[j]) : 0.f; }
#pragma unroll 1
          for (int q = 0; q < 2; ++q) { const int idx = t + 256 * q, i = idx >> 3, j8 = idx & 7, ti = dir ? 63 - i : i; float xf[8];
#pragma unroll
              for (int e = 0; e < 8; ++e) { const int j = j8 * 8 + e, tj = dir ? 63 - j : j; xf[e] = (j <= i) ? QKs[ti * 65 + tj] * __expf(gc[i] - gc[j]) : 0.f; }
              *(v4u*)(ATg + rec * 4096 + i * 64 + j8 * 8) = pack8(xf); }
          if (t < 128) { const int j = t & 63; ((LAS float*)(L + O_SC))[dir * 128 + t] = (t < 64) ? bt[j] : bt[j] * __expf(gc[j]); }
          __syncthreads();
          LAS unsigned short* TI = (LAS unsigned short*)(L + O_KK) + dir * 4608;
          if (wl == 0) {
              float X[64];
#pragma unroll
              for (int i = 0; i < 64; ++i) X[i] = (i == lane2) ? 1.f : 0.f;
              SubstCol<0>::run(X, Am);
#pragma unroll
              for (int i = 0; i < 64; ++i) TI[i * 72 + lane2] = (unsigned short)f2bf(X[i]);
          } else { const int t3 = t - 64;
#pragma unroll 1
              for (int idx = t3; idx < 1024; idx += 192) { const int i = idx >> 4, k8 = idx & 15, ti = dir ? 63 - i : i; const float eg = __expf(gc[i]);
                  float xf[8]; unpack8(*(const LAS v4u*)(L + O_QB + ti * 272 + k8 * 16), xf);
#pragma unroll
                  for (int e = 0; e < 8; ++e) xf[e] *= eg;
                  *(v4u*)(QDg + rec * 8192 + i * 128 + k8 * 8) = pack8(xf); }
#pragma unroll 1
              for (int idx = t3; idx < 1024; idx += 192) { const int j8 = idx >> 7, kk = idx & 127; float xf[8];
#pragma unroll
                  for (int e = 0; e < 8; ++e) { const int j = j8 * 8 + e, tj = dir ? 63 - j : j; xf[e] = bf2f(*(const LAS unsigned short*)(L + O_KB + tj * 272 + kk * 2)) * __expf(gc[63] - gc[j]); }
                  *(v4u*)(KDg + rec * 8192 + kk * 64 + j8 * 8) = pack8(xf); }
              if (t3 < 128) GLg[rec * 128 + t3] = __expf(gc[63]);
          }
          __syncthreads();
#pragma unroll 1
          for (int cbi = 0; cbi < 2; ++cbi) { const int cb = 2 * wl + cbi, col = cb * 32 + l32; const bool isk = cb >= 4;
              const LAS unsigned char* colp = L + (isk ? O_KB + (col - 128) * 2 : O_VB + col * 2);
              const LAS float* scp = (const LAS float*)(L + O_SC) + dir * 128 + (isk ? 64 : 0);
              f32x16 acc0 = {}, acc1 = {};
#pragma unroll
              for (int ks = 0; ks < 4; ++ks) { float f[8];
#pragma unroll
                  for (int e = 0; e < 8; ++e) { const int j = ks * 16 + hi * 8 + e, tj = dir ? 63 - j : j; f[e] = bf2f(*(const LAS unsigned short*)(colp + tj * 272)) * scp[j]; }
                  const v4u bw = pack8(f); const bf16x8 rfrag = __builtin_bit_cast(bf16x8, bw);
                  const bf16x8 t0 = *(const LAS bf16x8*)(TI + (l32) * 72 + ks * 16 + hi * 8), t1 = *(const LAS bf16x8*)(TI + (32 + l32) * 72 + ks * 16 + hi * 8);
                  if (!isk) { acc0 = __builtin_amdgcn_mfma_f32_32x32x16_bf16(t0, rfrag, acc0, 0, 0, 0); acc1 = __builtin_amdgcn_mfma_f32_32x32x16_bf16(t1, rfrag, acc1, 0, 0, 0); }
                  else      { acc0 = __builtin_amdgcn_mfma_f32_32x32x16_bf16(rfrag, t0, acc0, 0, 0, 0); acc1 = __builtin_amdgcn_mfma_f32_32x32x16_bf16(rfrag, t1, acc1, 0, 0, 0); } }
              if (!isk) { bf16* up = U0g + rec * 8192 + (size_t)col * 64 + 4 * hi;
#pragma unroll
                  for (int q = 0; q < 4; ++q) { u32x2 o0, o1; o0.x = pk2(acc0[q * 4], acc0[q * 4 + 1]); o0.y = pk2(acc0[q * 4 + 2], acc0[q * 4 + 3]); o1.x = pk2(acc1[q * 4], acc1[q * 4 + 1]); o1.y = pk2(acc1[q * 4 + 2], acc1[q * 4 + 3]);
                      *(u32x2*)(up + 8 * q) = o0; *(u32x2*)(up + 32 + 8 * q) = o1; } }
              else { bf16* wp0 = Wg + recw * 8192 + (size_t)l32 * 128 + (cb * 32 - 128) + 4 * hi;
#pragma unroll
                  for (int q = 0; q < 4; ++q) { u32x2 o0, o1; o0.x = pk2(acc0[q * 4], acc0[q * 4 + 1]); o0.y = pk2(acc0[q * 4 + 2], acc0[q * 4 + 3]); o1.x = pk2(acc1[q * 4], acc1[q * 4 + 1]); o1.y = pk2(acc1[q * 4 + 2], acc1[q * 4 + 3]);
                      *(u32x2*)(wp0 + 8 * q) = o0; *(u32x2*)(wp0 + 32 * 128 + 8 * q) = o1; } }
          }
        }
        __syncthreads();
    }
}

__device__ __forceinline__ void phase_s1_hg(Frame& F) {
    const bf16* P = (const bf16*)(F.ws + WS_PROJ0 * MiB);
    bf16* QDg = (bf16*)(F.ws + WS_SQD * MiB); bf16* ATg = (bf16*)(F.ws + WS_SATT * MiB); bf16* KDg = (bf16*)(F.ws + WS_SKDT * MiB);
    bf16* U0g = (bf16*)(F.ws + WS_SU0T * MiB); float* GLg = (float*)(F.ws + WS_SGLV * MiB);
    const float* lbl = ARG(4);
    LAS unsigned char* L = F.lds;
    constexpr int O_FF = 0, O_CU = 32768;
    constexpr int O_QS = 65536, O_KS = 82944;
    constexpr int O_AM = 0, O_HV = 32768;
    const int lane = F.lane, w = F.wave;
    for (int unit = F.bid; unit < NBATCH * 8 * 36 * 2; unit += F.G) {
        int tid = F.tid; asm volatile("" : "+v"(tid));
        const int dir = unit & 1, u2 = unit >> 1, tb = u2 % 36, bh = u2 / 36, h = bh & 7, b = bh >> 3;
        const int row0 = blk_row0(b, tb), ci = blk_ci(tb, dir);
        const size_t rec = rec_of(1, b, h, dir, ci);
        v4u hvr[4];
#pragma unroll
        for (int q = 0; q < 4; ++q) { hvr[q] = (v4u){0u, 0u, 0u, 0u};
            if (w >= 4) { const int idx = (tid - 256) + 256 * q, i = idx >> 4, c16 = idx & 15, ti = dir ? 63 - i : i; hvr[q] = *(const v4u*)(P + (size_t)(row0 + ti) * N0 + C_HI + h * 128 + c16 * 8); } }
        float qreg[2][8];
#pragma unroll
        for (int q = 0; q < 2; ++q) { const int idx = tid + 512 * q, i = idx >> 4, k8 = idx & 15, ti = dir ? 63 - i : i; const size_t prow = (size_t)(row0 + ti) * N0;
            float xg[8]; unpack8(*(const v4u*)(P + prow + C_HQ + h * 128 + k8 * 8), qreg[q]); unpack8(*(const v4u*)(P + prow + C_HF + dir * 1024 + h * 128 + k8 * 8), xg);
#pragma unroll
            for (int e = 0; e < 8; ++e) { const int c = h * 128 + k8 * 8 + e; const float e0 = __expf(lbl[c]), e1 = __expf(lbl[1024 + c]), e2 = __expf(lbl[2048 + c]); const float lb = e0 / (e0 + e1 + e2);
                qreg[q][e] = siluf_(qreg[q][e]); xg[e] = lb + (1.f - lb) * sigmoidf_(xg[e]); }
            LAS float* fd = (LAS float*)(L + O_FF) + i * 128 + k8 * 8;
            *(LAS f32x4*)fd = (f32x4){xg[0], xg[1], xg[2], xg[3]}; *(LAS f32x4*)(fd + 4) = (f32x4){xg[4], xg[5], xg[6], xg[7]}; }
        __syncthreads();
        { const int kch = tid & 127, part = tid >> 7; const LAS float* ff = (const LAS float*)(L + O_FF); LAS float* cu = (LAS float*)(L + O_CU); LAS float* tot = (LAS float*)(L + O_QS);
          float loc[16]; float s = 0.f;
#pragma unroll
          for (int i = 0; i < 16; ++i) { s += __logf(ff[(part * 16 + i) * 128 + kch]); loc[i] = s; }
          tot[part * 128 + kch] = s;
          __syncthreads();
          float base = 0.f;
#pragma unroll
          for (int p = 0; p < 3; ++p) base += (p < part) ? tot[p * 128 + kch] : 0.f;
#pragma unroll
          for (int i = 0; i < 16; ++i) cu[(part * 16 + i) * 128 + kch] = base + loc[i]; }
        __syncthreads();
        { const LAS float* ff = (const LAS float*)(L + O_FF); const LAS float* cu = (const LAS float*)(L + O_CU);
#pragma unroll
          for (int q = 0; q < 2; ++q) { const int idx = tid + 512 * q, i = idx >> 4, k8 = idx & 15; float qs[8], ks[8], qd[8];
#pragma unroll
              for (int e = 0; e < 8; ++e) { const int k = k8 * 8 + e; const float c = cu[i * 128 + k], cm = cu[31 * 128 + k], qv = qreg[q][e];
                  qs[e] = qv * __expf(c - cm); ks[e] = (1.f - ff[i * 128 + k]) * __expf(cm - c); qd[e] = qv * __expf(c); }
              *(LAS v4u*)(L + O_QS + i * 272 + k8 * 16) = pack8(qs); *(LAS v4u*)(L + O_KS + i * 272 + k8 * 16) = pack8(ks);
              *(v4u*)(QDg + rec * 8192 + i * 128 + k8 * 8) = pack8(qd); }
#pragma unroll 1
          for (int q = 0; q < 2; ++q) { const int idx = tid + 512 * q, j8 = idx >> 7, k = idx & 127; float xf[8]; const float cl = cu[63 * 128 + k];
#pragma unroll
              for (int e = 0; e < 8; ++e) { const int j = j8 * 8 + e; xf[e] = (1.f - ff[j * 128 + k]) * __expf(cl - cu[j * 128 + k]); }
              *(v4u*)(KDg + rec * 8192 + k * 64 + j8 * 8) = pack8(xf); }
          if (tid < 128) GLg[rec * 128 + tid] = __expf(cu[63 * 128 + tid]); }
        __syncthreads();
        if (w < 4) { const int rb = w >> 1, cb = w & 1, l32 = lane & 31, hi = lane >> 5; f32x16 acc = {};
#pragma unroll
            for (int ks = 0; ks < 8; ++ks) { const bf16x8 a = *(const LAS bf16x8*)(L + O_QS + (rb * 32 + l32) * 272 + (ks * 16 + hi * 8) * 2);
                const bf16x8 bb = *(const LAS bf16x8*)(L + O_KS + (cb * 32 + l32) * 272 + (ks * 16 + hi * 8) * 2);
                acc = __builtin_amdgcn_mfma_f32_32x32x16_bf16(a, bb, acc, 0, 0, 0); }
            LAS float* am = (LAS float*)(L + O_AM);
#pragma unroll
            for (int r = 0; r < 16; ++r) am[(rb * 32 + crow16(r, hi)) * 65 + cb * 32 + l32] = acc[r];
        } else { const int t = tid - 256;
#pragma unroll
            for (int q = 0; q < 4; ++q) { const int idx = t + 256 * q, i = idx >> 4, c16 = idx & 15;
                *(LAS v4u*)(L + O_HV + i * 256 + c16 * 16) = hvr[q]; } }
        __syncthreads();
        { const LAS float* am = (const LAS float*)(L + O_AM); const int i = tid >> 3, j8 = tid & 7; float xf[8];
#pragma unroll
          for (int e = 0; e < 8; ++e) { const int j = j8 * 8 + e; xf[e] = (j <= i) ? am[i * 65 + j] : 0.f; }
          *(v4u*)(ATg + rec * 4096 + i * 64 + j8 * 8) = pack8(xf);
#pragma unroll
          for (int q = 0; q < 4; ++q) { const int idx = tid + 512 * q, i4 = idx >> 7, v = idx & 127; const LAS unsigned short* hp = (const LAS unsigned short*)(L + O_HV) + (i4 * 4) * 128 + v;
              u32x2 o; o.x = (unsigned)hp[0] | ((unsigned)hp[128] << 16); o.y = (unsigned)hp[256] | ((unsigned)hp[384] << 16); *(u32x2*)(U0g + rec * 8192 + v * 64 + i4 * 4) = o; } }
        __syncthreads();
    }
}

__device__ __forceinline__ int sw256(int row, int colB) { return row * 256 + (colB ^ ((row & 15) << 4)); }
__device__ __forceinline__ int sw128(int row, int colB) { return row * 128 + (colB ^ (((row >> 1) & 7) << 4)); }
__device__ __forceinline__ void s2_compute(LAS unsigned char* L, int type, int ci, int w, int l32, int hi, int b, int h, int dir, int vh, bf16* Og, f32x16& Sacc) {
    constexpr int O_W = 0, O_QD = 16384, O_AT = 32768, O_KD = 40960, O_U0 = 57344, O_GL = 65536, O_ST = 66048, O_UT = 82432;
            const int rb = (w >> 1) & 1, cb = w & 1;
            f32x16 oacc = {};
            if (w < 4) {
                f32x16 acc = {};
                if (type == 0) { f32x16 acc1 = {};
#pragma unroll
                    for (int ks = 0; ks < 8; ks += 2) { const bf16x8 a = *(const LAS bf16x8*)(L + O_W + sw256(rb * 32 + l32, ks * 32 + hi * 16)), a1 = *(const LAS bf16x8*)(L + O_W + sw256(rb * 32 + l32, (ks + 1) * 32 + hi * 16));
                        const bf16x8 bb = *(const LAS bf16x8*)(L + O_ST + sw256(cb * 32 + l32, ks * 32 + hi * 16)), bb1 = *(const LAS bf16x8*)(L + O_ST + sw256(cb * 32 + l32, (ks + 1) * 32 + hi * 16));
                        acc = __builtin_amdgcn_mfma_f32_32x32x16_bf16(a, bb, acc, 0, 0, 0); acc1 = __builtin_amdgcn_mfma_f32_32x32x16_bf16(a1, bb1, acc1, 0, 0, 0); }
                    acc += acc1; }
#pragma unroll
                for (int q = 0; q < 4; ++q) { const int i0 = rb * 32 + 8 * q + 4 * hi; const u32x2 uw = *(const LAS u32x2*)(L + O_U0 + sw128(cb * 32 + l32, i0 * 2)); const f32x4 u0 = {bflo(uw.x), bfhi(uw.x), bflo(uw.y), bfhi(uw.y)};
                    u32x2 pkd; pkd.x = pk2(u0.x - acc[q * 4], u0.y - acc[q * 4 + 1]); pkd.y = pk2(u0.z - acc[q * 4 + 2], u0.w - acc[q * 4 + 3]);
                    *(LAS u32x2*)(L + O_UT + sw128(cb * 32 + l32, i0 * 2)) = pkd; }
            } else {
                f32x16 oacc1 = {};
#pragma unroll
                for (int ks = 0; ks < 8; ks += 2) { const bf16x8 a = *(const LAS bf16x8*)(L + O_QD + sw256(rb * 32 + l32, ks * 32 + hi * 16)), a1 = *(const LAS bf16x8*)(L + O_QD + sw256(rb * 32 + l32, (ks + 1) * 32 + hi * 16));
                    const bf16x8 bb = *(const LAS bf16x8*)(L + O_ST + sw256(cb * 32 + l32, ks * 32 + hi * 16)), bb1 = *(const LAS bf16x8*)(L + O_ST + sw256(cb * 32 + l32, (ks + 1) * 32 + hi * 16));
                    oacc = __builtin_amdgcn_mfma_f32_32x32x16_bf16(a, bb, oacc, 0, 0, 0); oacc1 = __builtin_amdgcn_mfma_f32_32x32x16_bf16(a1, bb1, oacc1, 0, 0, 0); }
                oacc += oacc1;
            }
            __syncthreads();
            if (w >= 4) {
#pragma unroll
                for (int js = 0; js < 4; ++js) { const bf16x8 a = *(const LAS bf16x8*)(L + O_AT + sw128(rb * 32 + l32, js * 32 + hi * 16));
                    const bf16x8 bb = *(const LAS bf16x8*)(L + O_UT + sw128(cb * 32 + l32, js * 32 + hi * 16));
                    oacc = __builtin_amdgcn_mfma_f32_32x32x16_bf16(a, bb, oacc, 0, 0, 0); }
                LAS unsigned short* ost = (LAS unsigned short*)(L + 90624 + (w - 4) * 2048);
#pragma unroll
                for (int r = 0; r < 16; ++r) ost[crow16(r, hi) * 32 + l32] = f2bf(oacc[r]);
#pragma unroll
                for (int j = 0; j < 2; ++j) { const int idx = (hi * 32 + l32) + 64 * j, rr = idx >> 2, c4 = idx & 3; const int i = rb * 32 + rr; const int pos = (ci < 4 ? ci * 64 : (ci - 4) * 64) + i;
                    const int row = ci < 4 ? (TL + b * CTXL + (dir ? CTXL - 1 - pos : pos)) : (b * SEQ + (dir ? SEQ - 1 - pos : pos));
                    const v4u v = *(const LAS v4u*)(L + 90624 + (w - 4) * 2048 + rr * 64 + c4 * 16);
                    *(v4u*)(Og + (size_t)row * 1024 + h * 128 + vh * 64 + cb * 32 + c4 * 8) = v; }
            }
            {
                const int kb = w >> 1;
#pragma unroll
                for (int q = 0; q < 4; ++q) { const f32x4 g4 = *(const LAS f32x4*)(L + O_GL + (kb * 32 + 8 * q + 4 * hi) * 4);
                    Sacc[q * 4] *= g4.x; Sacc[q * 4 + 1] *= g4.y; Sacc[q * 4 + 2] *= g4.z; Sacc[q * 4 + 3] *= g4.w; }
#pragma unroll
                for (int js = 0; js < 4; ++js) { const bf16x8 a = *(const LAS bf16x8*)(L + O_KD + sw128(kb * 32 + l32, js * 32 + hi * 16));
                    const bf16x8 bb = *(const LAS bf16x8*)(L + O_UT + sw128(cb * 32 + l32, js * 32 + hi * 16));
                    Sacc = __builtin_amdgcn_mfma_f32_32x32x16_bf16(a, bb, Sacc, 0, 0, 0); }
#pragma unroll
                for (int q = 0; q < 4; ++q) { const int k0 = kb * 32 + 8 * q + 4 * hi; u32x2 pkd; pkd.x = pk2(Sacc[q * 4], Sacc[q * 4 + 1]); pkd.y = pk2(Sacc[q * 4 + 2], Sacc[q * 4 + 3]);
                    *(LAS u32x2*)(L + O_ST + sw256(cb * 32 + l32, k0 * 2)) = pkd; }
            }
}

__device__ __forceinline__ void phase_s2(Frame& F) {
    const bf16* QDg = (const bf16*)(F.ws + WS_SQD * MiB); const bf16* ATg = (const bf16*)(F.ws + WS_SATT * MiB); const bf16* KDg = (const bf16*)(F.ws + WS_SKDT * MiB);
    const bf16* U0g = (const bf16*)(F.ws + WS_SU0T * MiB); const float* GLg = (const float*)(F.ws + WS_SGLV * MiB); const bf16* Wg = (const bf16*)(F.ws + WS_SW * MiB);
    LAS unsigned char* L = F.lds;
    constexpr int O_W = 0, O_QD = 16384, O_AT = 32768, O_KD = 40960, O_U0 = 57344, O_GL = 65536, O_ST = 66048, O_UT = 82432;
    const int tid = F.tid, lane = F.lane, w = F.wave, l32 = lane & 31, hi = lane >> 5;
    for (int u0_ = F.bid; u0_ < 256; u0_ += F.G) {
        const int unit = (F.G == 256) ? (2 * ((u0_ & 7) + 8 * (u0_ >> 4)) + ((u0_ >> 3) & 1)) : u0_;
        const int type = unit >> 7, rem = unit & 127, b = rem >> 5, h = (rem >> 2) & 7, dir = (rem >> 1) & 1, vh = rem & 1;
        bf16* Og = (bf16*)(F.ws + (type ? WS_OH : WS_OD) * MiB) + (size_t)dir * TT * 1024;
        const size_t rec0 = rec_of(type, b, h, dir, 0), recw0 = (size_t)(((b * 8 + h) * 2 + dir) * 36);
        for (int i = tid; i < 16384 / 16; i += 512) { v4u z; z.x = z.y = z.z = z.w = 0u; *(LAS v4u*)(L + O_ST + i * 16) = z; }
        f32x16 Sacc = {};
        v4u pwA[2], pqA[2], paA, pkA[2], puA; f32x4 pgA = {0.f, 0.f, 0.f, 0.f};
        v4u pwB[2], pqB[2], paB, pkB[2], puB; f32x4 pgB = {0.f, 0.f, 0.f, 0.f};
        pwA[0] = pwA[1] = pwB[0] = pwB[1] = (v4u){0u, 0u, 0u, 0u};
#define S2_LOAD(X, ci) do { const size_t rc = rec0 + (ci); \
            _Pragma("unroll") for (int j = 0; j < 2; ++j) { const int idx = tid + 512 * j; \
                if (type == 0) pw##X[j] = *(const v4u*)(Wg + (recw0 + (ci)) * 8192 + idx * 8); \
                pq##X[j] = *(const v4u*)(QDg + rc * 8192 + idx * 8); pk##X[j] = *(const v4u*)(KDg + rc * 8192 + idx * 8); } \
            pu##X = *(const v4u*)(U0g + rc * 8192 + (size_t)vh * 4096 + tid * 8); \
            pa##X = *(const v4u*)(ATg + rc * 4096 + tid * 8); \
            if (tid < 32) pg##X = *(const f32x4*)(GLg + rc * 128 + tid * 4); } while (0)
#define S2_STEP(X, ci) do { \
            __syncthreads(); \
            _Pragma("unroll") for (int j = 0; j < 2; ++j) { const int idx = tid + 512 * j; \
                { const int row = idx >> 4, c16 = idx & 15; *(LAS v4u*)(L + O_W + sw256(row, c16 * 16)) = pw##X[j]; *(LAS v4u*)(L + O_QD + sw256(row, c16 * 16)) = pq##X[j]; } \
                { const int row = idx >> 3, c16 = idx & 7; *(LAS v4u*)(L + O_KD + sw128(row, c16 * 16)) = pk##X[j]; } } \
            { const int row = tid >> 3, c16 = tid & 7; *(LAS v4u*)(L + O_AT + sw128(row, c16 * 16)) = pa##X; *(LAS v4u*)(L + O_U0 + sw128(row, c16 * 16)) = pu##X; } \
            if (tid < 32) *(LAS f32x4*)(L + O_GL + tid * 16) = pg##X; \
            __syncthreads(); \
            if ((ci) + 2 < 36) S2_LOAD(X, (ci) + 2); \
            s2_compute(L, type, ci, w, l32, hi, b, h, dir, vh, Og, Sacc); } while (0)
        S2_LOAD(A, 0); S2_LOAD(B, 1);
#pragma unroll 1
        for (int ci = 0; ci < 36; ci += 2) { S2_STEP(A, ci); S2_STEP(B, ci + 1); }
        __syncthreads();
#undef S2_LOAD
#undef S2_STEP
    }
}

__device__ __forceinline__ void phase_outnorm0(Frame& F, const Args& A) {
    const bf16* P = (const bf16*)(F.ws + WS_PROJ0 * MiB); bf16* Y = (bf16*)(F.ws + WS_Y * MiB);
    const int gw = F.bid * NWAVES + F.wave, NGW = F.G * NWAVES, lane = F.lane;
    for (int row = gw; row < TT; row += NGW) {
        v4u oin[4][3];
#pragma unroll
        for (int p = 0; p < 4; ++p) { const int t2 = p >> 1, c0 = (p & 1) * 512 + lane * 8; const bf16* O0 = (const bf16*)(F.ws + (t2 ? WS_OH : WS_OD) * MiB) + (size_t)row * 1024 + c0;
            oin[p][0] = *(const v4u*)O0; oin[p][1] = *(const v4u*)(O0 + (size_t)TT * 1024); oin[p][2] = *(const v4u*)(P + (size_t)row * N0 + (t2 ? C_OG : C_Z) + c0); }
#pragma unroll
        for (int p = 0; p < 4; ++p) { const int t2 = p >> 1, c0 = (p & 1) * 512 + lane * 8;
            float fa[8], fb[8]; unpack8(oin[p][0], fa); unpack8(oin[p][1], fb);
            float o[8] = {fa[0] + fb[0], fa[1] + fb[1], fa[2] + fb[2], fa[3] + fb[3], fa[4] + fb[4], fa[5] + fb[5], fa[6] + fb[6], fa[7] + fb[7]};
            float ss = 0.f;
#pragma unroll
            for (int e = 0; e < 8; ++e) ss += o[e] * o[e];
            ss += __shfl_xor(ss, 1); ss += __shfl_xor(ss, 2); ss += __shfl_xor(ss, 4); ss += __shfl_xor(ss, 8);
            const float rstd = 1.f / sqrtf(ss * (1.f / 128.f) + EPS);
            const float* nw = (t2 ? ARG(14) : ARG(13)) + (c0 & 127);
            float gf[8]; unpack8(oin[p][2], gf);
#pragma unroll
            for (int e = 0; e < 8; ++e) o[e] = o[e] * rstd * nw[e] * (t2 ? sigmoidf_(gf[e]) : siluf_(gf[e]));
            *(v4u*)(Y + (size_t)row * DM + t2 * 1024 + c0) = pack8(o);
        }
    }
}

struct EpiProj0 {
    static constexpr bool PERM = true, AFTER_DRAIN = false;
    bf16* O;
    __device__ __forceinline__ void operator()(const pg8::f32x4 (&acc)[2][2][4][2], const pg8::Unit& u, int wr, int wc, int fr, int fq) const {
        const int row0 = u.pm * 256 + wr * 64 + fr, col0 = u.pn * 256 + wc * 32 + 8 * fq;
#pragma unroll
        for (int ai = 0; ai < 2; ++ai)
#pragma unroll
            for (int m = 0; m < 4; ++m) { bf16* rowp = O + (size_t)(row0 + ai * 128 + m * 16) * N0 + col0;
#pragma unroll
                for (int bj = 0; bj < 2; ++bj) { if (col0 + bj * 128 < N0) { const pg8::f32x4 v0 = acc[ai][bj][m][0], v1 = acc[ai][bj][m][1];
                    pg8::u32x4 w; w.x = pg8::cvt_pk_bf16(v0[0], v0[1]); w.y = pg8::cvt_pk_bf16(v0[2], v0[3]); w.z = pg8::cvt_pk_bf16(v1[0], v1[1]); w.w = pg8::cvt_pk_bf16(v1[2], v1[3]);
                    *(pg8::u32x4*)(rowp + bj * 128) = w; } } }
    }
};
template <bool BASE16> struct EpiResidT {
    static constexpr bool PERM = false, AFTER_DRAIN = false;
    const void* baseL; const void* baseC; bf16* out; const float* gate;
    __device__ __forceinline__ void operator()(const pg8::f32x4 (&acc)[2][2][4][2], const pg8::Unit& u, int wr, int wc, int fr, int fq) const {
        const int row0 = u.pm * 256 + wr * 64 + fr, col0 = u.pn * 256 + wc * 32 + 4 * fq;
#pragma unroll
        for (int ai = 0; ai < 2; ++ai)
#pragma unroll
            for (int m = 0; m < 4; ++m) { const int row = row0 + ai * 128 + m * 16;
                const size_t boff = (row < TL ? (size_t)row * DM : (size_t)(row - TL) * DM) + col0; const void* bsel = row < TL ? baseL : baseC;
                const float* gp = gate + (size_t)bidx_of_row(row) * 12288 + col0; bf16* op = out + (size_t)row * DM + col0;
#pragma unroll
                for (int bj = 0; bj < 2; ++bj)
#pragma unroll
                    for (int n = 0; n < 2; ++n) { const int o = bj * 128 + n * 16; pg8::f32x4 bs;
                        if constexpr (BASE16) { const u32x2 bw = *(const u32x2*)((const bf16*)bsel + boff + o); bs = (pg8::f32x4){bflo(bw.x), bfhi(bw.x), bflo(bw.y), bfhi(bw.y)}; }
                        else bs = *(const pg8::f32x4*)((const float*)bsel + boff + o);
                        const pg8::f32x4 g = *(const pg8::f32x4*)(gp + o); const pg8::f32x4 r = bs + g * acc[ai][bj][m][n];
                        u32x2 pw; pw.x = pk2(r[0], r[1]); pw.y = pk2(r[2], r[3]); *(u32x2*)(op + o) = pw; } }
    }
};
struct EpiSwiGLU {
    static constexpr bool PERM = true, AFTER_DRAIN = false;
    bf16* ACT;
    __device__ __forceinline__ void operator()(const pg8::f32x4 (&acc)[2][2][4][2], const pg8::Unit& u, int wr, int wc, int fr, int fq) const {
        const int row0 = u.pm * 256 + wr * 64 + fr, col0 = (u.pn & 3) * 128 + wc * 32 + 8 * fq;
#pragma unroll
        for (int ai = 0; ai < 2; ++ai)
#pragma unroll
            for (int m = 0; m < 4; ++m) { bf16* rowp = ACT + (size_t)(row0 + ai * 128 + m * 16) * 512 + col0; float r[8];
#pragma unroll
                for (int n = 0; n < 2; ++n)
#pragma unroll
                    for (int i = 0; i < 4; ++i) { const float a = acc[ai][0][m][n][i], b = acc[ai][1][m][n][i]; r[n * 4 + i] = siluf_(a) * b; }
                pg8::u32x4 w; w.x = pg8::cvt_pk_bf16(r[0], r[1]); w.y = pg8::cvt_pk_bf16(r[2], r[3]); w.z = pg8::cvt_pk_bf16(r[4], r[5]); w.w = pg8::cvt_pk_bf16(r[6], r[7]);
                *(pg8::u32x4*)rowp = w; }
    }
};
struct EpiDown {
    static constexpr bool PERM = true, AFTER_DRAIN = false;
    bf16* Yo; const float* lw; const LAS int* lcnt; const LAS int* rstart; const LAS int* tile_e; int nsh;
    __device__ __forceinline__ void operator()(const pg8::f32x4 (&acc)[2][2][4][2], const pg8::Unit& u, int wr, int wc, int fr, int fq) const {
        const int r0 = wr * 64 + fr, col0 = (u.pn & 7) * 256 + wc * 32 + 8 * fq;
        int e = 0, base = 0, cnt = 0; const bool shared = u.pm < nsh;
        if (!shared) { const int t = u.pm - nsh; e = tile_e[t]; base = t * 256 - rstart[e]; cnt = lcnt[e]; }
#pragma unroll
        for (int ai = 0; ai < 2; ++ai)
#pragma unroll
            for (int m = 0; m < 4; ++m) { const int r = r0 + ai * 128 + m * 16; const int pos = base + r;
                const float sw = shared ? 1.f : (pos < cnt ? lw[(size_t)e * TCAP + pos] : 0.f); bf16* rowp = Yo + (size_t)(u.pm * 256 + r) * DM + col0;
#pragma unroll
                for (int bj = 0; bj < 2; ++bj) { const pg8::f32x4 v0 = acc[ai][bj][m][0] * sw, v1 = acc[ai][bj][m][1] * sw;
                    pg8::u32x4 w; w.x = pg8::cvt_pk_bf16(v0[0], v0[1]); w.y = pg8::cvt_pk_bf16(v0[2], v0[3]); w.z = pg8::cvt_pk_bf16(v1[0], v1[1]); w.w = pg8::cvt_pk_bf16(v1[2], v1[3]);
                    *(pg8::u32x4*)(rowp + bj * 128) = w; } }
    }
};
#ifndef Y8MASK
#define Y8MASK 2
#endif
constexpr float Y8_SCALE = 8.f;
struct EpiDown8 {
    static constexpr bool PERM = true, AFTER_DRAIN = false;
    unsigned char* Yo;
    __device__ __forceinline__ void operator()(const pg8::f32x4 (&acc)[2][2][4][2], const pg8::Unit& u, int wr, int wc, int fr, int fq) const {
        const int r0 = u.pm * 256 + wr * 64 + fr, col0 = (u.pn & 7) * 256 + wc * 32 + 8 * fq;
#pragma unroll
        for (int ai = 0; ai < 2; ++ai)
#pragma unroll
            for (int m = 0; m < 4; ++m) { unsigned char* rowp = Yo + (size_t)(r0 + ai * 128 + m * 16) * DM + col0;
#pragma unroll
                for (int bj = 0; bj < 2; ++bj) { const pg8::f32x4 v0 = acc[ai][bj][m][0] * Y8_SCALE, v1 = acc[ai][bj][m][1] * Y8_SCALE;
                    int w0 = __builtin_amdgcn_cvt_pk_fp8_f32(v0[0], v0[1], 0, false); w0 = __builtin_amdgcn_cvt_pk_fp8_f32(v0[2], v0[3], w0, true);
                    int w1 = __builtin_amdgcn_cvt_pk_fp8_f32(v1[0], v1[1], 0, false); w1 = __builtin_amdgcn_cvt_pk_fp8_f32(v1[2], v1[3], w1, true);
                    u32x2 o; o.x = (unsigned)w0; o.y = (unsigned)w1; *(u32x2*)(rowp + bj * 128) = o; } }
    }
};
template <int LAYER> struct MoeAGather {
    static constexpr bool GATHER = true;
    const int* ltok; const LAS int* lcnt; const LAS int* rstart; const LAS int* tile_e;
    __device__ __forceinline__ unsigned rowoff(int pm, int R) const {
        constexpr int T = LAYER ? TL : TT; constexpr int NSH = T / 256;
        if (pm < NSH) return (unsigned)(pm * 256 + R) * 4096u;
        const int t = pm - NSH, e = tile_e[t], pos = t * 256 + R - rstart[e];
        return pos < lcnt[e] ? (unsigned)ltok[(size_t)e * TCAP + pos] * 4096u : (unsigned)T * 4096u;
    }
};
struct MoeOrder {
    int nsh, ntiles, nN, G, c; const LAS int* tile_e; const LAS int* xt_pm; int xt_n; const LAS int* lcnt; const LAS int* rstart;
    __device__ __forceinline__ bool next(int i, pg8::Unit& u) const {
        int pm, pnl;
        if (G == 256) { const int L = i * 32 + (c >> 3); if (L >= xt_n * nN) return false; const int t = L / nN; pnl = L - t * nN; pm = xt_pm[t]; }
        else { const int L = i * G + c; if (L >= ntiles * nN) return false; pm = L / nN; pnl = L - pm * nN; }
        int e = NE, hf = 0;
        if (pm >= nsh) { const int t = pm - nsh; e = tile_e[t]; hf = (lcnt[e] - (t * 256 - rstart[e]) <= 128) ? 1 : 0; }
        u.pm = pm; u.pn = e * nN + pnl; u.half = hf; return true;
    }
    __device__ __forceinline__ void a_ready(const pg8::Unit&) const {}
    __device__ __forceinline__ void done(const pg8::Unit&) const {}
};

template <int LAYER> __device__ __forceinline__ void phase_route(Frame& F, const Args& A) {
    constexpr int T = LAYER ? TL : TT;
    const float* modv = (const float*)(F.ws + WS_MODV * MiB) + (size_t)LAYER * 5 * 12288;
    const bf16* XR = (const bf16*)(F.ws + WS_XR * MiB); bf16* HA = (bf16*)(F.ws + WS_HA * MiB);
    const float* nw = ARG(LAYER ? 25 : 8); const float* rw = ARG(LAYER ? 32 : 16); const float* rbias = ARG(LAYER ? 33 : 17);
    int* cnt = (int*)(F.ctl + CW_CNT + LAYER * 64);
    int* ltok = (int*)(F.ws + WS_LTOK * MiB); float* lw = (float*)(F.ws + WS_LW * MiB); int* sele = (int*)(F.ws + WS_SELE * MiB); int* selp = (int*)(F.ws + WS_SELP * MiB);
    if (F.bid == 0 && F.tid < 256) { v4u z; z.x = z.y = z.z = z.w = 0u; *(v4u*)(HA + (size_t)T * DM + F.tid * 8) = z; }
    LAS float* h2s = (LAS float*)(F.lds); LAS float* parts = (LAS float*)(F.lds);
    const int w = F.wave;
    for (int grp = F.bid; grp < T / 16; grp += F.G) {
        int lane = F.lane; asm volatile("" : "+v"(lane));
        {
          const int m0 = 2 * w, row0 = grp * 16 + m0; const float* mv = modv + (size_t)bidx_of_row(row0) * 12288;
          const bf16* xr0 = XR + (size_t)row0 * DM;
          f32x4 xa[8], xb[8], cm[8], cs[8]; float ssa = 0.f, ssb = 0.f;
#pragma unroll
          for (int j = 0; j < 8; ++j) { const int c = j * 256 + lane * 4; const u32x2 wa = *(const u32x2*)(xr0 + c), wb = *(const u32x2*)(xr0 + DM + c);
              xa[j] = (f32x4){bflo(wa.x), bfhi(wa.x), bflo(wa.y), bfhi(wa.y)}; xb[j] = (f32x4){bflo(wb.x), bfhi(wb.x), bflo(wb.y), bfhi(wb.y)}; }
#pragma unroll
          for (int j = 0; j < 8; ++j) { const int c = j * 256 + lane * 4; const f32x4 w4 = *(const f32x4*)(nw + c), g4 = *(const f32x4*)(mv + 8192 + c); cs[j] = *(const f32x4*)(mv + 6144 + c); cm[j] = w4 * (g4 + 1.f); }
#pragma unroll
          for (int j = 0; j < 8; ++j) { ssa += (xa[j].x * xa[j].x + xa[j].y * xa[j].y) + (xa[j].z * xa[j].z + xa[j].w * xa[j].w); ssb += (xb[j].x * xb[j].x + xb[j].y * xb[j].y) + (xb[j].z * xb[j].z + xb[j].w * xb[j].w); }
#pragma unroll
          for (int o = 1; o < 64; o <<= 1) { ssa += __shfl_xor(ssa, o); ssb += __shfl_xor(ssb, o); }
          const float ra = 1.f / sqrtf(ssa * (1.f / 2048.f) + EPS), rb = 1.f / sqrtf(ssb * (1.f / 2048.f) + EPS);
#pragma unroll
          for (int j = 0; j < 8; ++j) { const int c = j * 256 + lane * 4; const f32x4 oa = xa[j] * ra * cm[j] + cs[j], ob = xb[j] * rb * cm[j] + cs[j];
              *(LAS f32x4*)(h2s + m0 * 2048 + ((c + 4 * m0) & 2047)) = oa; *(LAS f32x4*)(h2s + (m0 + 1) * 2048 + ((c + 4 * (m0 + 1)) & 2047)) = ob;
              uint2 pa; pa.x = pk2(oa.x, oa.y); pa.y = pk2(oa.z, oa.w); *(uint2*)(HA + (size_t)row0 * DM + c) = pa;
              uint2 pb; pb.x = pk2(ob.x, ob.y); pb.y = pk2(ob.z, ob.w); *(uint2*)(HA + (size_t)(row0 + 1) * DM + c) = pb; } }
        __syncthreads();
        f32x4 acc[4];
#pragma unroll
        for (int c = 0; c < 4; ++c) acc[c] = (f32x4){0.f, 0.f, 0.f, 0.f};
        { const int m = lane & 15, kq = lane >> 4;
          const float* rwp = rw + (size_t)(w * 256 + kq) * 64 + m * 4;
          f32x4 bc[16], bn[16];
#pragma unroll
          for (int u = 0; u < 16; ++u) bc[u] = *(const f32x4*)(rwp + (size_t)(4 * u) * 64);
#pragma unroll 1
          for (int s0 = 0; s0 < 64; s0 += 16) {
              if (s0 + 16 < 64) {
#pragma unroll
                  for (int u = 0; u < 16; ++u) bn[u] = *(const f32x4*)(rwp + (size_t)(4 * (s0 + 16 + u)) * 64); }
#pragma unroll
              for (int u = 0; u < 16; ++u) { const int kk = w * 256 + 4 * (s0 + u) + kq; const float av = h2s[m * 2048 + ((kk + 4 * m) & 2047)]; const f32x4 bv = bc[u];
                  acc[0] = __builtin_amdgcn_mfma_f32_16x16x4f32(av, bv.x, acc[0], 0, 0, 0); acc[1] = __builtin_amdgcn_mfma_f32_16x16x4f32(av, bv.y, acc[1], 0, 0, 0);
                  acc[2] = __builtin_amdgcn_mfma_f32_16x16x4f32(av, bv.z, acc[2], 0, 0, 0); acc[3] = __builtin_amdgcn_mfma_f32_16x16x4f32(av, bv.w, acc[3], 0, 0, 0); }
#pragma unroll
              for (int u = 0; u < 16; ++u) bc[u] = bn[u];
          } }
        __syncthreads();
#pragma unroll
        for (int c = 0; c < 4; ++c)
#pragma unroll
            for (int i = 0; i < 4; ++i) parts[(w * 16 + 4 * (lane >> 4) + i) * 64 + 4 * (lane & 15) + c] = acc[c][i];
        __syncthreads();
        {
          float score[2], biased[2], gsum[2], mb[2]; int rg[2], gr[2], er[2]; bool gsel[2];
#pragma unroll
          for (int rr = 0; rr < 2; ++rr) { const int mrow = 2 * w + rr; float logit = 0.f;
#pragma unroll
              for (int ww = 0; ww < 8; ++ww) logit += parts[(ww * 16 + mrow) * 64 + lane];
              score[rr] = 1.f / (1.f + expf(-logit)); biased[rr] = score[rr] + rbias[lane]; rg[rr] = 0; gr[rr] = 0; er[rr] = 0; }
#pragma unroll
          for (int j = 1; j < 8; ++j) { const int ol = (lane & ~7) | ((lane + j) & 7);
#pragma unroll
              for (int rr = 0; rr < 2; ++rr) { const float ob = __shfl(biased[rr], ol); rg[rr] += (ob > biased[rr] || (ob == biased[rr] && ol < lane)) ? 1 : 0; } }
#pragma unroll
          for (int rr = 0; rr < 2; ++rr) gsum[rr] = rg[rr] < 2 ? biased[rr] : 0.f;
#pragma unroll
          for (int o = 1; o < 8; o <<= 1) { gsum[0] += __shfl_xor(gsum[0], o); gsum[1] += __shfl_xor(gsum[1], o); }
          const int g = lane >> 3;
#pragma unroll
          for (int j = 0; j < 8; ++j) {
#pragma unroll
              for (int rr = 0; rr < 2; ++rr) { const float og = __shfl(gsum[rr], j * 8); gr[rr] += (j != g && (og > gsum[rr] || (og == gsum[rr] && j < g))) ? 1 : 0; } }
#pragma unroll
          for (int rr = 0; rr < 2; ++rr) { gsel[rr] = gr[rr] < 4; mb[rr] = gsel[rr] ? biased[rr] : -__builtin_inff(); }
#pragma unroll 1
          for (int j = 0; j < 64; ++j) { const float o0 = __uint_as_float(__builtin_amdgcn_readlane(__float_as_uint(mb[0]), j)), o1 = __uint_as_float(__builtin_amdgcn_readlane(__float_as_uint(mb[1]), j));
              er[0] += (o0 > mb[0] || (o0 == mb[0] && j < lane)) ? 1 : 0; er[1] += (o1 > mb[1] || (o1 == mb[1] && j < lane)) ? 1 : 0; }
#pragma unroll
          for (int rr = 0; rr < 2; ++rr) { const int row = grp * 16 + 2 * w + rr; const bool sel = gsel[rr] && er[rr] < 8;
              const float wsum = wave_sum(sel ? score[rr] : 0.f); const float wt = score[rr] / wsum * 2.5f;
              const unsigned long long mk = __ballot(sel); const int kidx = __popcll(mk & ((1ull << lane) - 1ull));
              if (sel) { const int pos = atomicAdd(&cnt[lane], 1); ltok[(size_t)lane * TCAP + pos] = row; lw[(size_t)lane * TCAP + pos] = wt; sele[(size_t)row * 8 + kidx] = lane; selp[(size_t)row * 8 + kidx] = pos; } }
        }
        __syncthreads();
    }
}
template <int LAYER> __device__ __forceinline__ int moe_tables(Frame& F) {
    LAS int* lcnt = (LAS int*)(F.lds + L_CNT); LAS int* rstart = (LAS int*)(F.lds + L_RSTART); LAS int* tile_e = (LAS int*)(F.lds + L_TILEE);
    const int* cnt = (const int*)(F.ctl + CW_CNT + LAYER * 64);
    __syncthreads();
    if (F.tid < 64) { const int c = __hip_atomic_load(cnt + F.tid, __ATOMIC_RELAXED, __HIP_MEMORY_SCOPE_AGENT); const int p = (c + 255) & ~255; int incl = p;
#pragma unroll
        for (int o = 1; o < 64; o <<= 1) { const int v = __shfl_up(incl, o); if (F.lane >= o) incl += v; }
        lcnt[F.tid] = c; rstart[F.tid] = incl - p; if (F.tid == 63) rstart[64] = incl; }
    __syncthreads();
    const int total = rstart[64];
    for (int t = F.tid; t < (total >> 8); t += 512) { const int r = t << 8; int e = 0;
#pragma unroll 1
        for (int q = 1; q < 64; ++q) e += (rstart[q] <= r) ? 1 : 0;
        tile_e[t] = e; }
    if (F.tid == 0) {
        constexpr int NSH = (LAYER ? TL : TT) / 256; LAS int* xt = (LAS int*)(F.lds + L_XT); const int x = F.bid & 7; int n = 0;
#pragma unroll 1
        for (int pm = x; pm < NSH; pm += 8) xt[n++] = pm;
#pragma unroll 1
        for (int e = x; e < 64; e += 8) { const int t0 = rstart[e] >> 8, t1 = rstart[e + 1] >> 8;
#pragma unroll 1
            for (int t = t0; t < t1; ++t) xt[n++] = NSH + t; }
        *(LAS int*)(F.lds + L_XTN) = n; }
    __syncthreads();
    return total;
}
template <int LAYER> __device__ __forceinline__ void phase_moe_gemm1(Frame& F) {
    constexpr int T = LAYER ? TL : TT;
    const int total = moe_tables<LAYER>(F);
    pg8::Gemm g{(const bf16*)(F.ws + WS_HA * MiB), (const bf16*)(F.ws + (LAYER ? WS_GU1 : WS_GU0) * MiB), 0, 1024, 2048};
    MoeOrder S{T / 256, T / 256 + (total >> 8), 4, F.G, F.bid, (const LAS int*)(F.lds + L_TILEE), (const LAS int*)(F.lds + L_XT), *(const LAS int*)(F.lds + L_XTN), (const LAS int*)(F.lds + L_CNT), (const LAS int*)(F.lds + L_RSTART)};
    EpiSwiGLU E{(bf16*)(F.ws + WS_ACT * MiB)};
    MoeAGather<LAYER> AM{(const int*)(F.ws + WS_LTOK * MiB), (const LAS int*)(F.lds + L_CNT), (const LAS int*)(F.lds + L_RSTART), (const LAS int*)(F.lds + L_TILEE)};
    pg8::gemm_phase<EpiSwiGLU, MoeOrder, true, true, MoeAGather<LAYER>>(F.lds, g, S, E, AM);
}
template <int LAYER> __device__ __forceinline__ void phase_moe_gemm2(Frame& F) {
    constexpr int T = LAYER ? TL : TT;
    const int total = moe_tables<LAYER>(F);
    pg8::Gemm g{(const bf16*)(F.ws + WS_ACT * MiB), (const bf16*)(F.ws + (LAYER ? WS_DN1 : WS_DN0) * MiB), 0, 2048, 512};
    MoeOrder S{T / 256, T / 256 + (total >> 8), 8, F.G, F.bid, (const LAS int*)(F.lds + L_TILEE), (const LAS int*)(F.lds + L_XT), *(const LAS int*)(F.lds + L_XTN), (const LAS int*)(F.lds + L_CNT), (const LAS int*)(F.lds + L_RSTART)};
    EpiDown E{(bf16*)(F.ws + WS_HA * MiB), (const float*)(F.ws + WS_LW * MiB), (const LAS int*)(F.lds + L_CNT), (const LAS int*)(F.lds + L_RSTART), (const LAS int*)(F.lds + L_TILEE), T / 256};
    if constexpr ((Y8MASK >> LAYER) & 1) { EpiDown8 E8{(unsigned char*)(F.ws + WS_HA * MiB)};
        pg8::gemm_phase<EpiDown8, MoeOrder, true, true>(F.lds, g, S, E8); }
    else pg8::gemm_phase<EpiDown, MoeOrder, true, true>(F.lds, g, S, E);
}
template <int LAYER> __device__ __forceinline__ void phase_combine(Frame& F, const Args& A) {
    constexpr int T = LAYER ? TL : TT;
    (void)moe_tables<LAYER>(F);
    const LAS int* rstart = (const LAS int*)(F.lds + L_RSTART);
    const bf16* Yb = (const bf16*)(F.ws + WS_HA * MiB); bf16* XR = (bf16*)(F.ws + WS_XR * MiB); bf16* H = (bf16*)(F.ws + WS_H * MiB);
    const int* sele = (const int*)(F.ws + WS_SELE * MiB); const int* selp = (const int*)(F.ws + WS_SELP * MiB); const float* lwp = (const float*)(F.ws + WS_LW * MiB);
    const float* modv = (const float*)(F.ws + WS_MODV * MiB);
    const int gw = F.bid * NWAVES + F.wave, NGW = F.G * NWAVES, lane = F.lane;
    for (int row = gw; row < T; row += NGW) {
        int rws[9]; float rwt[9]; rws[0] = row; rwt[0] = 1.f;
#pragma unroll
        for (int k = 0; k < 8; ++k) { const int e = sele[(size_t)row * 8 + k], pos = selp[(size_t)row * 8 + k]; rws[k + 1] = T + rstart[e] + pos; rwt[k + 1] = lwp[(size_t)e * TCAP + pos]; }
        const float* gate = modv + (size_t)(LAYER * 5 + bidx_of_row(row)) * 12288 + 10240;
        float xv[4][8]; float ss = 0.f;
#pragma unroll
        for (int j = 0; j < 4; ++j) { const int c0 = j * 512 + lane * 8; float s[8];
#pragma unroll
            for (int e = 0; e < 8; ++e) s[e] = 0.f;
#pragma unroll
            for (int k = 0; k < 9; ++k) { float yf[8];
                if constexpr ((Y8MASK >> LAYER) & 1) { const uint2 y8 = *(const uint2*)((const unsigned char*)Yb + (size_t)rws[k] * DM + c0);
                    typedef float f2_t __attribute__((ext_vector_type(2)));
                    const f2_t p0 = __builtin_amdgcn_cvt_pk_f32_fp8((int)y8.x, false), p1 = __builtin_amdgcn_cvt_pk_f32_fp8((int)y8.x, true), p2 = __builtin_amdgcn_cvt_pk_f32_fp8((int)y8.y, false), p3 = __builtin_amdgcn_cvt_pk_f32_fp8((int)y8.y, true);
                    yf[0] = p0.x * (1.f / Y8_SCALE); yf[1] = p0.y * (1.f / Y8_SCALE); yf[2] = p1.x * (1.f / Y8_SCALE); yf[3] = p1.y * (1.f / Y8_SCALE); yf[4] = p2.x * (1.f / Y8_SCALE); yf[5] = p2.y * (1.f / Y8_SCALE); yf[6] = p3.x * (1.f / Y8_SCALE); yf[7] = p3.y * (1.f / Y8_SCALE); }
                else { const v4u yw = *(const v4u*)(Yb + (size_t)rws[k] * DM + c0); unpack8(yw, yf); }
#pragma unroll
                for (int e = 0; e < 8; ++e) s[e] += rwt[k] * yf[e]; }
            float xin_[8]; unpack8(*(const v4u*)(XR + (size_t)row * DM + c0), xin_); const f32x4 x0 = {xin_[0], xin_[1], xin_[2], xin_[3]}, x1 = {xin_[4], xin_[5], xin_[6], xin_[7]};
            const f32x4 g0 = *(const f32x4*)(gate + c0), g1 = *(const f32x4*)(gate + c0 + 4);
            xv[j][0] = x0.x + g0.x * s[0]; xv[j][1] = x0.y + g0.y * s[1]; xv[j][2] = x0.z + g0.z * s[2]; xv[j][3] = x0.w + g0.w * s[3];
            xv[j][4] = x1.x + g1.x * s[4]; xv[j][5] = x1.y + g1.y * s[5]; xv[j][6] = x1.z + g1.z * s[6]; xv[j][7] = x1.w + g1.w * s[7];
#pragma unroll
            for (int e = 0; e < 8; ++e) ss += xv[j][e] * xv[j][e];
            if (LAYER) { float* op = ARG_OUT() + (size_t)row * DM + c0; *(f32x4*)op = (f32x4){xv[j][0], xv[j][1], xv[j][2], xv[j][3]}; *(f32x4*)(op + 4) = (f32x4){xv[j][4], xv[j][5], xv[j][6], xv[j][7]}; }
            else *(v4u*)(XR + (size_t)row * DM + c0) = pack8(xv[j]);
        }
        if (LAYER == 0) {
            const float rstd = 1.f / sqrtf(wave_sum(ss) * (1.f / 2048.f) + EPS);
            const float* mv = modv + (size_t)(5 + bidx_of_row(row)) * 12288; const float* nw = ARG(24);
#pragma unroll
            for (int j = 0; j < 4; ++j) { const int c0 = j * 512 + lane * 8; float o[8];
#pragma unroll
                for (int e = 0; e < 8; ++e) o[e] = xv[j][e] * rstd * nw[c0 + e] * (1.f + mv[2048 + c0 + e]) + mv[c0 + e];
                *(v4u*)(H + (size_t)row * DM + c0) = pack8(o); }
        }
    }
}

__device__ __forceinline__ void phase_qkprep1(Frame& F, const Args& A) {
    const bf16* QKV = (const bf16*)(F.ws + WS_QKV * MiB); bf16* Qo = (bf16*)(F.ws + WS_Q * MiB); bf16* Ko = (bf16*)(F.ws + WS_K * MiB); bf16* Vo = (bf16*)(F.ws + WS_V * MiB);
    const int gw = F.bid * NWAVES + F.wave, NGW = F.G * NWAVES, lane = F.lane;
    const int j16 = lane & 15;
    for (int row = gw; row < TT; row += NGW) {
        const bool lat = row < TL; int b, t, key;
        if (lat) { b = row >> 11; t = row & 2047; key = t; } else { const int rr = row - TL; b = rr >> 8; t = rr & 255; key = SEQ + t; }
        const float prow = (float)(t >> 6), pcol = (float)(t & 63);
        v4u xin[12];
#pragma unroll
        for (int p = 0; p < 12; ++p) xin[p] = (p < 4 && !lat) ? (v4u){0u, 0u, 0u, 0u} : *(const v4u*)(QKV + (size_t)row * N1 + p * 512 + lane * 8);
#pragma unroll
        for (int p = 0; p < 8; ++p) {
            if (p < 4 && !lat) continue;
            const int isk = p >> 2; const int hs = (p & 3) * 4 + (lane >> 4), h = hs >> 1, s = hs & 1;
            float x[8]; unpack8(xin[p], x);
            float ss = 0.f;
#pragma unroll
            for (int e = 0; e < 8; ++e) ss += x[e] * x[e];
            ss += __shfl_xor(ss, 1); ss += __shfl_xor(ss, 2); ss += __shfl_xor(ss, 4); ss += __shfl_xor(ss, 8);
            const float rstd = 1.f / sqrtf(ss * (1.f / 128.f) + EPS);
            const float* nw = ARG(isk ? 28 : 27) + j16 * 8;
#pragma unroll
            for (int e = 0; e < 8; ++e) x[e] = x[e] * rstd * nw[e];
            if (lat) {
                const float pos = (j16 & 8) ? pcol : prow; const bool second = (j16 & 4) != 0;
#pragma unroll
                for (int e = 0; e < 8; ++e) { const float other = __shfl_xor(x[e], 4); const int fi = 8 * (j16 & 3) + e;
                    const float inv_freq = __expf(-(float)fi * (9.210340371976184f / 32.f)); const float ang = pos * inv_freq; const float cs = __cosf(ang), sn = __sinf(ang);
                    x[e] = second ? (x[e] * cs + other * sn) : (x[e] * cs - other * sn); }
            }
            bf16* dst = isk ? Ko + ((size_t)((b * 8 + h) * 2 + s) * 2304 + key) * 128 + j16 * 8 : Qo + ((size_t)((b * 8 + h) * 2 + s) * 2048 + t) * 128 + j16 * 8;
            *(v4u*)dst = pack8(x);
        }
#pragma unroll
        for (int p = 0; p < 4; ++p) { const int c0 = p * 512 + lane * 8, h = c0 >> 8, dv = c0 & 255;
            *(v4u*)(Vo + ((size_t)((b * 8 + h) * 2 + (dv >> 7)) * 2304 + key) * 128 + (dv & 127)) = xin[8 + p]; }
    }
}
__device__ __forceinline__ void phase_attn1(Frame& F) {
    const att::bf16* Qo = (const att::bf16*)(F.ws + WS_Q * MiB); const att::bf16* Ko = (const att::bf16*)(F.ws + WS_K * MiB); const att::bf16* Vo = (const att::bf16*)(F.ws + WS_V * MiB);
    att::bf16* OA = (att::bf16*)(F.ws + WS_OATT * MiB);
#pragma unroll 1
    for (int i = 0; i < 4; ++i) {
        const int x = F.bid & 7, j = F.bid >> 3; const int grp = (8 * x + 2 * i + (j >> 4)) & 63, qb = j & 15, s = grp & 1, bh = grp >> 1;
        att::attn_pair_body(Qo + ((size_t)(bh * 2 + s) * 2048 + qb * 128) * 128, Ko + (size_t)(bh * 2 + s) * 2304 * 128, Vo + (size_t)(bh * 2) * 2304 * 128, Vo + (size_t)(bh * 2 + 1) * 2304 * 128,
                            OA + ((size_t)((s * 32 + bh) * 2) * 2048 + qb * 128) * 128, OA + ((size_t)((s * 32 + bh) * 2 + 1) * 2048 + qb * 128) * 128, 2304, F.lds);
        __syncthreads();
    }
}
__device__ __forceinline__ void phase_attncomb1(Frame& F, const Args& A) {
    const bf16* OA = (const bf16*)(F.ws + WS_OATT * MiB); bf16* Y = (bf16*)(F.ws + WS_Y * MiB);
    const int gw = F.bid * NWAVES + F.wave, NGW = F.G * NWAVES, lane = F.lane;
    const float* lam = ARG(29);
    const float s01 = wave_sum(lam[lane] * lam[128 + lane] + lam[64 + lane] * lam[192 + lane]);
    const float s23 = wave_sum(lam[256 + lane] * lam[384 + lane] + lam[320 + lane] * lam[448 + lane]);
    const float lmbda = expf(s01) - expf(s23) + LAM_INIT;
    const f32x4 sn = *(const f32x4*)(ARG(30) + lane * 4);
    for (int row = gw; row < TL; row += NGW) { const int b = row >> 11, t = row & 2047;
        uint2 win[8][2];
#pragma unroll
        for (int h = 0; h < 8; ++h) { const size_t oo = ((size_t)((b * 8 + h) * 2 + (lane >> 5)) * 2048 + t) * 128 + (lane & 31) * 4;
            win[h][0] = *(const uint2*)(OA + oo); win[h][1] = *(const uint2*)(OA + (size_t)64 * 2048 * 128 + oo); }
#pragma unroll
        for (int h = 0; h < 8; ++h) {
            const uint2 w0 = win[h][0], w1 = win[h][1];
            const f32x4 o0 = {bflo(w0.x), bfhi(w0.x), bflo(w0.y), bfhi(w0.y)}, o1 = {bflo(w1.x), bfhi(w1.x), bflo(w1.y), bfhi(w1.y)};
            const f32x4 o = o0 - o1 * lmbda;
            const float ss = wave_sum((o.x * o.x + o.y * o.y) + (o.z * o.z + o.w * o.w));
            const float rstd = 1.f / sqrtf(ss * (1.f / 256.f) + EPS) * (1.f - LAM_INIT);
            uint2 w; w.x = pk2(o.x * rstd * sn.x, o.y * rstd * sn.y); w.y = pk2(o.z * rstd * sn.z, o.w * rstd * sn.w);
            *(uint2*)(Y + (size_t)row * DM + h * 256 + lane * 4) = w;
        }
    }
}

#ifndef PHM
#define PHM 0xffffffffu
#endif
#ifndef REPM
#define REPM 0u
#endif
__global__ void __launch_bounds__(NWAVES * 64, 2) mega_fwd(Args args) {
    extern __shared__ __attribute__((aligned(16))) unsigned char lds[];
    Frame F;
    F.lds = (LAS unsigned char*)lds; F.ldsg = lds;
    F.tid = threadIdx.x; F.lane = F.tid & 63; F.wave = __builtin_amdgcn_readfirstlane(F.tid >> 6);
    F.G = gridDim.x; F.bid = blockIdx.x; F.ws = args.ws; F.ctl = (gu32*)(args.ws + WS_CTL);
    for (int u = F.tid; u < (LDS_BYTES - LDSCTL_OFF) / 4; u += NWAVES * 64) ((LAS unsigned*)(F.lds + LDSCTL_OFF))[u] = 0u;
    __syncthreads();
    XcdBarrier bar = xcd_barrier_post((unsigned*)(F.ctl + CW_BAR), (volatile LAS unsigned*)(F.lds + L_MISC));
    unsigned char* ws = args.ws;
#define GRID_BAR() do { xcd_barrier(bar); int t_ = threadIdx.x; asm volatile("" : "+v"(t_)); F.tid = t_; F.lane = t_ & 63; F.wave = __builtin_amdgcn_readfirstlane(t_ >> 6); } while (0)

#if (PHM >> 0) & 1
    phase_mod(F, args);
    __syncthreads();
    phase_convert(F, args);
#endif
#if (REPM >> 0) & 1
    GRID_BAR();
    phase_mod(F, args);
    __syncthreads();
    phase_convert(F, args);
#endif
    GRID_BAR();
#if (PHM >> 1) & 1
    phase_norm0(F, args);
#endif
#if (REPM >> 1) & 1
    GRID_BAR();
    phase_norm0(F, args);
#endif
    GRID_BAR();
#if (PHM >> 2) & 1
    { pg8::Gemm g{(const bf16*)(ws + WS_H * MiB), (const bf16*)(ws + WS_WIN0 * MiB), TT, N0P, 2048}; pg8::StaticOrder S; S.init(TT, N0P, F.G, F.bid);
      EpiProj0 E{(bf16*)(ws + WS_PROJ0 * MiB)};
      pg8::gemm_phase<EpiProj0, pg8::StaticOrder, true, true>(F.lds, g, S, E); }
    if (F.G == 256) phase_tail_fill(F, 0, F.bid < (36 * 37) % 256, (36 * 37) % 256);
#endif
#if (REPM >> 2) & 1
    GRID_BAR();
    { pg8::Gemm g{(const bf16*)(ws + WS_H * MiB), (const bf16*)(ws + WS_WIN0 * MiB), TT, N0P, 2048}; pg8::StaticOrder S; S.init(TT, N0P, F.G, F.bid);
      EpiProj0 E{(bf16*)(ws + WS_PROJ0 * MiB)};
      pg8::gemm_phase<EpiProj0, pg8::StaticOrder, true, true>(F.lds, g, S, E); }
#endif
    GRID_BAR();
#if (PHM >> 3) & 1
    phase_s1_dn(F);
    phase_s1_hg(F);
    if (F.G == 256) phase_tail_fill(F, 1, F.bid < 128, 128);
#endif
#if (REPM >> 3) & 1
    GRID_BAR();
    phase_s1_dn(F);
    phase_s1_hg(F);
#endif
    GRID_BAR();
#if (PHM >> 4) & 1
    phase_s2(F);
    if (F.G == 256) phase_tail_fill(F, 2, F.bid < 128, 128);
#endif
#if (REPM >> 4) & 1
    GRID_BAR();
    phase_s2(F);
#endif
    GRID_BAR();
#if (PHM >> 5) & 1
    phase_outnorm0(F, args);
#endif
#if (REPM >> 5) & 1
    GRID_BAR();
    phase_outnorm0(F, args);
#endif
    GRID_BAR();
#if (PHM >> 6) & 1
    { pg8::Gemm g{(const bf16*)(ws + WS_Y * MiB), (const bf16*)(ws + WS_WOUT0 * MiB), TT, 2048, 2048}; pg8::StaticOrder S; S.init(TT, 2048, F.G, F.bid);
      EpiResidT<false> E{ARG(0), ARG(2), (bf16*)(ws + WS_XR * MiB), (const float*)(ws + WS_MODV * MiB) + 4096};
      pg8::gemm_phase<EpiResidT<false>, pg8::StaticOrder, true, true>(F.lds, g, S, E); }
    if (F.G == 256) phase_tail_fill(F, 3, F.bid < (36 * 8) % 256, (36 * 8) % 256);
#endif
#if (REPM >> 6) & 1
    GRID_BAR();
    { pg8::Gemm g{(const bf16*)(ws + WS_Y * MiB), (const bf16*)(ws + WS_WOUT0 * MiB), TT, 2048, 2048}; pg8::StaticOrder S; S.init(TT, 2048, F.G, F.bid);
      EpiResidT<false> E{ARG(0), ARG(2), (bf16*)(ws + WS_XR * MiB), (const float*)(ws + WS_MODV * MiB) + 4096};
      pg8::gemm_phase<EpiResidT<false>, pg8::StaticOrder, true, true>(F.lds, g, S, E); }
#endif
    GRID_BAR();
#if (PHM >> 7) & 1
    phase_route<0>(F, args);
    convert_queue(F, CVQ_L0END, nullptr, 0u);
#endif
#if (REPM >> 7) & 1
    GRID_BAR();
    phase_route<0>(F, args);
#endif
    GRID_BAR();
#if (PHM >> 9) & 1
    phase_moe_gemm1<0>(F);
#endif
#if (REPM >> 9) & 1
    GRID_BAR();
    phase_moe_gemm1<0>(F);
#endif
    GRID_BAR();
#if (PHM >> 10) & 1
    phase_moe_gemm2<0>(F);
#endif
#if (REPM >> 10) & 1
    GRID_BAR();
    phase_moe_gemm2<0>(F);
#endif
    GRID_BAR();
#if (PHM >> 11) & 1
    phase_combine<0>(F, args);
    __syncthreads();
    convert_queue(F, CVQ_IN1END, nullptr, 0u);
#endif
#if (REPM >> 11) & 1
    GRID_BAR();
    phase_combine<0>(F, args);
#endif
    GRID_BAR();
#if (PHM >> 12) & 1
    { pg8::Gemm g{(const bf16*)(ws + WS_H * MiB), (const bf16*)(ws + WS_WIN1 * MiB), TT, N1, 2048}; pg8::StaticOrder S; S.init(TT, N1, F.G, F.bid);
      pg8::EpiBf16<0> E{(bf16*)(ws + WS_QKV * MiB), N1, nullptr, 0, 0, 1.f};
      pg8::gemm_phase<pg8::EpiBf16<0>, pg8::StaticOrder, true, true>(F.lds, g, S, E); }
    if (F.G == 256) phase_tail_fill(F, 4, F.bid < (36 * 24) % 256, (36 * 24) % 256);
#endif
#if (REPM >> 12) & 1
    GRID_BAR();
    { pg8::Gemm g{(const bf16*)(ws + WS_H * MiB), (const bf16*)(ws + WS_WIN1 * MiB), TT, N1, 2048}; pg8::StaticOrder S; S.init(TT, N1, F.G, F.bid);
      pg8::EpiBf16<0> E{(bf16*)(ws + WS_QKV * MiB), N1, nullptr, 0, 0, 1.f};
      pg8::gemm_phase<pg8::EpiBf16<0>, pg8::StaticOrder, true, true>(F.lds, g, S, E); }
#endif
    GRID_BAR();
#if (PHM >> 13) & 1
    phase_qkprep1(F, args);
#endif
#if (REPM >> 13) & 1
    GRID_BAR();
    phase_qkprep1(F, args);
#endif
    GRID_BAR();
#if (PHM >> 14) & 1
    phase_attn1(F);
#endif
#if (REPM >> 14) & 1
    GRID_BAR();
    phase_attn1(F);
#endif
    GRID_BAR();
#if (PHM >> 15) & 1
    phase_attncomb1(F, args);
#endif
#if (REPM >> 15) & 1
    GRID_BAR();
    phase_attncomb1(F, args);
#endif
    GRID_BAR();
#if (PHM >> 16) & 1
    { pg8::Gemm g{(const bf16*)(ws + WS_Y * MiB), (const bf16*)(ws + WS_WOUT1 * MiB), TL, 2048, 2048}; pg8::StaticOrder S; S.init(TL, 2048, F.G, F.bid);
      EpiResidT<true> E{(const bf16*)(ws + WS_XR * MiB), (const bf16*)(ws + WS_XR * MiB) + (size_t)TL * DM, (bf16*)(ws + WS_XR * MiB), (const float*)(ws + WS_MODV * MiB) + (size_t)5 * 12288 + 4096};
      pg8::gemm_phase<EpiResidT<true>, pg8::StaticOrder, true, true>(F.lds, g, S, E); }
#endif
#if (REPM >> 16) & 1
    GRID_BAR();
    { pg8::Gemm g{(const bf16*)(ws + WS_Y * MiB), (const bf16*)(ws + WS_WOUT1 * MiB), TL, 2048, 2048}; pg8::StaticOrder S; S.init(TL, 2048, F.G, F.bid);
      EpiResidT<true> E{(const bf16*)(ws + WS_XR * MiB), (const bf16*)(ws + WS_XR * MiB) + (size_t)TL * DM, (bf16*)(ws + WS_XR * MiB), (const float*)(ws + WS_MODV * MiB) + (size_t)5 * 12288 + 4096};
      pg8::gemm_phase<EpiResidT<true>, pg8::StaticOrder, true, true>(F.lds, g, S, E); }
#endif
    GRID_BAR();
#if (PHM >> 17) & 1
    phase_route<1>(F, args);
    convert_queue(F, CVQ_END, nullptr, 0u);
#endif
#if (REPM >> 17) & 1
    GRID_BAR();
    phase_route<1>(F, args);
#endif
    GRID_BAR();
#if (PHM >> 19) & 1
    phase_moe_gemm1<1>(F);
#endif
#if (REPM >> 19) & 1
    GRID_BAR();
    phase_moe_gemm1<1>(F);
#endif
    GRID_BAR();
#if (PHM >> 20) & 1
    phase_moe_gemm2<1>(F);
#endif
#if (REPM >> 20) & 1
    GRID_BAR();
    phase_moe_gemm2<1>(F);
#endif
    GRID_BAR();
#if (PHM >> 21) & 1
    phase_combine<1>(F, args);

#endif
#if (REPM >> 21) & 1
    GRID_BAR();
    phase_combine<1>(F, args);

#endif
#undef GRID_BAR
}

extern "C" void kernel_launch(void* const* d_in, const int* in_sizes, int n_in, void* d_out, int out_size, void* d_ws, size_t ws_size, hipStream_t stream) {
    static int grid = 0;
    if (grid == 0) {
        if (n_in != 38 || out_size != TL * DM || ws_size < WS_END * MiB) { fprintf(stderr, "kernel_launch: shape mismatch n_in %d out %d ws %zu\n", n_in, out_size, ws_size); grid = -1; return; }
        int dev = 0, cus = 0, per_cu = 0;
        if (hipGetDevice(&dev) != hipSuccess || hipDeviceGetAttribute(&cus, hipDeviceAttributeMultiprocessorCount, dev) != hipSuccess) { grid = -1; return; }
        if (hipFuncSetAttribute((const void*)mega_fwd, hipFuncAttributeMaxDynamicSharedMemorySize, LDS_BYTES) != hipSuccess) { fprintf(stderr, "kernel_launch: hipFuncSetAttribute failed\n"); grid = -1; return; }
        if (hipOccupancyMaxActiveBlocksPerMultiprocessor(&per_cu, (const void*)mega_fwd, NWAVES * 64, LDS_BYTES) != hipSuccess || per_cu < 1)
            fprintf(stderr, "kernel_launch: occupancy query reports %d workgroups per CU\n", per_cu);
        (void)hipGetLastError();
        grid = cus;
    }
    if (grid < 0) return;
    if (hipMemsetAsync((char*)d_ws + WS_CTL, 0, CTL_ZERO_BYTES, stream) != hipSuccess) return;
    Args a{};
    for (int i = 0; i < 38; ++i) a.in[i] = (const float*)d_in[i];
    a.out = (float*)d_out; a.ws = (unsigned char*)d_ws;
    hipLaunchKernelGGL(mega_fwd, dim3(grid), dim3(NWAVES * 64), LDS_BYTES, stream, a);
}
```

```cpp
#define Y8MASK 3
#include <hip/hip_bf16.h>
#include <hip/hip_runtime.h>
#include <cstdio>
#include <cstdint>
namespace pg8 {
#define PG8_LAS __attribute__((address_space(3)))
typedef unsigned short bf16_t;
typedef short bf16x8 __attribute__((ext_vector_type(8)));
typedef float f32x4 __attribute__((ext_vector_type(4)));
typedef unsigned u32x4 __attribute__((ext_vector_type(4)));
constexpr int BM = 256, BK = 64, HALF = 128, HTB = HALF * BK * 2  , STAGE_BYTES = 8 * HTB, NXCD = 8, WGM = 8;

__host__ __device__ __forceinline__ int lds_byte(int r, int c) { const int st = (r >> 4) * 2 + (c >> 5), rr = r & 15, cc = c & 31, ob = rr * 64 + cc * 2; return st * 1024 + (ob ^ (((ob >> 9) & 1) << 5)); }
__host__ __device__ __forceinline__ void stage_rc(int b, int& R, int& C) { const int st = b / 1024, sb = b % 1024, swz = sb ^ (((sb >> 9) & 1) << 5); R = (st >> 1) * 16 + swz / 64; C = (st & 1) * 32 + (swz % 64) / 2; }
__host__ __device__ __forceinline__ int perm32(int rho) { const int n = rho >> 4, i = rho & 15; return 8 * (i >> 2) + 4 * n + (i & 3); }

struct Unit { int pm, pn, half; };
struct Gemm { const bf16_t* A; const bf16_t* Bt; int M, N, K; };

struct StaticOrder {
    int nM, nN, nwg, G, c;
    __host__ __device__ void init(int M, int N, int G_, int c_) { nM = M / BM; nN = N / BM; nwg = nM * nN; G = G_; c = c_; }
    __host__ __device__ bool next(int i, Unit& u) const {
        const long L = (long)i * G + c; if (L >= nwg) return false;
        int wgid = (int)L; { const int q = nwg / NXCD, r = nwg % NXCD, xcd = wgid % NXCD, off = wgid / NXCD; wgid = (xcd < r ? xcd * (q + 1) : r * (q + 1) + (xcd - r) * q) + off; }
        const int nig = WGM * nN, gid = wgid / nig, fm = gid * WGM, gsz = (nM - fm) < WGM ? (nM - fm) : WGM;
        u.pm = fm + ((wgid % nig) % gsz); u.pn = (wgid % nig) / gsz; u.half = 0; return true;
    }
    __device__ __forceinline__ void a_ready(const Unit&) const {}
    __device__ __forceinline__ void done(const Unit&) const {}
};

__device__ __forceinline__ unsigned cvt_pk_bf16(float lo, float hi) { unsigned r; asm volatile("v_cvt_pk_bf16_f32 %0, %1, %2" : "=v"(r) : "v"(lo), "v"(hi)); return r; }
typedef float f32x2 __attribute__((ext_vector_type(2)));
__device__ __forceinline__ f32x2 gelu_pk(f32x2 v) {
    const f32x2 av = __builtin_elementwise_abs(v), d = av * 0.2316418882f + 1.0f;
    f32x2 t; t.x = __builtin_amdgcn_rcpf(d.x); t.y = __builtin_amdgcn_rcpf(d.y);
    f32x2 q = t * 0.5307027145f + (-0.7265760135f); q = q * t + 0.7107068705f; q = q * t + (-0.142248368f); q = q * t + 0.127414796f; q = q * t;
    const f32x2 s = (v * v) * (-0.72134752044f);
    f32x2 e; e.x = __builtin_amdgcn_exp2f(s.x); e.y = __builtin_amdgcn_exp2f(s.y);
    const f32x2 m = v * (q * e), r = v - m;
    f32x2 o; o.x = v.x < 0.f ? m.x : r.x; o.y = v.y < 0.f ? m.y : r.y; return o;
}

template <int ACT  > struct EpiBf16 {
    static constexpr bool PERM = true, AFTER_DRAIN = false, PERM2 = false; static_assert(ACT == 0 || ACT == 1, "EpiBf16: ACT is 0 (none) or 1 (gelu_pk)");
    bf16_t* O; int ldc; const float* bias; int split_cols; size_t split_stride; float scale0;
    __device__ __forceinline__ void operator()(const f32x4 (&acc)[2][2][4][2], const Unit& u, int wr, int wc, int fr, int fq) const {
        const int row0 = u.pm * BM + wr * 64 + fr; int colt = u.pn * BM; bf16_t* base = O;
        float sc = 1.f; if (split_cols) { const int t = colt / split_cols; base += (size_t)t * split_stride; colt -= t * split_cols; if (t == 0) sc = scale0; }
        const int col0 = colt + wc * 32 + 8 * fq, bcol0 = u.pn * BM + wc * 32 + 8 * fq;
        f32x4 bv[2][2];
#pragma unroll
        for (int bj = 0; bj < 2; ++bj)
#pragma unroll
            for (int n = 0; n < 2; ++n) bv[bj][n] = bias ? *(const f32x4*)(bias + bcol0 + bj * HALF + 4 * n) : (f32x4){0.f, 0.f, 0.f, 0.f};
#pragma unroll
        for (int ai = 0; ai < 2; ++ai)
#pragma unroll
            for (int m = 0; m < 4; ++m) { bf16_t* rowp = base + (size_t)(row0 + ai * HALF + m * 16) * ldc + col0;
#pragma unroll
                for (int bj = 0; bj < 2; ++bj) { f32x4 v0 = acc[ai][bj][m][0] + bv[bj][0], v1 = acc[ai][bj][m][1] + bv[bj][1];
                    if (ACT == 1) { f32x2 a = gelu_pk((f32x2){v0[0], v0[1]}), b = gelu_pk((f32x2){v0[2], v0[3]}), c = gelu_pk((f32x2){v1[0], v1[1]}), d = gelu_pk((f32x2){v1[2], v1[3]});
                        v0 = (f32x4){a.x, a.y, b.x, b.y}; v1 = (f32x4){c.x, c.y, d.x, d.y}; }
                    v0 = v0 * sc; v1 = v1 * sc; u32x4 w; w.x = cvt_pk_bf16(v0[0], v0[1]); w.y = cvt_pk_bf16(v0[2], v0[3]); w.z = cvt_pk_bf16(v1[0], v1[1]); w.w = cvt_pk_bf16(v1[2], v1[3]);
                    *(u32x4*)(rowp + bj * HALF) = w; } }
    }
};

struct ADirect { static constexpr bool GATHER = false; __device__ __forceinline__ unsigned rowoff(int, int) const { return 0u; } };
template <class Epi, class Sched, bool ALIGN_EPI = false, bool SP2 = false, class AMap = ADirect>
__device__ __forceinline__ void gemm_phase(PG8_LAS unsigned char* lds, const Gemm g, const Sched& S, const Epi& E, const AMap& AM = AMap()) {
    static_assert(!AMap::GATHER || SP2, "gathered A rows: SP2 loop only");
    int tid_l = threadIdx.x; asm volatile("" : "+v"(tid_l));
    const int tid = tid_l, wid = __builtin_amdgcn_readfirstlane(tid >> 6), lane = tid & 63, wr = wid >> 2, wc = wid & 3, fr = lane & 15, fq = lane >> 4;
    const int K = g.K, nt = K / BK;
    unsigned voffA[2], voffB[2]; int gR[2]; unsigned gC2[2];
#pragma unroll
    for (int i = 0; i < 2; ++i) { int R, C; stage_rc(tid * 16 + i * 8192, R, C); const int Rb = Epi::PERM2 ? (64 * (R >> 5) + 16 * ((R >> 2) & 3) + 4 * ((R >> 4) & 1) + (R & 3)) : (Epi::PERM ? ((R & ~31) + perm32(R & 31)) : R);
        voffA[i] = (unsigned)(R * K + C) * 2u; voffB[i] = (unsigned)(Rb * K + C) * 2u; gR[i] = R; gC2[i] = (unsigned)C * 2u; }
    unsigned vc[2][2], vn[2][2];
    const size_t kstep = (size_t)(BK * 2);
    const size_t hstep = (size_t)HALF * K * 2;
    const size_t tstep = 2 * hstep;
    const size_t hstepB = Epi::PERM2 ? (size_t)8 * K * 2 : hstep;
    const unsigned ldsw = (unsigned)wid * 1024u;
    const int aoff = lds_byte(wr * 64 + fr, fq * 8), boff = lds_byte(wc * 32 + fr, fq * 8);
#define PG8_SA(b, h) (((b) * 2 + (h)) * HTB)
#define PG8_SB(b, h) ((4 + (b) * 2 + (h)) * HTB)
#define PG8_STAGE(bufoff, gbase, voff) do { _Pragma("unroll") for (int _i = 0; _i < 2; ++_i) \
        __builtin_amdgcn_global_load_lds((const unsigned*)((const char*)(gbase) + (voff)[_i]), (PG8_LAS unsigned*)(lds + (bufoff) + ldsw + _i * 8192), 16, 0, 0); } while (0)
#define PG8_GOFF(dst, pm_) do { _Pragma("unroll") for (int _h = 0; _h < 2; ++_h) _Pragma("unroll") for (int _i = 0; _i < 2; ++_i) dst[_h][_i] = AM.rowoff((pm_), _h * HALF + gR[_i]) + gC2[_i]; } while (0)
#define PG8_STAGE_A(b, h, gptr, NX) do { if constexpr (AMap::GATHER) { unsigned v_[2]; v_[0] = (NX) ? vn[h][0] : vc[h][0]; v_[1] = (NX) ? vn[h][1] : vc[h][1]; PG8_STAGE(PG8_SA(b, h), gptr, v_); } \
        else { PG8_STAGE(PG8_SA(b, h), (gptr) + (h) * hstep, voffA); } } while (0)
#define PG8_LDA(dst, b, h) do { _Pragma("unroll") for (int m = 0; m < 4; ++m) _Pragma("unroll") for (int k = 0; k < 2; ++k) dst[m][k] = *(const PG8_LAS bf16x8*)(lds + PG8_SA(b, h) + aoff + m * 2048 + k * 1024); } while (0)
#define PG8_LDB(dst, b, h) do { _Pragma("unroll") for (int n = 0; n < 2; ++n) _Pragma("unroll") for (int k = 0; k < 2; ++k) dst[n][k] = *(const PG8_LAS bf16x8*)(lds + PG8_SB(b, h) + boff + n * 2048 + k * 1024); } while (0)
#define PG8_MMA(ai, bj, At, Bt) do { __builtin_amdgcn_s_setprio(1); _Pragma("unroll") for (int m = 0; m < 4; ++m) _Pragma("unroll") for (int n = 0; n < 2; ++n) _Pragma("unroll") for (int k = 0; k < 2; ++k) \
        acc[ai][bj][m][n] = __builtin_amdgcn_mfma_f32_16x16x32_bf16(Bt[n][k], At[m][k], acc[ai][bj][m][n], 0, 0, 0); __builtin_amdgcn_s_setprio(0); } while (0)
#define PG8_WAIT_V(n) asm volatile("s_waitcnt vmcnt(" #n ")" ::: "memory")
#define PG8_WAIT_L(n) asm volatile("s_waitcnt lgkmcnt(" #n ")" ::: "memory")
#define PG8_BAR __builtin_amdgcn_s_barrier()
#define PG8_SCHED __builtin_amdgcn_sched_barrier(0)
    Unit cur, nxt; int ui = 0;
    if (!S.next(0, cur)) return;
    f32x4 acc[2][2][4][2];
#pragma unroll
    for (int a = 0; a < 2; ++a)
#pragma unroll
        for (int b = 0; b < 2; ++b)
#pragma unroll
            for (int m = 0; m < 4; ++m)
#pragma unroll
                for (int n = 0; n < 2; ++n) acc[a][b][m][n] = (f32x4){0.f, 0.f, 0.f, 0.f};
    bf16x8 At[4][2], B0[2][2], B1[2][2];
    const char* cA = (const char*)g.A + (AMap::GATHER ? (size_t)0 : (size_t)cur.pm * tstep); const char* cB = (const char*)g.Bt + (size_t)cur.pn * tstep;
    if constexpr (AMap::GATHER) { PG8_GOFF(vc, cur.pm); }
    S.a_ready(cur);
    if constexpr (SP2) {
        PG8_STAGE(PG8_SB(0, 0), cB, voffB); PG8_STAGE(PG8_SB(0, 1), cB + hstepB, voffB); PG8_STAGE_A(0, 0, cA, false); PG8_STAGE_A(0, 1, cA, false);
        if (wr == 1) PG8_BAR;
        PG8_WAIT_V(2); PG8_BAR;
        PG8_STAGE(PG8_SB(1, 0), cB + kstep, voffB); PG8_STAGE_A(1, 0, cA + kstep, false); PG8_STAGE(PG8_SB(1, 1), cB + hstepB + kstep, voffB);
        PG8_WAIT_V(6); PG8_BAR;
    } else {
        PG8_STAGE(PG8_SB(0, 0), cB, voffB); PG8_STAGE(PG8_SA(0, 0), cA, voffA); PG8_STAGE(PG8_SB(0, 1), cB + hstepB, voffB); PG8_STAGE(PG8_SA(0, 1), cA + hstep, voffA);
        if (wr == 1) PG8_BAR;
        PG8_WAIT_V(4); PG8_BAR;
        PG8_STAGE(PG8_SB(1, 0), cB + kstep, voffB); PG8_STAGE(PG8_SA(1, 0), cA + kstep, voffA); PG8_STAGE(PG8_SB(1, 1), cB + hstepB + kstep, voffB);
        PG8_WAIT_V(6); PG8_BAR;
    }
    for (;;) {
        const bool has_next = S.next(ui + 1, nxt);
        const char* nA = (has_next && !AMap::GATHER) ? (const char*)g.A + (size_t)nxt.pm * tstep : cA; const char* nB = has_next ? (const char*)g.Bt + (size_t)nxt.pn * tstep : cB;
        if constexpr (AMap::GATHER) { if (has_next) { PG8_GOFF(vn, nxt.pm); } else { vn[0][0] = vc[0][0]; vn[0][1] = vc[0][1]; vn[1][0] = vc[1][0]; vn[1][1] = vc[1][1]; } }
        for (int t = 0; t < nt; t += 2) {
            const bool last = (t == nt - 2);
            const char* a1 = cA + (size_t)(t + 1) * kstep;
            const char* a2 = last ? nA : cA + (size_t)(t + 2) * kstep; const char* b2 = last ? nB : cB + (size_t)(t + 2) * kstep;
            const char* a3 = a2 + kstep; const char* b3 = b2 + kstep;
            if (last && has_next) S.a_ready(nxt);
            if constexpr (SP2) {
            PG8_LDB(B0, 0, 0); PG8_LDB(B1, 0, 1); PG8_SCHED; PG8_LDA(At, 0, 0); PG8_STAGE_A(1, 1, a1, false);
            PG8_WAIT_V(8); PG8_WAIT_L(0); PG8_BAR; PG8_MMA(0, 0, At, B0); PG8_MMA(0, 1, At, B1); PG8_BAR; PG8_SCHED;
            PG8_LDA(At, 0, 1); PG8_STAGE(PG8_SB(0, 0), b2, voffB); PG8_STAGE(PG8_SB(0, 1), b2 + hstepB, voffB); PG8_STAGE_A(0, 0, a2, last);
            PG8_WAIT_V(8); PG8_WAIT_L(0); PG8_BAR; if (!cur.half) { PG8_MMA(1, 0, At, B0); PG8_MMA(1, 1, At, B1); } PG8_BAR; PG8_SCHED;
            PG8_LDB(B0, 1, 0); PG8_LDB(B1, 1, 1); PG8_SCHED; PG8_LDA(At, 1, 0); PG8_STAGE_A(0, 1, a2, last);
            PG8_WAIT_V(8); PG8_WAIT_L(0); PG8_BAR; PG8_MMA(0, 0, At, B0); PG8_MMA(0, 1, At, B1); PG8_BAR; PG8_SCHED;
            PG8_LDA(At, 1, 1); PG8_STAGE(PG8_SB(1, 0), b3, voffB); PG8_STAGE(PG8_SB(1, 1), b3 + hstepB, voffB); PG8_STAGE_A(1, 0, a3, last);
            PG8_WAIT_V(8); PG8_WAIT_L(0); PG8_BAR; if (!cur.half) { PG8_MMA(1, 0, At, B0); PG8_MMA(1, 1, At, B1); } PG8_BAR; PG8_SCHED;
            } else {
            PG8_LDB(B0, 0, 0); PG8_SCHED; PG8_LDA(At, 0, 0); PG8_STAGE(PG8_SA(1, 1), a1 + hstep, voffA);
            PG8_WAIT_L(8); PG8_BAR; PG8_WAIT_L(0); PG8_MMA(0, 0, At, B0); PG8_BAR; PG8_SCHED;
            PG8_LDB(B1, 0, 1); PG8_STAGE(PG8_SB(0, 0), b2, voffB);
            PG8_BAR; PG8_WAIT_L(0); PG8_MMA(0, 1, At, B1); PG8_BAR;
            PG8_LDA(At, 0, 1); PG8_STAGE(PG8_SA(0, 0), a2, voffA);
            PG8_BAR; PG8_WAIT_L(0); PG8_MMA(1, 0, At, B0); PG8_BAR; PG8_SCHED;
            PG8_STAGE(PG8_SB(0, 1), b2 + hstepB, voffB);
            PG8_WAIT_V(6); PG8_BAR; PG8_MMA(1, 1, At, B1); PG8_BAR;
            PG8_LDB(B0, 1, 0); PG8_SCHED; PG8_LDA(At, 1, 0); PG8_STAGE(PG8_SA(0, 1), a2 + hstep, voffA);
            PG8_WAIT_L(8); PG8_BAR; PG8_WAIT_L(0); PG8_MMA(0, 0, At, B0); PG8_BAR; PG8_SCHED;
            PG8_LDB(B1, 1, 1); PG8_STAGE(PG8_SB(1, 0), b3, voffB);
            PG8_BAR; PG8_WAIT_L(0); PG8_MMA(0, 1, At, B1); PG8_BAR;
            PG8_LDA(At, 1, 1); PG8_STAGE(PG8_SA(1, 0), a3, voffA);
            PG8_BAR; PG8_WAIT_L(0); PG8_MMA(1, 0, At, B0); PG8_BAR; PG8_SCHED;
            PG8_STAGE(PG8_SB(1, 1), b3 + hstepB, voffB);
            PG8_WAIT_V(6); PG8_BAR; PG8_MMA(1, 1, At, B1); PG8_BAR;
            }
        }
        if constexpr (ALIGN_EPI) { if (wr == 0) PG8_BAR; }
        if constexpr (!Epi::AFTER_DRAIN) { int te_ = threadIdx.x; asm volatile("" : "+v"(te_));
            E(acc, cur, wr, wc, te_ & 15, (te_ >> 4) & 3); S.done(cur); }
        if (!has_next) break;
#pragma unroll
        for (int a = 0; a < 2; ++a)
#pragma unroll
            for (int b = 0; b < 2; ++b)
#pragma unroll
                for (int m = 0; m < 4; ++m)
#pragma unroll
                    for (int n = 0; n < 2; ++n) acc[a][b][m][n] = (f32x4){0.f, 0.f, 0.f, 0.f};
        cur = nxt; cA = nA; cB = nB; ++ui;
        if constexpr (AMap::GATHER) { vc[0][0] = vn[0][0]; vc[0][1] = vn[0][1]; vc[1][0] = vn[1][0]; vc[1][1] = vn[1][1]; }
        if constexpr (ALIGN_EPI) { if (wr == 1) PG8_BAR; }
    }
    PG8_WAIT_V(0);
    if constexpr (!ALIGN_EPI) { if (wr == 0) PG8_BAR; }
    PG8_BAR;
    if constexpr (Epi::AFTER_DRAIN) { E.fused(acc, cur, wr, wc, fr, fq, lds, wid, lane); S.done(cur); }
#undef PG8_SA
#undef PG8_SB
#undef PG8_STAGE
#undef PG8_LDA
#undef PG8_GOFF
#undef PG8_STAGE_A
#undef PG8_LDB
#undef PG8_MMA
#undef PG8_WAIT_V
#undef PG8_WAIT_L
#undef PG8_BAR
#undef PG8_SCHED
}
}
#define GAS __attribute__((address_space(1)))
#define LAS __attribute__((address_space(3)))
typedef unsigned short bf16;
typedef unsigned v4u __attribute__((ext_vector_type(4)));
typedef float f32x4 __attribute__((ext_vector_type(4)));
typedef short bf16x8 __attribute__((ext_vector_type(8)));
typedef GAS unsigned gu32;
typedef GAS unsigned long long gu64;
#define RLX_AGENT __ATOMIC_RELAXED, __HIP_MEMORY_SCOPE_AGENT
#define LDS_WAIT() asm volatile("s_waitcnt lgkmcnt(0)" ::: "memory")
#define VM_WAIT() asm volatile("s_waitcnt vmcnt(0)" ::: "memory")
__device__ __forceinline__ unsigned long long rt() { return __builtin_amdgcn_s_memrealtime(); }
__device__ __forceinline__ unsigned f2bf(float f) { unsigned u = __builtin_bit_cast(unsigned, f); return (u + 0x7fffu + ((u >> 16) & 1u)) >> 16; }
__device__ __forceinline__ unsigned pk2(float lo, float hi) { return f2bf(lo) | (f2bf(hi) << 16); }

#define XB_TMO      128
#define XB_XCNT(j)  (256  + 64 * (j))
#define XB_XSUB(j)  (1280 + 64 * (j))
#define XB_XGEN(j)  (2304 + 64 * (j))
#define XB_TOP      3328
#define XB_TOPGEN   3392
#define XCD_BAR_WORDS 3456
#define XB_SPIN_CAP (1u << 18)

__device__ __forceinline__ unsigned xb_ld(unsigned* p)              { return __hip_atomic_load(p, __ATOMIC_RELAXED, __HIP_MEMORY_SCOPE_AGENT); }
__device__ __forceinline__ unsigned xb_add(unsigned* p, unsigned v) { return __hip_atomic_fetch_add(p, v, __ATOMIC_RELAXED, __HIP_MEMORY_SCOPE_AGENT); }
__device__ __forceinline__ unsigned xb_xcc_id() { return (unsigned)__builtin_amdgcn_s_getreg((3 << 11) | 20) & 0xFu; }
#define XB_SPIN(cond, bar) do { unsigned _sp = 0; while (cond) { __builtin_amdgcn_s_sleep(1); \
    if ((++_sp & 255u) == 0u) { if (xb_ld(&(bar)[XB_TMO])) break; if (_sp > XB_SPIN_CAP) { atomicAdd(&(bar)[XB_TMO], 1u); break; } } } } while (0)

struct XcdBarrier {
    unsigned* bar; unsigned x;
    volatile LAS unsigned* st;
};

__device__ __forceinline__ XcdBarrier xcd_barrier_post(unsigned* bar, volatile LAS unsigned* st) {
    XcdBarrier b; b.bar = bar; b.x = xb_xcc_id(); b.st = st;
    if (threadIdx.x == 0) (void)xb_add(&bar[XB_XCNT(b.x)], 1u);
    return b;
}
__device__ __forceinline__ void xcd_barrier_complete(unsigned* bar, unsigned x, unsigned& nloc, unsigned& nx) {
    const unsigned G = gridDim.x * gridDim.y * gridDim.z;
    unsigned sum, cnt, mine, sp = 0u;
    for (;;) {
        sum = 0u; cnt = 0u; mine = 0u;
#pragma unroll
        for (unsigned j = 0; j < 16; ++j) { const unsigned c = xb_ld(&bar[XB_XCNT(j)]); sum += c; cnt += (c > 0u) ? 1u : 0u; mine = (j == x) ? c : mine; }
        if (sum == G) break;
        __builtin_amdgcn_s_sleep(1);
        if ((++sp & 255u) == 0u) { if (xb_ld(&bar[XB_TMO])) break; if (sp > XB_SPIN_CAP) { atomicAdd(&bar[XB_TMO], 1u); break; } }
    }
    nloc = mine > 0u ? mine : 1u; nx = cnt > 0u ? cnt : 1u;
}

__device__ __forceinline__ void xcd_barrier(const XcdBarrier& b) {
    asm volatile("s_waitcnt vmcnt(0)" ::: "memory");
    __syncthreads();
    if (threadIdx.x == 0) {
        unsigned* bar = b.bar;
        __builtin_amdgcn_s_waitcnt(0);
        unsigned nloc = b.st[0], nx = b.st[1];
        if (nloc == 0u) { xcd_barrier_complete(bar, b.x, nloc, nx); b.st[0] = nloc; b.st[1] = nx; }
        const unsigned old = xb_add(&bar[XB_XSUB(b.x)], 1u);
        const unsigned gen = old / nloc;
        if (old + 1u == (gen + 1u) * nloc) {
            __builtin_amdgcn_fence(__ATOMIC_RELEASE, "agent");
            asm volatile("s_waitcnt vmcnt(0)" ::: "memory");
            const unsigned og = xb_add(&bar[XB_TOP], 1u);
            const unsigned tg = og / nx;
            if (og + 1u == (tg + 1u) * nx) xb_add(&bar[XB_TOPGEN], 1u);
            else XB_SPIN(xb_ld(&bar[XB_TOPGEN]) == tg, bar);
            __builtin_amdgcn_fence(__ATOMIC_ACQUIRE, "agent");
            xb_add(&bar[XB_XGEN(b.x)], 1u);
            asm volatile("s_waitcnt vmcnt(0)" ::: "memory");
        } else {
            XB_SPIN(xb_ld(&bar[XB_XGEN(b.x)]) == gen, bar);
            __builtin_amdgcn_fence(__ATOMIC_ACQUIRE, "agent");
            asm volatile("s_waitcnt vmcnt(0)" ::: "memory");
        }
    }
    __syncthreads();
}
namespace att {
using bf16 = __hip_bfloat16;
constexpr int   D = 128, NW = 8, QBLK = 32, KVBLK = 64;
constexpr float SCALE = 0.088388347648318440f;
constexpr float THR = 8.f;
#ifndef ATT_SDEPTH
#define ATT_SDEPTH 1
#endif
constexpr int SDEPTH = ATT_SDEPTH;
constexpr size_t SHM_V = KVBLK * D * 2, SHM_K = KVBLK * D * 2, SHM_ATTN = 2 * SHM_V + 2 * SHM_K + NW * 64 * 4;
using bf16x8 = __attribute__((ext_vector_type(8))) short;
using s16x4  = __attribute__((ext_vector_type(4))) short;
using f32x16 = __attribute__((ext_vector_type(16))) float;
using u32x4  = __attribute__((ext_vector_type(4))) unsigned;
#define KSWZ(row, colB) ((row) * 256 + ((colB) ^ (((row) & 7) << 4)))
#define SBAR() __builtin_amdgcn_sched_barrier(0)
__device__ __forceinline__ int crow(int r, int hi) { return (r & 3) + 8 * (r >> 2) + 4 * hi; }
__device__ __forceinline__ unsigned cvtpk(float lo, float hi) {
  unsigned r; asm volatile("v_cvt_pk_bf16_f32 %0, %1, %2" : "=v"(r) : "v"(lo), "v"(hi)); return r;
}
__device__ __forceinline__ bf16x8 ld8(const bf16* p) { return *reinterpret_cast<const bf16x8*>(p); }
__device__ __forceinline__ void partialSM(f32x16& p0, f32x16& p1, float& m_reg, float& mn, float& alpha) {
  constexpr float C = SCALE * 1.4426950408889634f;
  float pmax = p0[0]; for (int r = 1; r < 16; ++r) pmax = fmaxf(pmax, p0[r]); for (int r = 0; r < 16; ++r) pmax = fmaxf(pmax, p1[r]);
  { auto rr = __builtin_amdgcn_permlane32_swap(__float_as_uint(pmax), __float_as_uint(pmax), false, false);
    pmax = fmaxf(__uint_as_float(rr[0]), __uint_as_float(rr[1])); }
  if (__builtin_expect(__all(pmax - m_reg <= THR / SCALE), 1)) { mn = m_reg; alpha = 1.f; }
  else { mn = fmaxf(m_reg, pmax); alpha = __builtin_amdgcn_exp2f((m_reg - mn) * C); m_reg = mn; }
  float mnC = -mn * C;
  for (int r = 0; r < 16; ++r) p0[r] = fmaf(p0[r], C, mnC); for (int r = 0; r < 16; ++r) p1[r] = fmaf(p1[r], C, mnC);
  for (int r = 0; r < 16; ++r) p0[r] = __builtin_amdgcn_exp2f(p0[r]);
}
__device__ __forceinline__ void finishSM(f32x16& p0, f32x16& p1, float alpha, float& l_reg, bf16x8& pa0, bf16x8& pa1, bf16x8& pa2, bf16x8& pa3) {
  for (int r = 0; r < 16; ++r) p1[r] = __builtin_amdgcn_exp2f(p1[r]);
  float ps = 0; for (int r = 0; r < 16; ++r) ps += p0[r]; for (int r = 0; r < 16; ++r) ps += p1[r];
  { auto rr = __builtin_amdgcn_permlane32_swap(__float_as_uint(ps), __float_as_uint(ps), false, false);
    ps = __uint_as_float(rr[0]) + __uint_as_float(rr[1]); }
  l_reg = l_reg * alpha + ps;
#define PK4(P, BASE, OUT) do { unsigned a0 = cvtpk(P[BASE + 0], P[BASE + 1]), a1 = cvtpk(P[BASE + 2], P[BASE + 3]);   \
    unsigned b0 = cvtpk(P[BASE + 4], P[BASE + 5]), b1 = cvtpk(P[BASE + 6], P[BASE + 7]);                              \
    auto r0 = __builtin_amdgcn_permlane32_swap(a0, b0, false, false); auto r1 = __builtin_amdgcn_permlane32_swap(a1, b1, false, false); \
    u32x4 w = {r0[0], r1[0], r0[1], r1[1]}; OUT = *reinterpret_cast<bf16x8*>(&w); } while (0)
  PK4(p0, 0, pa0); PK4(p0, 8, pa1); PK4(p1, 0, pa2); PK4(p1, 8, pa3);
#undef PK4
}
__device__ __forceinline__ void qkt(f32x16& p0, f32x16& p1, const bf16* Ks, const bf16x8* qr, int r32, int hi) {
  p0 = f32x16{}; p1 = f32x16{};
  for (int d0 = 0; d0 < 8; ++d0) { int cb = (d0 * 16 + hi * 8) * 2;
    bf16x8 b0 = *reinterpret_cast<const bf16x8*>((const char*)Ks + KSWZ(r32, cb));
    bf16x8 b1 = *reinterpret_cast<const bf16x8*>((const char*)Ks + KSWZ(32 + r32, cb));
    p0 = __builtin_amdgcn_mfma_f32_32x32x16_bf16(b0, qr[d0], p0, 0, 0, 0);
    p1 = __builtin_amdgcn_mfma_f32_32x32x16_bf16(b1, qr[d0], p1, 0, 0, 0); }
}
__device__ __forceinline__ int v_st(int k, int c) { const int kk = (k & ~0xC) | ((k & 4) << 1) | ((k & 8) >> 1); return ((kk >> 3) * 4 + (c >> 5)) * 512 + ((kk & 7) * 32 + (c & 31)) * 2; }
__device__ __forceinline__ int v_rd_base(int lane) { return ((lane & 3) << 3) | (((lane >> 2) & 3) << 6) | (((lane >> 4) & 1) << 5) | (((lane >> 5) & 1) << 8); }
constexpr int v_rd_off(int d0, int ks, int half) { return d0 * 512 + ks * 4096 + half * 2048; }
template <int OFF> __device__ __forceinline__ s16x4 tr_read(int vb) {
  s16x4 r; asm volatile("ds_read_b64_tr_b16 %0, %1 offset:%2" : "=&v"(r) : "v"(vb), "i"(OFF) : "memory"); return r;
}
template <int D0> __device__ __forceinline__ void pv_one(f32x16& od, int vb, bf16x8 pa0, bf16x8 pa1, bf16x8 pa2, bf16x8 pa3) {
  const s16x4 l0 = tr_read<v_rd_off(D0, 0, 0)>(vb), h0 = tr_read<v_rd_off(D0, 0, 1)>(vb), l1 = tr_read<v_rd_off(D0, 1, 0)>(vb), h1 = tr_read<v_rd_off(D0, 1, 1)>(vb);
  const s16x4 l2 = tr_read<v_rd_off(D0, 2, 0)>(vb), h2 = tr_read<v_rd_off(D0, 2, 1)>(vb), l3 = tr_read<v_rd_off(D0, 3, 0)>(vb), h3 = tr_read<v_rd_off(D0, 3, 1)>(vb);
  asm volatile("s_waitcnt lgkmcnt(0)" ::: "memory"); SBAR();
#define PK(L, H) (bf16x8){L[0], L[1], L[2], L[3], H[0], H[1], H[2], H[3]}
  od = __builtin_amdgcn_mfma_f32_32x32x16_bf16(pa0, PK(l0, h0), od, 0, 0, 0);
  od = __builtin_amdgcn_mfma_f32_32x32x16_bf16(pa1, PK(l1, h1), od, 0, 0, 0);
  od = __builtin_amdgcn_mfma_f32_32x32x16_bf16(pa2, PK(l2, h2), od, 0, 0, 0);
  od = __builtin_amdgcn_mfma_f32_32x32x16_bf16(pa3, PK(l3, h3), od, 0, 0, 0);
#undef PK
}
__device__ __forceinline__ void pv_d0(f32x16* o, int vb, bf16x8 pa0, bf16x8 pa1, bf16x8 pa2, bf16x8 pa3) {
  pv_one<0>(o[0], vb, pa0, pa1, pa2, pa3); pv_one<1>(o[1], vb, pa0, pa1, pa2, pa3); pv_one<2>(o[2], vb, pa0, pa1, pa2, pa3); pv_one<3>(o[3], vb, pa0, pa1, pa2, pa3);
}
template <int LDQ, int LDKK, int LDV, int LDO>
__device__ __forceinline__ void attn_dense_body(const bf16* __restrict__ Qb, const bf16* __restrict__ Kh, const bf16* __restrict__ Vh,
                                                bf16* __restrict__ Ob, int seq, char* lds) {
  const int tid = threadIdx.x, wid = tid >> 6, lane = tid & 63, r32 = lane & 31, hi = lane >> 5;
  bf16* V_lds = (bf16*)lds; bf16* K_lds = (bf16*)(lds + 2 * SHM_V);
  float* ws = (float*)(lds + 2 * SHM_V + 2 * SHM_K) + wid * 64; float* li_l = ws; float* al_l = ws + 32;
  float m_reg = -1e30f, l_reg = 0; f32x16 o[4] = {}; bf16x8 qr[8];
  const bf16* Qw = Qb + (long)(wid * QBLK + r32) * LDQ + hi * 8;
#pragma unroll
  for (int d0 = 0; d0 < 8; ++d0) qr[d0] = ld8(Qw + d0 * 16);
  const int sr = tid >> 4, sc = (tid & 15) * 8, vst0 = v_st(sr, sc), vst1 = v_st(32 + sr, sc);
  const int vb0 = (int)(uintptr_t)V_lds + v_rd_base(lane);
  struct { bf16x8 vs0, vs1, ks0, ks1; } sr_[SDEPTH];
#define SLOAD(i, k0) do { sr_[i].vs0 = ld8(&Vh[(long)((k0) + sr) * LDV + sc]); sr_[i].vs1 = ld8(&Vh[(long)((k0) + 32 + sr) * LDV + sc]); \
    sr_[i].ks0 = ld8(&Kh[(long)((k0) + sr) * LDKK + sc]); sr_[i].ks1 = ld8(&Kh[(long)((k0) + 32 + sr) * LDKK + sc]); } while (0)
#define SWRITE(b, i) do { *(bf16x8*)((char*)V_lds + (b) * SHM_V + vst0) = sr_[i].vs0;          \
    *(bf16x8*)((char*)V_lds + (b) * SHM_V + vst1) = sr_[i].vs1; int kc = sc * 2;               \
    *(bf16x8*)((char*)K_lds + (b) * SHM_K + KSWZ(sr, kc)) = sr_[i].ks0;                       \
    *(bf16x8*)((char*)K_lds + (b) * SHM_K + KSWZ(32 + sr, kc)) = sr_[i].ks1; } while (0)
#define SWAIT() do { if constexpr (SDEPTH == 2) asm volatile("s_waitcnt vmcnt(4)" ::: "memory"); else asm volatile("s_waitcnt vmcnt(0)" ::: "memory"); } while (0)
#define RESC(a) do { if (__any((a) < 1.f)) { if (hi == 0) al_l[r32] = (a); asm volatile("s_waitcnt lgkmcnt(0)" ::: "memory"); \
    for (int d = 0; d < 4; ++d) for (int r = 0; r < 16; ++r) o[d][r] *= al_l[crow(r, hi)]; } } while (0)
  f32x16 pA0, pA1, pB0, pB1; float mnA, mnB, alA, alB; bf16x8 pa0, pa1, pa2, pa3; const int NT = seq / KVBLK;
  constexpr int SE = 0, SO = SDEPTH - 1;
  SLOAD(SE, 0); asm volatile("s_waitcnt vmcnt(0)" ::: "memory"); SWRITE(0, SE); __syncthreads();
  qkt(pA0, pA1, K_lds, qr, r32, hi); partialSM(pA0, pA1, m_reg, mnA, alA);
  SLOAD(SO, KVBLK); if constexpr (SDEPTH == 2) { if (2 < NT) SLOAD(SE, 2 * KVBLK); }
  SWAIT(); SWRITE(1, SO); __syncthreads();
  for (int j = 1; j + 1 < NT; j += 2) {
    SBAR(); qkt(pB0, pB1, (bf16*)((char*)K_lds + SHM_K), qr, r32, hi);
    finishSM(pA0, pA1, alA, l_reg, pa0, pa1, pa2, pa3); SBAR();
    SLOAD(SO, (j + SDEPTH) * KVBLK); SBAR();
    pv_d0(o, vb0, pa0, pa1, pa2, pa3); partialSM(pB0, pB1, m_reg, mnB, alB);
    __syncthreads(); SWAIT(); SWRITE(0, SE);
    RESC(alB); __syncthreads();
    SBAR(); qkt(pA0, pA1, K_lds, qr, r32, hi);
    finishSM(pB0, pB1, alB, l_reg, pa0, pa1, pa2, pa3); SBAR();
    if (SDEPTH == 1 || j + 3 < NT) SLOAD(SE, (j + 1 + SDEPTH) * KVBLK); SBAR();
    pv_d0(o, vb0 + (int)SHM_V, pa0, pa1, pa2, pa3); partialSM(pA0, pA1, m_reg, mnA, alA);
    __syncthreads(); SWAIT(); SWRITE(1, SO);
    RESC(alA); __syncthreads();
  }
  SBAR(); qkt(pB0, pB1, (bf16*)((char*)K_lds + SHM_K), qr, r32, hi);
  finishSM(pA0, pA1, alA, l_reg, pa0, pa1, pa2, pa3); SBAR();
  pv_d0(o, vb0, pa0, pa1, pa2, pa3); partialSM(pB0, pB1, m_reg, mnB, alB);
  __syncthreads(); RESC(alB);
  finishSM(pB0, pB1, alB, l_reg, pa0, pa1, pa2, pa3); SBAR();
  pv_d0(o, vb0 + (int)SHM_V, pa0, pa1, pa2, pa3);
  if (hi == 0) li_l[r32] = l_reg; asm volatile("s_waitcnt lgkmcnt(0)" ::: "memory");
  float rli[16];
#pragma unroll
  for (int r = 0; r < 16; ++r) rli[r] = __builtin_amdgcn_rcpf(li_l[crow(r, hi)]);
  bf16* Ow = Ob + (long)(wid * QBLK) * LDO;
#pragma unroll
  for (int r = 0; r < 16; ++r) { int orow = crow(r, hi);
    for (int d0 = 0; d0 < 4; ++d0) Ow[(long)orow * LDO + d0 * 32 + r32] = __float2bfloat16(o[d0][r] * rli[r]); }
#undef SLOAD
#undef SWRITE
#undef SWAIT
#undef RESC
}

constexpr int PV_OFF = 0, PK_OFF = 65536, PP_OFF = 98304, PMX_OFF = 143360, PAL_OFF = 145408, PLI_OFF = 146432;
#define LBAR() asm volatile("s_waitcnt vmcnt(0) lgkmcnt(0)\n\ts_barrier" ::: "memory")
#define GAP() __builtin_amdgcn_sched_barrier(0)
struct VF { s16x4 l0, h0, l1, h1, l2, h2, l3, h3; };
__device__ __forceinline__ void attn_pair_body(const bf16* __restrict__ Qb, const bf16* __restrict__ Kh, const bf16* __restrict__ V0, const bf16* __restrict__ V1,
                                               bf16* __restrict__ O0, bf16* __restrict__ O1, int seq, __attribute__((address_space(3))) unsigned char* L) {
  typedef __attribute__((address_space(3))) unsigned char lds_u8; typedef __attribute__((address_space(3))) float lds_f32; typedef __attribute__((address_space(3))) bf16x8 lds_b8;
  constexpr float C = SCALE * 1.4426950408889634f;
  int tid = threadIdx.x; asm volatile("" : "+v"(tid));
  const int wid = __builtin_amdgcn_readfirstlane(tid >> 6), lane = tid & 63, r32 = lane & 31, hi = lane >> 5, pr = wid & 3, kh = wid >> 2;
  lds_f32* mxb = (lds_f32*)(L + PMX_OFF); lds_f32* al_l = (lds_f32*)(L + PAL_OFF) + wid * 32; lds_f32* li = (lds_f32*)(L + PLI_OFF);
  float m_reg = -1e30f, l_reg = 0.f; f32x16 o[4] = {}; bf16x8 qr[8];
  const bf16* Qw = Qb + (long)(pr * 32 + r32) * 128 + hi * 8;
#pragma unroll
  for (int d0 = 0; d0 < 8; ++d0) qr[d0] = ld8(Qw + d0 * 16);
  const int krow = kh * 32 + r32, kx = (krow & 7) << 4;
  const int ka0 = PK_OFF + krow * 256 + ((0 * 32 + hi * 16) ^ kx), ka1 = PK_OFF + krow * 256 + ((1 * 32 + hi * 16) ^ kx), ka2 = PK_OFF + krow * 256 + ((2 * 32 + hi * 16) ^ kx), ka3 = PK_OFF + krow * 256 + ((3 * 32 + hi * 16) ^ kx);
  const int vo = PV_OFF + kh * 16384 + v_rd_base(lane) + kh * 8192, vp = PV_OFF + kh * 16384 + v_rd_base(lane) + (1 - kh) * 8192;
  lds_u8* Pown = L + PP_OFF + (wid * 2) * 1024 + lane * 16; const lds_u8* Ppar = L + PP_OFF + ((wid ^ 4) * 2) * 1024 + lane * 16;
  typedef __attribute__((address_space(3))) unsigned lds_u32;
  const int ldsw = wid * 2048; int koff[2], voff[2];
#pragma unroll
  for (int i = 0; i < 2; ++i) { const int c = wid * 2 + i, row = 4 * c + (lane >> 4), cc = (lane & 15) ^ (row & 7); koff[i] = row * 128 + cc * 8;
    const int kk = (c >> 1) * 8 + ((lane >> 2) & 7), kx = (kk & ~0xC) | ((kk & 4) << 1) | ((kk & 8) >> 1), col = ((lane >> 5) | ((c & 1) << 1)) * 32 + (lane & 3) * 8; voff[i] = kx * 128 + col; }
#define DMAK(k0, b) do { _Pragma("unroll") for (int i_ = 0; i_ < 2; ++i_) \
    __builtin_amdgcn_global_load_lds((const unsigned*)(Kh + (long)(k0) * 128 + koff[i_]), (lds_u32*)(L + PK_OFF + (b) * 16384 + ldsw + i_ * 1024), 16, 0, 0); } while (0)
#define DMAV(k0, b) do { _Pragma("unroll") for (int i_ = 0; i_ < 2; ++i_) { \
    __builtin_amdgcn_global_load_lds((const unsigned*)(V0 + (long)(k0) * 128 + voff[i_]), (lds_u32*)(L + PV_OFF + (b) * 32768 + ldsw + i_ * 1024), 16, 0, 0); \
    __builtin_amdgcn_global_load_lds((const unsigned*)(V1 + (long)(k0) * 128 + voff[i_]), (lds_u32*)(L + PV_OFF + (b) * 32768 + 16384 + ldsw + i_ * 1024), 16, 0, 0); } } while (0)
#define PK4(P, BASE, OUT) do { unsigned a0 = cvtpk(P[BASE + 0], P[BASE + 1]), a1 = cvtpk(P[BASE + 2], P[BASE + 3]);   \
    unsigned b0_ = cvtpk(P[BASE + 4], P[BASE + 5]), b1_ = cvtpk(P[BASE + 6], P[BASE + 7]);                              \
    auto r0 = __builtin_amdgcn_permlane32_swap(a0, b0_, false, false); auto r1 = __builtin_amdgcn_permlane32_swap(a1, b1_, false, false); \
    u32x4 w_ = {r0[0], r1[0], r0[1], r1[1]}; OUT = *reinterpret_cast<bf16x8*>(&w_); } while (0)
  f32x16 pm = {}, pq = {}; bf16x8 fo0 = {}, fo1 = {}, fp0 = {}, fp1 = {}; float pmax = 0.f, pmaxq = 0.f; const int NT = seq / KVBLK;
  DMAK(0, 0); LBAR();
  typedef __attribute__((address_space(3))) s16x4 lds_s4;
#define TRR(off) __builtin_amdgcn_ds_read_tr16_b64_v4i16((lds_s4*)(L + (off)))
#define PVREAD(f, D0, vo_, vp_) do { f.l0 = TRR(vo_ + v_rd_off(D0, 0, 0)); f.h0 = TRR(vo_ + v_rd_off(D0, 0, 1)); f.l1 = TRR(vo_ + v_rd_off(D0, 1, 0)); f.h1 = TRR(vo_ + v_rd_off(D0, 1, 1)); \
    f.l2 = TRR(vp_ + v_rd_off(D0, 0, 0)); f.h2 = TRR(vp_ + v_rd_off(D0, 0, 1)); f.l3 = TRR(vp_ + v_rd_off(D0, 1, 0)); f.h3 = TRR(vp_ + v_rd_off(D0, 1, 1)); } while (0)
#define PKF(L_, H_) (bf16x8){L_[0], L_[1], L_[2], L_[3], H_[0], H_[1], H_[2], H_[3]}
#define MMA(acc, a_, b_) acc = __builtin_amdgcn_mfma_f32_32x32x16_bf16(a_, b_, acc, 0, 0, 0)
#define KF(d0, B) (*(const lds_b8*)(L + kaa[(d0) & 3] + (1 - (B)) * 16384 + ((d0) >> 2) * 128))
#define EXP2(i) do { pm[i] = __builtin_amdgcn_exp2f(fmaf(pm[i], C, mnC)); pm[(i) + 1] = __builtin_amdgcn_exp2f(fmaf(pm[(i) + 1], C, mnC)); } while (0)
#define PSEG(k, B, HQ, HM, HP) do { \
    float pmP = 0.f, alpha = 1.f, mnC = 0.f, ps = 0.f; VF fa, fb; bf16x8 kf0, kf1, kf2, kf3, kf4, kf5, kf6, kf7, fn0 = fo0, fn1 = fo1; unsigned ca0, ca1, cb0, cb1; \
    const int vo_ = vo + (1 - (B)) * 32768, vp_ = vp + (1 - (B)) * 32768; const int kaa[4] = {ka0, ka1, ka2, ka3}; \
    if ((k) + 2 < NT) DMAK(((k) + 2) * KVBLK, B); \
    if ((k) >= 0 && (k) < NT) DMAV((k) * KVBLK, B); \
    if (HM) pmP = mxb[(B) * 256 + (wid ^ 4) * 32 + r32]; \
    if (HP) { fp0 = *(const lds_b8*)(Ppar + (1 - (B)) * 16384); fp1 = *(const lds_b8*)(Ppar + (1 - (B)) * 16384 + 1024); } \
    if (HQ) { kf0 = KF(0, B); kf1 = KF(1, B); kf2 = KF(2, B); kf3 = KF(3, B); } \
    if (HP) PVREAD(fa, 0, vo_, vp_); \
    GAP(); \
    if (HQ) pq = __builtin_amdgcn_mfma_f32_32x32x16_bf16(kf0, qr[0], f32x16{}, 0, 0, 0); \
    if (HM) { pmax = fmaxf(pmax, pmP); const bool ok_ = __all(pmax - m_reg <= THR / SCALE); const float mn = ok_ ? m_reg : fmaxf(m_reg, pmax); \
        alpha = __builtin_amdgcn_exp2f((m_reg - mn) * C); m_reg = mn; mnC = -mn * C; } \
    GAP(); \
    if (HQ) { MMA(pq, kf1, qr[1]); kf4 = KF(4, B); kf5 = KF(5, B); } if (HM) EXP2(0); \
    GAP(); \
    if (HQ) { MMA(pq, kf2, qr[2]); kf6 = KF(6, B); kf7 = KF(7, B); } if (HM) EXP2(2); \
    GAP(); \
    if (HQ) MMA(pq, kf3, qr[3]); if (HP) PVREAD(fb, 1, vo_, vp_); if (HM) EXP2(4); \
    GAP(); \
    if (HQ) MMA(pq, kf4, qr[4]); if (HM) EXP2(6); \
    GAP(); \
    if (HQ) MMA(pq, kf5, qr[5]); if (HM) EXP2(8); \
    GAP(); \
    if (HQ) MMA(pq, kf6, qr[6]); if (HM) EXP2(10); \
    GAP(); \
    if (HQ) MMA(pq, kf7, qr[7]); if (HM) EXP2(12); \
    GAP(); \
    if (HP) MMA(o[0], fo0, PKF(fa.l0, fa.h0)); if (HM) EXP2(14); \
    GAP(); \
    if (HP) MMA(o[0], fo1, PKF(fa.l1, fa.h1)); if (HM) ps = (pm[0] + pm[1]) + (pm[2] + pm[3]); \
    GAP(); \
    if (HP) MMA(o[0], fp0, PKF(fa.l2, fa.h2)); if (HM) ps += (pm[4] + pm[5]) + (pm[6] + pm[7]); \
    GAP(); \
    if (HP) { MMA(o[0], fp1, PKF(fa.l3, fa.h3)); PVREAD(fa, 2, vo_, vp_); } if (HM) ps += (pm[8] + pm[9]) + (pm[10] + pm[11]); \
    GAP(); \
    if (HP) MMA(o[1], fo0, PKF(fb.l0, fb.h0)); \
    if (HM) { ps += (pm[12] + pm[13]) + (pm[14] + pm[15]); \
        auto rr = __builtin_amdgcn_permlane32_swap(__float_as_uint(ps), __float_as_uint(ps), false, false); ps = __uint_as_float(rr[0]) + __uint_as_float(rr[1]); l_reg = l_reg * alpha + ps; } \
    GAP(); \
    if (HP) MMA(o[1], fo1, PKF(fb.l1, fb.h1)); \
    if (HQ) { pmaxq = fmaxf(fmaxf(pq[0], pq[1]), fmaxf(pq[2], pq[3])); pmaxq = fmaxf(pmaxq, fmaxf(fmaxf(pq[4], pq[5]), fmaxf(pq[6], pq[7]))); } \
    GAP(); \
    if (HP) MMA(o[1], fp0, PKF(fb.l2, fb.h2)); \
    if (HQ) { pmaxq = fmaxf(pmaxq, fmaxf(fmaxf(pq[8], pq[9]), fmaxf(pq[10], pq[11]))); pmaxq = fmaxf(pmaxq, fmaxf(fmaxf(pq[12], pq[13]), fmaxf(pq[14], pq[15]))); \
        auto rr = __builtin_amdgcn_permlane32_swap(__float_as_uint(pmaxq), __float_as_uint(pmaxq), false, false); pmaxq = fmaxf(__uint_as_float(rr[0]), __uint_as_float(rr[1])); } \
    GAP(); \
    if (HP) { MMA(o[1], fp1, PKF(fb.l3, fb.h3)); PVREAD(fb, 3, vo_, vp_); } \
    if (HQ) { if (hi == 0) mxb[(1 - (B)) * 256 + wid * 32 + r32] = pmaxq; } \
    GAP(); \
    if (HP) MMA(o[2], fo0, PKF(fa.l0, fa.h0)); if (HM) { ca0 = cvtpk(pm[0], pm[1]); ca1 = cvtpk(pm[2], pm[3]); cb0 = cvtpk(pm[4], pm[5]); cb1 = cvtpk(pm[6], pm[7]); } \
    GAP(); \
    if (HP) MMA(o[2], fo1, PKF(fa.l1, fa.h1)); \
    GAP(); \
    if (HP) MMA(o[3], fo0, PKF(fb.l0, fb.h0)); \
    GAP(); \
    if (HP) MMA(o[3], fo1, PKF(fb.l1, fb.h1)); \
    GAP(); \
    if (HM) { auto r0 = __builtin_amdgcn_permlane32_swap(ca0, cb0, false, false); auto r1 = __builtin_amdgcn_permlane32_swap(ca1, cb1, false, false); \
        u32x4 w_ = {r0[0], r1[0], r0[1], r1[1]}; fn0 = *reinterpret_cast<bf16x8*>(&w_); \
        ca0 = cvtpk(pm[8], pm[9]); ca1 = cvtpk(pm[10], pm[11]); cb0 = cvtpk(pm[12], pm[13]); cb1 = cvtpk(pm[14], pm[15]); } \
    if (HP) MMA(o[2], fp0, PKF(fa.l2, fa.h2)); \
    GAP(); \
    if (HM) { auto r0 = __builtin_amdgcn_permlane32_swap(ca0, cb0, false, false); auto r1 = __builtin_amdgcn_permlane32_swap(ca1, cb1, false, false); \
        u32x4 w_ = {r0[0], r1[0], r0[1], r1[1]}; fn1 = *reinterpret_cast<bf16x8*>(&w_); } \
    if (HP) MMA(o[2], fp1, PKF(fa.l3, fa.h3)); \
    GAP(); \
    if (HM) { *(lds_b8*)(Pown + (B) * 16384) = fn0; *(lds_b8*)(Pown + (B) * 16384 + 1024) = fn1; } \
    if (HP) MMA(o[3], fp0, PKF(fb.l2, fb.h2)); \
    GAP(); \
    if (HP) MMA(o[3], fp1, PKF(fb.l3, fb.h3)); \
    GAP(); \
    if (HM) { if (__any(alpha < 1.f)) { if (hi == 0) al_l[r32] = alpha; asm volatile("s_waitcnt lgkmcnt(0)" ::: "memory"); \
            _Pragma("unroll") for (int d = 0; d < 4; ++d) _Pragma("unroll") for (int r = 0; r < 16; ++r) o[d][r] *= al_l[crow(r, hi)]; } \
        fo0 = fn0; fo1 = fn1; } \
    LBAR(); \
    if (HQ) { pm = pq; pmax = pmaxq; } } while (0)
  PSEG(-1, 1, 1, 0, 0);
  PSEG(0, 0, 1, 1, 0);
#pragma unroll 1
  for (int k = 1; k < NT - 1; k += 2) { PSEG(k, 1, 1, 1, 1); PSEG(k + 1, 0, 1, 1, 1); }
  PSEG(NT - 1, 1, 0, 1, 1);
  PSEG(NT, 0, 0, 0, 1);
  if (hi == 0) li[wid * 32 + r32] = l_reg;
  LBAR();
  float rli[16];
#pragma unroll
  for (int r = 0; r < 16; ++r) rli[r] = __builtin_amdgcn_rcpf(li[wid * 32 + crow(r, hi)] + li[(wid ^ 4) * 32 + crow(r, hi)]);
  bf16* Ow = (kh ? O1 : O0) + (long)(pr * 32) * 128;
  typedef __attribute__((address_space(3))) unsigned short lds_u16; typedef __attribute__((address_space(3))) u32x4 lds_q;
  lds_u16* ost = (lds_u16*)(L + PV_OFF + wid * 8192);
#pragma unroll
  for (int r = 0; r < 16; r += 2)
#pragma unroll
    for (int d0 = 0; d0 < 4; ++d0) { const unsigned w = cvtpk(o[d0][r] * rli[r], o[d0][r + 1] * rli[r + 1]);
      ost[crow(r, hi) * 128 + d0 * 32 + r32] = (unsigned short)w; ost[crow(r + 1, hi) * 128 + d0 * 32 + r32] = (unsigned short)(w >> 16); }
  asm volatile("s_waitcnt lgkmcnt(0)" ::: "memory");
#pragma unroll
  for (int i = 0; i < 8; ++i) { const int row = i * 4 + (lane >> 4), c8 = lane & 15;
    const u32x4 v = *(const lds_q*)(L + PV_OFF + wid * 8192 + row * 256 + c8 * 16); *(u32x4*)(Ow + (long)row * 128 + c8 * 8) = v; }
#undef PK4
#undef PSEG
#undef TRR
#undef PVREAD
#undef PKF
#undef MMA
#undef KF
#undef EXP2
#undef DMAK
#undef DMAV
}
#undef LBAR
#undef GAP
#undef KSWZ
#undef SBAR
}
constexpr int NWAVES = 8;
constexpr int DM = 2048, NBATCH = 4, SEQ = 2048, CTXL = 256;
constexpr int TL = NBATCH * SEQ, TC = NBATCH * CTXL, TT = TL + TC;
constexpr int N0 = 9248, N0P = 9472, N1 = 6144;
constexpr int NE = 64, TCAP = TT;
constexpr int MAXROWS = 99328;
constexpr int C_Z = 3072, C_A = 4096, C_B = 4112, C_HQ = 4128, C_HF = 5152, C_HI = 7200, C_OG = 8224;
constexpr float EPS = 1e-6f;
constexpr float LAM_INIT = 0.35550906759310186f;
constexpr size_t MiB = 1u << 20;
constexpr size_t WS_CTL = 0, CTL_ZERO_BYTES = 1 * MiB;
constexpr size_t WS_MODV = 2, WS_LTOK = 3, WS_LW = 6, WS_SELE = 9, WS_SELP = 10, WS_SLOTW = 11, WS_G = 12, WS_BETA = 14;
constexpr size_t WS_WIN0 = 16, WS_WOUT0 = 53, WS_GU0 = 61, WS_DN0 = 321, WS_WIN1 = 451, WS_WOUT1 = 475, WS_GU1 = 483, WS_DN1 = 743;
constexpr size_t WS_XR = 873, WS_H = 945, WS_BIG = 981;
constexpr size_t WS_PROJ0 = WS_BIG, WS_SQD = 1144, WS_SKDT = 1216, WS_SATT = 1288, WS_SU0T = 1324, WS_SW = 1468, WS_SGLV = 1504, WS_OD = 1508, WS_OH = 1580, WS_Y = 1652;
constexpr size_t WS_QKV = WS_BIG, WS_Q = 1089, WS_K = 1121, WS_V = 1157, WS_OATT = 1193;
constexpr size_t WS_HA = WS_BIG, WS_ACT = 1369;
constexpr size_t WS_END = 1690;
constexpr int CW_TMO = 0, CW_BAR = 4096, CW_CNT = 8192, CW_QHEAD = 8448, CW_DONE = 8960;
constexpr int RING_BYTES = 131072, LDSCTL_OFF = RING_BYTES, LDS_BYTES = 147456;
constexpr int L_TILEE = LDSCTL_OFF;
constexpr int L_RSTART = LDSCTL_OFF + 2048;
constexpr int L_CNT = LDSCTL_OFF + 2048 + 512;
constexpr int L_MISC = LDSCTL_OFF + 4096;
constexpr int L_XT = LDSCTL_OFF + 8192;
constexpr int L_XTN = LDSCTL_OFF + 8192 + 2048;

struct Args { const float* in[38]; float* out; unsigned char* ws; };
struct Frame { LAS unsigned char* lds; unsigned char* ldsg; int tid, lane, wave, G, bid; unsigned char* ws; gu32* ctl; };

typedef const float* cfptr_t;
__device__ __forceinline__ const float* ARG(int i) {
    unsigned long long b = (unsigned long long)__builtin_amdgcn_kernarg_segment_ptr(); asm volatile("" : "+s"(b));
    return ((const __attribute__((address_space(4))) cfptr_t*)b)[i];
}
__device__ __forceinline__ float* ARG_OUT() { return (float*)ARG(38); }
__device__ __forceinline__ float wave_sum(float v) {
#pragma unroll
    for (int o = 1; o < 64; o <<= 1) v += __shfl_xor(v, o);
    return v;
}
__device__ __forceinline__ float bf2f(unsigned short b) { return __uint_as_float(((unsigned)b) << 16); }
__device__ __forceinline__ float bflo(unsigned w) { return __uint_as_float(w << 16); }
__device__ __forceinline__ float bfhi(unsigned w) { return __uint_as_float(w & 0xffff0000u); }
__device__ __forceinline__ float sigmoidf_(float x) { return 1.f / (1.f + __expf(-x)); }
__device__ __forceinline__ float siluf_(float x) { return x / (1.f + __expf(-x)); }
__device__ __forceinline__ void unpack8(const v4u w, float (&o)[8]) {
    o[0] = bflo(w.x); o[1] = bfhi(w.x); o[2] = bflo(w.y); o[3] = bfhi(w.y); o[4] = bflo(w.z); o[5] = bfhi(w.z); o[6] = bflo(w.w); o[7] = bfhi(w.w);
}
__device__ __forceinline__ v4u pack8(const float (&o)[8]) { v4u w; w.x = pk2(o[0], o[1]); w.y = pk2(o[2], o[3]); w.z = pk2(o[4], o[5]); w.w = pk2(o[6], o[7]); return w; }

__device__ __forceinline__ void phase_mod(Frame& F, const Args& A) {
    LAS float* sc = (LAS float*)(F.lds);
    LAS float* part = (LAS float*)(F.lds + 40960);
    float* modv = (float*)(F.ws + WS_MODV * MiB);
    for (int i = F.tid; i < 5 * 2048; i += 512) { const int r = i >> 11, k = i & 2047; const float v = (r < 4) ? ARG(1)[r * 2048 + k] : ARG(3)[k]; sc[i] = siluf_(v); }
    __syncthreads();
    const int kq = F.lane >> 4, c4 = F.lane & 15;
    for (int item = F.bid; item < 384; item += F.G) {
        const int l = item / 192, cb = item % 192;
        const float* W = l ? ARG(22) : ARG(5); const float* Bv = l ? ARG(23) : ARG(6);
        float acc[5][4];
#pragma unroll
        for (int r = 0; r < 5; ++r)
#pragma unroll
            for (int j = 0; j < 4; ++j) acc[r][j] = 0.f;
        const float* wp = W + (size_t)(F.wave * 256 + kq) * 12288 + cb * 64 + c4 * 4;
#pragma unroll 8
        for (int i = 0; i < 64; ++i) {
            const f32x4 w = *(const f32x4*)(wp + (size_t)i * 4 * 12288);
            const int k = F.wave * 256 + 4 * i + kq;
#pragma unroll
            for (int r = 0; r < 5; ++r) { const float s = sc[r * 2048 + k];
#pragma unroll
                for (int j = 0; j < 4; ++j) acc[r][j] += s * w[j]; }
        }
#pragma unroll
        for (int r = 0; r < 5; ++r)
#pragma unroll
            for (int j = 0; j < 4; ++j) { float a = acc[r][j]; a += __shfl_xor(a, 16); a += __shfl_xor(a, 32); acc[r][j] = a; }
        if (kq == 0) {
#pragma unroll
            for (int r = 0; r < 5; ++r)
#pragma unroll
                for (int j = 0; j < 4; ++j) part[(F.wave * 5 + r) * 64 + c4 * 4 + j] = acc[r][j];
        }
        __syncthreads();
        if (F.tid < 320) { const int r = F.tid >> 6, cc = F.tid & 63; float s = 0.f;
#pragma unroll
            for (int w = 0; w < 8; ++w) s += part[(w * 5 + r) * 64 + cc];
            modv[(size_t)(l * 5 + r) * 12288 + cb * 64 + cc] = s + Bv[cb * 64 + cc]; }
        __syncthreads();
    }
}

template <int MODE> __device__ __forceinline__ void transpose_item(const float* W, int K, int N, bf16* WT, LAS float* scr, int item, int lane) {
    const int nblk = N / 32, kb = item / nblk, nb = item % nblk, k0 = 64 * kb, n0 = 32 * nb;
    const int d0 = MODE ? (256 * ((n0 & 511) >> 7) + 128 * (n0 >> 9) + (n0 & 127)) : n0;
#pragma unroll 8
    for (int i = 0; i < 32; ++i) { const int kk = 2 * i + (lane >> 5); scr[kk * 33 + (lane & 31)] = W[(size_t)(k0 + kk) * N + n0 + (lane & 31)]; }
    LDS_WAIT(); asm volatile("" ::: "memory");
    const int c = lane & 7;
#pragma unroll
    for (int j = 0; j < 4; ++j) { const int n = (lane >> 3) + 8 * j; const LAS float* s = scr + (8 * c) * 33 + n;
        v4u o; o.x = pk2(s[0 * 33], s[1 * 33]); o.y = pk2(s[2 * 33], s[3 * 33]); o.z = pk2(s[4 * 33], s[5 * 33]); o.w = pk2(s[6 * 33], s[7 * 33]);
        *(GAS v4u*)(WT + (size_t)(d0 + n) * K + k0 + 8 * c) = o; }
    LDS_WAIT(); asm volatile("" ::: "memory");
}
constexpr int CV_IN0 = 32 * 289, CV_OUT = 32 * 64, CV_GU = 32 * 32, CV_DN = 8 * 64, CV_IN1 = 32 * 192;
constexpr int CV_PER_L = NE * CV_GU + CV_GU + NE * CV_DN + CV_DN;
constexpr int CVQ_L0END = CV_PER_L, CVQ_IN1END = CV_PER_L + CV_IN1 + CV_OUT, CVQ_END = CVQ_IN1END + CV_PER_L;
constexpr int CVB = 8;
__device__ __forceinline__ void convert_qitem(Frame& F, int q, LAS float* scr, int lane_) {
    unsigned char* ws = F.ws; int r = q, l = 0;
    if (r >= CVQ_L0END) { r -= CVQ_L0END;
        if (r < CV_IN1) { transpose_item<0>(ARG(26), 2048, N1, (bf16*)(ws + WS_WIN1 * MiB), scr, r, lane_); return; } r -= CV_IN1;
        if (r < CV_OUT) { transpose_item<0>(ARG(31), 2048, 2048, (bf16*)(ws + WS_WOUT1 * MiB), scr, r, lane_); return; } r -= CV_OUT;
        l = 1; }
    const float* egu = l ? ARG(34) : ARG(18); const float* edn = l ? ARG(35) : ARG(19);
    const float* sgu = l ? ARG(36) : ARG(20); const float* sdn = l ? ARG(37) : ARG(21);
    bf16* GU = (bf16*)(ws + (l ? WS_GU1 : WS_GU0) * MiB); bf16* DN = (bf16*)(ws + (l ? WS_DN1 : WS_DN0) * MiB);
    if (r < NE * CV_GU) { const int e = r / CV_GU; transpose_item<1>(egu + (size_t)e * 2048 * 1024, 2048, 1024, GU + (size_t)e * 1024 * 2048, scr, r % CV_GU, lane_); return; } r -= NE * CV_GU;
    if (r < CV_GU) { transpose_item<1>(sgu, 2048, 1024, GU + (size_t)NE * 1024 * 2048, scr, r, lane_); return; } r -= CV_GU;
    if (r < NE * CV_DN) { const int e = r / CV_DN; transpose_item<0>(edn + (size_t)e * 512 * 2048, 512, 2048, DN + (size_t)e * 2048 * 512, scr, r % CV_DN, lane_); return; } r -= NE * CV_DN;
    transpose_item<0>(sdn, 512, 2048, DN + (size_t)NE * 2048 * 512, scr, r, lane_);
}
__device__ __forceinline__ void convert_queue(Frame& F, int limit, const gu32* stop, unsigned target) {
    int tl = threadIdx.x; asm volatile("" : "+v"(tl));
    const int lane_ = tl & 63, wave_ = __builtin_amdgcn_readfirstlane(tl >> 6);
    LAS float* scr = (LAS float*)(F.lds + 51200 + wave_ * 8704);
    volatile LAS int* qc = (volatile LAS int*)(F.lds + L_MISC + 64);
    const int x = F.bid & 7;
    gu32* qhead = F.ctl + CW_QHEAD + 64 * x;
    const int lim_loc = (limit - x + 7) >> 3, end_loc = (CVQ_END - x + 7) >> 3;
    const int kb = stop ? 1 : 2;
    for (;;) {
        __syncthreads();
        if (tl == 0) { int base = -1;
            bool go = true; if (stop) go = __hip_atomic_load(stop, RLX_AGENT) < target;
            if (go) base = (int)__hip_atomic_fetch_add(qhead, (unsigned)(8 * kb), RLX_AGENT);
            qc[0] = base; }
        __syncthreads();
        const int base = qc[0];
        if (base < 0) break;
#pragma unroll 1
        for (int j = 0; j < kb; ++j) { const int li = base + j * 8 + wave_; if (li < end_loc) convert_qitem(F, 8 * li + x, scr, lane_); }
        if (base + 8 * kb >= lim_loc) break;
    }
}
__device__ __forceinline__ void phase_tail_fill(Frame& F, int ph, bool busy, unsigned nbusy) {
    gu32* done = F.ctl + CW_DONE + 64 * ph;
    if (busy) { asm volatile("" ::: "memory"); if (F.tid == 0) __hip_atomic_fetch_add(done, 1u, RLX_AGENT); }
    else { __syncthreads(); convert_queue(F, CVQ_END, done, nbusy); }
}
__device__ __forceinline__ void phase_convert(Frame& F, const Args& A) {
    LAS float* scr = (LAS float*)(F.lds + 51200 + F.wave * 8704);
    const int gw = F.bid * NWAVES + F.wave, NGW = F.G * NWAVES;
    unsigned char* ws = F.ws;
    for (int it = gw; it < CV_IN0 + CV_OUT; it += NGW) {
        if (it < CV_IN0) transpose_item<0>(ARG(9), 2048, N0, (bf16*)(ws + WS_WIN0 * MiB), scr, it, F.lane);
        else transpose_item<0>(ARG(15), 2048, 2048, (bf16*)(ws + WS_WOUT0 * MiB), scr, it - CV_IN0, F.lane);
    }
    { v4u z; z.x = z.y = z.z = z.w = 0u; GAS v4u* p = (GAS v4u*)(ws + WS_WIN0 * MiB + (size_t)N0 * 2048 * 2);
      for (int i = F.bid * 512 + F.tid; i < (N0P - N0) * 2048 * 2 / 16; i += F.G * 512) p[i] = z; }
}

__device__ __forceinline__ void norm_row_regs(const float* xr, const float* nw, const float* sh, const float* scl, int lane, f32x4 (&o)[8]) {
    f32x4 v[8]; float ss = 0.f;
#pragma unroll
    for (int j = 0; j < 8; ++j) { v[j] = *(const f32x4*)(xr + j * 256 + lane * 4); ss += (v[j].x * v[j].x + v[j].y * v[j].y) + (v[j].z * v[j].z + v[j].w * v[j].w); }
    const float rstd = 1.f / sqrtf(wave_sum(ss) * (1.f / 2048.f) + EPS);
#pragma unroll
    for (int j = 0; j < 8; ++j) { const int c = j * 256 + lane * 4; const f32x4 w = *(const f32x4*)(nw + c), s = *(const f32x4*)(sh + c), g = *(const f32x4*)(scl + c);
        o[j] = v[j] * rstd * w * (g + 1.f) + s; }
}
__device__ __forceinline__ int bidx_of_row(int row) { return row < TL ? (row >> 11) : 4; }
__device__ __forceinline__ void phase_norm0(Frame& F, const Args& A) {
    const float* modv = (const float*)(F.ws + WS_MODV * MiB); bf16* H = (bf16*)(F.ws + WS_H * MiB);
    const int gw = F.bid * NWAVES + F.wave, NGW = F.G * NWAVES;
    for (int row = gw; row < TT; row += NGW) {
        const float* xr = row < TL ? ARG(0) + (size_t)row * DM : ARG(2) + (size_t)(row - TL) * DM;
        const float* mv = modv + (size_t)bidx_of_row(row) * 12288;
        f32x4 o[8]; norm_row_regs(xr, ARG(7), mv, mv + 2048, F.lane, o);
#pragma unroll
        for (int j = 0; j < 8; ++j) { uint2 w; w.x = pk2(o[j].x, o[j].y); w.y = pk2(o[j].z, o[j].w); *(uint2*)(H + (size_t)row * DM + j * 256 + F.lane * 4) = w; }
    }
}

typedef float f32x16 __attribute__((ext_vector_type(16)));
typedef unsigned u32x2 __attribute__((ext_vector_type(2)));
__device__ __forceinline__ int crow16(int r, int hi) { return (r & 3) + 8 * (r >> 2) + 4 * hi; }
__device__ __forceinline__ size_t rec_of(int type, int b, int h, int dir, int ci) { return (size_t)((((type * 4 + b) * 8 + h) * 2 + dir) * 36 + ci); }
__device__ __forceinline__ int blk_row0(int b, int tb) { return tb < 4 ? TL + b * CTXL + tb * 64 : b * SEQ + (tb - 4) * 64; }
__device__ __forceinline__ int blk_ci(int tb, int dir) { return dir ? (tb < 4 ? 3 - tb : 4 + 35 - tb) : tb; }

template <int J> struct SubstCol {
    static __device__ __forceinline__ void run(float (&R)[64], const LAS float* At) {
        const float xj = R[J];
#pragma unroll
        for (int i4 = (J + 1) / 4; i4 < 16; ++i4) { const f32x4 a4 = *(const LAS f32x4*)(At + J * 64 + i4 * 4);
            if (i4 * 4 + 0 > J) R[i4 * 4 + 0] -= a4.x * xj;
            if (i4 * 4 + 1 > J) R[i4 * 4 + 1] -= a4.y * xj;
            if (i4 * 4 + 2 > J) R[i4 * 4 + 2] -= a4.z * xj;
            if (i4 * 4 + 3 > J) R[i4 * 4 + 3] -= a4.w * xj; }
        SubstCol<J + 1>::run(R, At);
    }
};
template <> struct SubstCol<63> { static __device__ __forceinline__ void run(float (&)[64], const LAS float*) {} };

__device__ __forceinline__ void phase_s1_dn(Frame& F) {
    const bf16* P = (const bf16*)(F.ws + WS_PROJ0 * MiB);
    bf16* QDg = (bf16*)(F.ws + WS_SQD * MiB); bf16* ATg = (bf16*)(F.ws + WS_SATT * MiB); bf16* KDg = (bf16*)(F.ws + WS_SKDT * MiB);
    bf16* U0g = (bf16*)(F.ws + WS_SU0T * MiB); float* GLg = (float*)(F.ws + WS_SGLV * MiB); bf16* Wg = (bf16*)(F.ws + WS_SW * MiB);
    const float* cw = ARG(10);
    LAS unsigned char* L = F.lds;
    constexpr int O_RAW = 0;
    constexpr int O_KK = 0, O_QK = 16640, O_AM = 33280;
    constexpr int O_QB = 66560, O_KB = 83968, O_VB = 101376;
    constexpr int O_GC = 118784, O_BT = 119296;
    constexpr int O_CW = 119808;
    constexpr int O_SC = 127488;
    const int tid = F.tid, lane = F.lane, w = F.wave, l16 = tid & 15;
    for (int unit = F.bid; unit < NBATCH * 8 * 36; unit += F.G) {
        const int tb = unit % 36, bh = unit / 36, h = bh & 7, b = bh >> 3;
        const int row0 = blk_row0(b, tb);
        const int tloc0 = tb < 4 ? tb * 64 : (tb - 4) * 64, Lseg = tb < 4 ? CTXL : SEQ;
        { v4u rr_[7]; f32x4 cwr = {0.f, 0.f, 0.f, 0.f}; int tl = tid; asm volatile("" : "+v"(tl));
#pragma unroll
          for (int q = 0; q < 7; ++q) { const int idx = tl + 512 * q, rr = idx / 48, pc = idx % 48, vec = pc >> 4, c16 = pc & 15; const int tt = tloc0 + rr - 2;
              rr_[q] = (v4u){0u, 0u, 0u, 0u};
              if (idx < 68 * 48 && tt >= 0 && tt < Lseg) rr_[q] = *(const v4u*)(P + (size_t)(row0 + rr - 2) * N0 + vec * 1024 + h * 128 + c16 * 8); }
          if (tid < 480) { const int vec = tid / 160, off = tid % 160; cwr = *(const f32x4*)(cw + (size_t)(vec * 1024 + h * 128) * 5 + off * 4); }
#pragma unroll
          for (int q = 0; q < 7; ++q) { const int idx = tl + 512 * q, rr = idx / 48, pc = idx % 48; if (idx < 68 * 48) *(LAS v4u*)(L + O_RAW + rr * 768 + pc * 16) = rr_[q]; }
          if (tid < 480) { const int vec = tid / 160, off = tid % 160; LAS float* cwl = (LAS float*)(L + O_CW) + vec * 640;
#pragma unroll
              for (int c = 0; c < 4; ++c) { const int f = off * 4 + c; cwl[(f % 5) * 128 + f / 5] = cwr[c]; } } }
        __syncthreads();
        if (tid < 384) { const int strip = (tid >> 4) & 7, vec = tid >> 7;
            float wv[40]; { const LAS float* wp = (const LAS float*)(L + O_CW) + vec * 640 + l16 * 8;
#pragma unroll
                for (int t5 = 0; t5 < 5; ++t5) { const f32x4 w0 = *(const LAS f32x4*)(wp + t5 * 128), w1 = *(const LAS f32x4*)(wp + t5 * 128 + 4);
                    wv[0 * 5 + t5] = w0.x; wv[1 * 5 + t5] = w0.y; wv[2 * 5 + t5] = w0.z; wv[3 * 5 + t5] = w0.w; wv[4 * 5 + t5] = w1.x; wv[5 * 5 + t5] = w1.y; wv[6 * 5 + t5] = w1.z; wv[7 * 5 + t5] = w1.w; } }
            v4u raw[12];
#pragma unroll
            for (int r = 0; r < 12; ++r) raw[r] = *(const LAS v4u*)(L + O_RAW + (strip * 8 + r) * 768 + (vec * 16 + l16) * 16);
#pragma unroll
            for (int r = 0; r < 8; ++r) { float acc[8];
#pragma unroll
                for (int e = 0; e < 8; ++e) acc[e] = 0.f;
#pragma unroll
                for (int t5 = 0; t5 < 5; ++t5) { float xf[8]; unpack8(raw[r + t5], xf);
#pragma unroll
                    for (int e = 0; e < 8; ++e) acc[e] += xf[e] * wv[e * 5 + t5]; }
#pragma unroll
                for (int e = 0; e < 8; ++e) acc[e] = siluf_(acc[e]);
                if (vec < 2) { float ss = 0.f;
#pragma unroll
                    for (int e = 0; e < 8; ++e) ss += acc[e] * acc[e];
                    ss += __shfl_xor(ss, 1); ss += __shfl_xor(ss, 2); ss += __shfl_xor(ss, 4); ss += __shfl_xor(ss, 8);
                    float inv = 1.f / sqrtf(ss + 1e-6f); if (vec == 0) inv *= 0.08838834764831845f;
#pragma unroll
                    for (int e = 0; e < 8; ++e) acc[e] *= inv; }
                *(LAS v4u*)(L + (vec == 0 ? O_QB : (vec == 1 ? O_KB : O_VB)) + (strip * 8 + r) * 272 + l16 * 16) = pack8(acc); }
        }
        if (w < 2) { const int dir = w, ti = dir ? 63 - lane : lane; const size_t prow = (size_t)(row0 + ti) * N0;
            const float a = bf2f(P[prow + C_A + dir * 8 + h]) + ARG(12)[dir * 8 + h];
            const float sp = fmaxf(a, 0.f) + log1pf(__expf(-fabsf(a)));
            float g = -__expf(ARG(11)[dir * 8 + h]) * sp;
#pragma unroll
            for (int o = 1; o < 64; o <<= 1) { const float v = __shfl_up(g, o); if (lane >= o) g += v; }
            ((LAS float*)(L + O_GC))[dir * 64 + lane] = g;
            ((LAS float*)(L + O_BT))[dir * 64 + lane] = sigmoidf_(bf2f(P[prow + C_B + dir * 8 + h])); }
        __syncthreads();
        { const int mat = w >> 2, rb = (w >> 1) & 1, cb = w & 1, l32 = lane & 31, hi = lane >> 5;
          f32x16 acc = {};
#pragma unroll
          for (int ks = 0; ks < 8; ++ks) { const bf16x8 a = *(const LAS bf16x8*)(L + (mat ? O_QB : O_KB) + (rb * 32 + l32) * 272 + (ks * 16 + hi * 8) * 2);
              const bf16x8 bb = *(const LAS bf16x8*)(L + O_KB + (cb * 32 + l32) * 272 + (ks * 16 + hi * 8) * 2);
              acc = __builtin_amdgcn_mfma_f32_32x32x16_bf16(a, bb, acc, 0, 0, 0); }
          LAS float* dstm = (LAS float*)(L + (mat ? O_QK : O_KK));
#pragma unroll
          for (int r = 0; r < 16; ++r) dstm[(rb * 32 + crow16(r, hi)) * 65 + cb * 32 + l32] = acc[r]; }
        __syncthreads();
        { int tl2 = tid; asm volatile("" : "+v"(tl2));
          const int dir = w >> 2, t = tl2 & 255, wl = w & 3, lane2 = tl2 & 63, l32 = lane2 & 31, hi = lane2 >> 5;
          const LAS float* gc = (const LAS float*)(L + O_GC) + dir * 64; const LAS float* bt = (const LAS float*)(L + O_BT) + dir * 64;
          const LAS float* KKs = (const LAS float*)(L + O_KK); const LAS float* QKs = (const LAS float*)(L + O_QK);
          LAS float* Am = (LAS float*)(L + O_AM) + dir * 4096;
          const int ci = blk_ci(tb, dir);
          const size_t rec = rec_of(0, b, h, dir, ci), recw = (size_t)(((b * 8 + h) * 2 + dir) * 36 + ci);
#pragma unroll 1
          for (int q = 0; q < 16; ++q) { const int idx = t + 256 * q, j = idx >> 6, i = idx & 63; const int ti = dir ? 63 - i : i, tj = dir ? 63 - j : j;
              Am[j * 64 + i] = (j < i) ? bt[i] * KKs[ti * 65 + tj] * __expf(gc[i] - gc[j]) : 0.f; }
#pragma unroll 1
          for (int q = 0; q < 2; ++q) { const int idx = t + 256 * q, i = idx >> 3, j8 = idx & 7, ti = dir ? 63 - i : i; float xf[8];
#pragma unroll
              for (int e = 0; e < 8; ++e) { const int j = j8 * 8 + e, tj = dir ? 63 - j : j; xf[e] = (j <= i) ? QKs[ti * 65 + tj] * __expf(gc[i] - gc[j]) : 0.f; }
              *(v4u*)(ATg + rec * 4096 + i * 64 + j8 * 8) = pack8(xf); }
          if (t < 128) { const int j = t & 63; ((LAS float*)(L + O_SC))[dir * 128 + t] = (t < 64) ? bt[j] : bt[j] * __expf(gc[j]); }
          __syncthreads();
          LAS unsigned short* TI = (LAS unsigned short*)(L + O_KK) + dir * 4608;
          if (wl == 0) {
              float X[64];
#pragma unroll
              for (int i = 0; i < 64; ++i) X[i] = (i == lane2) ? 1.f : 0.f;
              SubstCol<0>::run(X, Am);
#pragma unroll
              for (int i = 0; i < 64; ++i) TI[i * 72 + lane2] = (unsigned short)f2bf(X[i]);
          } else { const int t3 = t - 64;
#pragma unroll 1
              for (int idx = t3; idx < 1024; idx += 192) { const int i = idx >> 4, k8 = idx & 15, ti = dir ? 63 - i : i; const float eg = __expf(gc[i]);
                  float xf[8]; unpack8(*(const LAS v4u*)(L + O_QB + ti * 272 + k8 * 16), xf);
#pragma unroll
                  for (int e = 0; e < 8; ++e) xf[e] *= eg;
                  *(v4u*)(QDg + rec * 8192 + i * 128 + k8 * 8) = pack8(xf); }
#pragma unroll 1
              for (int idx = t3; idx < 1024; idx += 192) { const int j8 = idx >> 7, kk = idx & 127; float xf[8];
#pragma unroll
                  for (int e = 0; e < 8; ++e) { const int j = j8 * 8 + e, tj = dir ? 63 - j : j; xf[e] = bf2f(*(const LAS unsigned short*)(L + O_KB + tj * 272 + kk * 2)) * __expf(gc[63] - gc[j]); }
                  *(v4u*)(KDg + rec * 8192 + kk * 64 + j8 * 8) = pack8(xf); }
              if (t3 < 128) GLg[rec * 128 + t3] = __expf(gc[63]);
          }
          __syncthreads();
#pragma unroll 1
          for (int cbi = 0; cbi < 2; ++cbi) { const int cb = 2 * wl + cbi, col = cb * 32 + l32; const bool isk = cb >= 4;
              const LAS unsigned char* colp = L + (isk ? O_KB + (col - 128) * 2 : O_VB + col * 2);
              const LAS float* scp = (const LAS float*)(L + O_SC) + dir * 128 + (isk ? 64 : 0);
              f32x16 acc0 = {}, acc1 = {};
#pragma unroll
              for (int ks = 0; ks < 4; ++ks) { float f[8];
#pragma unroll
                  for (int e = 0; e < 8; ++e) { const int j = ks * 16 + hi * 8 + e, tj = dir ? 63 - j : j; f[e] = bf2f(*(const LAS unsigned short*)(colp + tj * 272)) * scp[j]; }
                  const v4u bw = pack8(f); const bf16x8 rfrag = __builtin_bit_cast(bf16x8, bw);
                  const bf16x8 t0 = *(const LAS bf16x8*)(TI + (l32) * 72 + ks * 16 + hi * 8), t1 = *(const LAS bf16x8*)(TI + (32 + l32) * 72 + ks * 16 + hi * 8);
                  if (!isk) { acc0 = __builtin_amdgcn_mfma_f32_32x32x16_bf16(t0, rfrag, acc0, 0, 0, 0); acc1 = __builtin_amdgcn_mfma_f32_32x32x16_bf16(t1, rfrag, acc1, 0, 0, 0); }
                  else      { acc0 = __builtin_amdgcn_mfma_f32_32x32x16_bf16(rfrag, t0, acc0, 0, 0, 0); acc1 = __builtin_amdgcn_mfma_f32_32x32x16_bf16(rfrag, t1, acc1, 0, 0, 0); } }
              if (!isk) { bf16* up = U0g + rec * 8192 + (size_t)col * 64 + 4 * hi;
#pragma unroll
                  for (int q = 0; q < 4; ++q) { u32x2 o0, o1; o0.x = pk2(acc0[q * 4], acc0[q * 4 + 1]); o0.y = pk2(acc0[q * 4 + 2], acc0[q * 4 + 3]); o1.x = pk2(acc1[q * 4], acc1[q * 4 + 1]); o1.y = pk2(acc1[q * 4 + 2], acc1[q * 4 + 3]);
                      *(u32x2*)(up + 8 * q) = o0; *(u32x2*)(up + 32 + 8 * q) = o1; } }
              else { bf16* wp0 = Wg + recw * 8192 + (size_t)l32 * 128 + (cb * 32 - 128) + 4 * hi;
#pragma unroll
                  for (int q = 0; q < 4; ++q) { u32x2 o0, o1; o0.x = pk2(acc0[q * 4], acc0[q * 4 + 1]); o0.y = pk2(acc0[q * 4 + 2], acc0[q * 4 + 3]); o1.x = pk2(acc1[q * 4], acc1[q * 4 + 1]); o1.y = pk2(acc1[q * 4 + 2], acc1[q * 4 + 3]);
                      *(u32x2*)(wp0 + 8 * q) = o0; *(u32x2*)(wp0 + 32 * 128 + 8 * q) = o1; } }
          }
        }
        __syncthreads();
    }
}

__device__ __forceinline__ void phase_s1_hg(Frame& F) {
    const bf16* P = (const bf16*)(F.ws + WS_PROJ0 * MiB);
    bf16* QDg = (bf16*)(F.ws + WS_SQD * MiB); bf16* ATg = (bf16*)(F.ws + WS_SATT * MiB); bf16* KDg = (bf16*)(F.ws + WS_SKDT * MiB);
    bf16* U0g = (bf16*)(F.ws + WS_SU0T * MiB); float* GLg = (float*)(F.ws + WS_SGLV * MiB);
    const float* lbl = ARG(4);
    LAS unsigned char* L = F.lds;
    constexpr int O_FF = 0, O_CU = 32768;
    constexpr int O_QS = 65536, O_KS = 82944;
    constexpr int O_AM = 0, O_HV = 32768;
    const int lane = F.lane, w = F.wave;
    for (int unit = F.bid; unit < NBATCH * 8 * 36 * 2; unit += F.G) {
        int tid = F.tid; asm volatile("" : "+v"(tid));
        const int dir = unit & 1, u2 = unit >> 1, tb = u2 % 36, bh = u2 / 36, h = bh & 7, b = bh >> 3;
        const int row0 = blk_row0(b, tb), ci = blk_ci(tb, dir);
        const size_t rec = rec_of(1, b, h, dir, ci);
        v4u hvr[4];
#pragma unroll
        for (int q = 0; q < 4; ++q) { hvr[q] = (v4u){0u, 0u, 0u, 0u};
            if (w >= 4) { const int idx = (tid - 256) + 256 * q, i = idx >> 4, c16 = idx & 15, ti = dir ? 63 - i : i; hvr[q] = *(const v4u*)(P + (size_t)(row0 + ti) * N0 + C_HI + h * 128 + c16 * 8); } }
        float qreg[2][8];
#pragma unroll
        for (int q = 0; q < 2; ++q) { const int idx = tid + 512 * q, i = idx >> 4, k8 = idx & 15, ti = dir ? 63 - i : i; const size_t prow = (size_t)(row0 + ti) * N0;
            float xg[8]; unpack8(*(const v4u*)(P + prow + C_HQ + h * 128 + k8 * 8), qreg[q]); unpack8(*(const v4u*)(P + prow + C_HF + dir * 1024 + h * 128 + k8 * 8), xg);
#pragma unroll
            for (int e = 0; e < 8; ++e) { const int c = h * 128 + k8 * 8 + e; const float e0 = __expf(lbl[c]), e1 = __expf(lbl[1024 + c]), e2 = __expf(lbl[2048 + c]); const float lb = e0 / (e0 + e1 + e2);
                qreg[q][e] = siluf_(qreg[q][e]); xg[e] = lb + (1.f - lb) * sigmoidf_(xg[e]); }
            LAS float* fd = (LAS float*)(L + O_FF) + i * 128 + k8 * 8;
            *(LAS f32x4*)fd = (f32x4){xg[0], xg[1], xg[2], xg[3]}; *(LAS f32x4*)(fd + 4) = (f32x4){xg[4], xg[5], xg[6], xg[7]}; }
        __syncthreads();
        { const int kch = tid & 127, part = tid >> 7; const LAS float* ff = (const LAS float*)(L + O_FF); LAS float* cu = (LAS float*)(L + O_CU); LAS float* tot = (LAS float*)(L + O_QS);
          float loc[16]; float s = 0.f;
#pragma unroll
          for (int i = 0; i < 16; ++i) { s += __logf(ff[(part * 16 + i) * 128 + kch]); loc[i] = s; }
          tot[part * 128 + kch] = s;
          __syncthreads();
          float base = 0.f;
#pragma unroll
          for (int p = 0; p < 3; ++p) base += (p < part) ? tot[p * 128 + kch] : 0.f;
#pragma unroll
          for (int i = 0; i < 16; ++i) cu[(part * 16 + i) * 128 + kch] = base + loc[i]; }
        __syncthreads();
        { const LAS float* ff = (const LAS float*)(L + O_FF); const LAS float* cu = (const LAS float*)(L + O_CU);
#pragma unroll
          for (int q = 0; q < 2; ++q) { const int idx = tid + 512 * q, i = idx >> 4, k8 = idx & 15; float qs[8], ks[8], qd[8];
#pragma unroll
              for (int e = 0; e < 8; ++e) { const int k = k8 * 8 + e; const float c = cu[i * 128 + k], cm = cu[31 * 128 + k], qv = qreg[q][e];
                  qs[e] = qv * __expf(c - cm); ks[e] = (1.f - ff[i * 128 + k]) * __expf(cm - c); qd[e] = qv * __expf(c); }
              *(LAS v4u*)(L + O_QS + i * 272 + k8 * 16) = pack8(qs); *(LAS v4u*)(L + O_KS + i * 272 + k8 * 16) = pack8(ks);
              *(v4u*)(QDg + rec * 8192 + i * 128 + k8 * 8) = pack8(qd); }
#pragma unroll 1
          for (int q = 0; q < 2; ++q) { const int idx = tid + 512 * q, j8 = idx >> 7, k = idx & 127; float xf[8]; const float cl = cu[63 * 128 + k];
#pragma unroll
              for (int e = 0; e < 8; ++e) { const int j = j8 * 8 + e; xf[e] = (1.f - ff[j * 128 + k]) * __expf(cl - cu[j * 128 + k]); }
              *(v4u*)(KDg + rec * 8192 + k * 64 + j8 * 8) = pack8(xf); }
          if (tid < 128) GLg[rec * 128 + tid] = __expf(cu[63 * 128 + tid]); }
        __syncthreads();
        if (w < 4) { const int rb = w >> 1, cb = w & 1, l32 = lane & 31, hi = lane >> 5; f32x16 acc = {};
#pragma unroll
            for (int ks = 0; ks < 8; ++ks) { const bf16x8 a = *(const LAS bf16x8*)(L + O_QS + (rb * 32 + l32) * 272 + (ks * 16 + hi * 8) * 2);
                const bf16x8 bb = *(const LAS bf16x8*)(L + O_KS + (cb * 32 + l32) * 272 + (ks * 16 + hi * 8) * 2);
                acc = __builtin_amdgcn_mfma_f32_32x32x16_bf16(a, bb, acc, 0, 0, 0); }
            LAS float* am = (LAS float*)(L + O_AM);
#pragma unroll
            for (int r = 0; r < 16; ++r) am[(rb * 32 + crow16(r, hi)) * 65 + cb * 32 + l32] = acc[r];
        } else { const int t = tid - 256;
#pragma unroll
            for (int q = 0; q < 4; ++q) { const int idx = t + 256 * q, i = idx >> 4, c16 = idx & 15;
                *(LAS v4u*)(L + O_HV + i * 256 + c16 * 16) = hvr[q]; } }
        __syncthreads();
        { const LAS float* am = (const LAS float*)(L + O_AM); const int i = tid >> 3, j8 = tid & 7; float xf[8];
#pragma unroll
          for (int e = 0; e < 8; ++e) { const int j = j8 * 8 + e; xf[e] = (j <= i) ? am[i * 65 + j] : 0.f; }
          *(v4u*)(ATg + rec * 4096 + i * 64 + j8 * 8) = pack8(xf);
#pragma unroll
          for (int q = 0; q < 4; ++q) { const int idx = tid + 512 * q, i4 = idx >> 7, v = idx & 127; const LAS unsigned short* hp = (const LAS unsigned short*)(L + O_HV) + (i4 * 4) * 128 + v;
              u32x2 o; o.x = (unsigned)hp[0] | ((unsigned)hp[128] << 16); o.y = (unsigned)hp[256] | ((unsigned)hp[384] << 16); *(u32x2*)(U0g + rec * 8192 + v * 64 + i4 * 4) = o; } }
        __syncthreads();
    }
}

__device__ __forceinline__ int sw256(int row, int colB) { return row * 256 + (colB ^ ((row & 15) << 4)); }
__device__ __forceinline__ int sw128(int row, int colB) { return row * 128 + (colB ^ (((row >> 1) & 7) << 4)); }
__device__ __forceinline__ void s2_compute(LAS unsigned char* L, int type, int ci, int w, int l32, int hi, int b, int h, int dir, int vh, bf16* Og, f32x16& Sacc) {
    constexpr int O_W = 0, O_QD = 16384, O_AT = 32768, O_KD = 40960, O_U0 = 57344, O_GL = 65536, O_ST = 66048, O_UT = 82432;
            const int rb = (w >> 1) & 1, cb = w & 1;
            f32x16 oacc = {};
            if (w < 4) {
                f32x16 acc = {};
                if (type == 0) { f32x16 acc1 = {};
#pragma unroll
                    for (int ks = 0; ks < 8; ks += 2) { const bf16x8 a = *(const LAS bf16x8*)(L + O_W + sw256(rb * 32 + l32, ks * 32 + hi * 16)), a1 = *(const LAS bf16x8*)(L + O_W + sw256(rb * 32 + l32, (ks + 1) * 32 + hi * 16));
                        const bf16x8 bb = *(const LAS bf16x8*)(L + O_ST + sw256(cb * 32 + l32, ks * 32 + hi * 16)), bb1 = *(const LAS bf16x8*)(L + O_ST + sw256(cb * 32 + l32, (ks + 1) * 32 + hi * 16));
                        acc = __builtin_amdgcn_mfma_f32_32x32x16_bf16(a, bb, acc, 0, 0, 0); acc1 = __builtin_amdgcn_mfma_f32_32x32x16_bf16(a1, bb1, acc1, 0, 0, 0); }
                    acc += acc1; }
#pragma unroll
                for (int q = 0; q < 4; ++q) { const int i0 = rb * 32 + 8 * q + 4 * hi; const u32x2 uw = *(const LAS u32x2*)(L + O_U0 + sw128(cb * 32 + l32, i0 * 2)); const f32x4 u0 = {bflo(uw.x), bfhi(uw.x), bflo(uw.y), bfhi(uw.y)};
                    u32x2 pkd; pkd.x = pk2(u0.x - acc[q * 4], u0.y - acc[q * 4 + 1]); pkd.y = pk2(u0.z - acc[q * 4 + 2], u0.w - acc[q * 4 + 3]);
                    *(LAS u32x2*)(L + O_UT + sw128(cb * 32 + l32, i0 * 2)) = pkd; }
            } else {
                f32x16 oacc1 = {};
#pragma unroll
                for (int ks = 0; ks < 8; ks += 2) { const bf16x8 a = *(const LAS bf16x8*)(L + O_QD + sw256(rb * 32 + l32, ks * 32 + hi * 16)), a1 = *(const LAS bf16x8*)(L + O_QD + sw256(rb * 32 + l32, (ks + 1) * 32 + hi * 16));
                    const bf16x8 bb = *(const LAS bf16x8*)(L + O_ST + sw256(cb * 32 + l32, ks * 32 + hi * 16)), bb1 = *(const LAS bf16x8*)(L + O_ST + sw256(cb * 32 + l32, (ks + 1) * 32 + hi * 16));
                    oacc = __builtin_amdgcn_mfma_f32_32x32x16_bf16(a, bb, oacc, 0, 0, 0); oacc1 = __builtin_amdgcn_mfma_f32_32x32x16_bf16(a1, bb1, oacc1, 0, 0, 0); }
                oacc += oacc1;
            }
            __syncthreads();
            if (w >= 4) {
#pragma unroll
                for (int js = 0; js < 4; ++js) { const bf16x8 a = *(const LAS bf16x8*)(L + O_AT + sw128(rb * 32 + l32, js * 32 + hi * 16));
                    const bf16x8 bb = *(const LAS bf16x8*)(L + O_UT + sw128(cb * 32 + l32, js * 32 + hi * 16));
                    oacc = __builtin_amdgcn_mfma_f32_32x32x16_bf16(a, bb, oacc, 0, 0, 0); }
#pragma unroll
                for (int r = 0; r < 16; ++r) { const int i = rb * 32 + crow16(r, hi); const int pos = (ci < 4 ? ci * 64 : (ci - 4) * 64) + i;
                    const int row = ci < 4 ? (TL + b * CTXL + (dir ? CTXL - 1 - pos : pos)) : (b * SEQ + (dir ? SEQ - 1 - pos : pos));
                    Og[(size_t)row * 1024 + h * 128 + vh * 64 + cb * 32 + l32] = (bf16)f2bf(oacc[r]); }
            }
            {
                const int kb = w >> 1;
#pragma unroll
                for (int q = 0; q < 4; ++q) { const f32x4 g4 = *(const LAS f32x4*)(L + O_GL + (kb * 32 + 8 * q + 4 * hi) * 4);
                    Sacc[q * 4] *= g4.x; Sacc[q * 4 + 1] *= g4.y; Sacc[q * 4 + 2] *= g4.z; Sacc[q * 4 + 3] *= g4.w; }
#pragma unroll
                for (int js = 0; js < 4; ++js) { const bf16x8 a = *(const LAS bf16x8*)(L + O_KD + sw128(kb * 32 + l32, js * 32 + hi * 16));
                    const bf16x8 bb = *(const LAS bf16x8*)(L + O_UT + sw128(cb * 32 + l32, js * 32 + hi * 16));
                    Sacc = __builtin_amdgcn_mfma_f32_32x32x16_bf16(a, bb, Sacc, 0, 0, 0); }
#pragma unroll
                for (int q = 0; q < 4; ++q) { const int k0 = kb * 32 + 8 * q + 4 * hi; u32x2 pkd; pkd.x = pk2(Sacc[q * 4], Sacc[q * 4 + 1]); pkd.y = pk2(Sacc[q * 4 + 2], Sacc[q * 4 + 3]);
                    *(LAS u32x2*)(L + O_ST + sw256(cb * 32 + l32, k0 * 2)) = pkd; }
            }
}

__device__ __forceinline__ void phase_s2(Frame& F) {
    const bf16* QDg = (const bf16*)(F.ws + WS_SQD * MiB); const bf16* ATg = (const bf16*)(F.ws + WS_SATT * MiB); const bf16* KDg = (const bf16*)(F.ws + WS_SKDT * MiB);
    const bf16* U0g = (const bf16*)(F.ws + WS_SU0T * MiB); const float* GLg = (const float*)(F.ws + WS_SGLV * MiB); const bf16* Wg = (const bf16*)(F.ws + WS_SW * MiB);
    LAS unsigned char* L = F.lds;
    constexpr int O_W = 0, O_QD = 16384, O_AT = 32768, O_KD = 40960, O_U0 = 57344, O_GL = 65536, O_ST = 66048, O_UT = 82432;
    const int tid = F.tid, lane = F.lane, w = F.wave, l32 = lane & 31, hi = lane >> 5;
    for (int u0_ = F.bid; u0_ < 256; u0_ += F.G) {
        const int unit = (F.G == 256) ? (2 * ((u0_ & 7) + 8 * (u0_ >> 4)) + ((u0_ >> 3) & 1)) : u0_;
        const int type = unit >> 7, rem = unit & 127, b = rem >> 5, h = (rem >> 2) & 7, dir = (rem >> 1) & 1, vh = rem & 1;
        bf16* Og = (bf16*)(F.ws + (type ? WS_OH : WS_OD) * MiB) + (size_t)dir * TT * 1024;
        const size_t rec0 = rec_of(type, b, h, dir, 0), recw0 = (size_t)(((b * 8 + h) * 2 + dir) * 36);
        for (int i = tid; i < 16384 / 16; i += 512) { v4u z; z.x = z.y = z.z = z.w = 0u; *(LAS v4u*)(L + O_ST + i * 16) = z; }
        f32x16 Sacc = {};
        v4u pwA[2], pqA[2], paA, pkA[2], puA; f32x4 pgA = {0.f, 0.f, 0.f, 0.f};
        v4u pwB[2], pqB[2], paB, pkB[2], puB; f32x4 pgB = {0.f, 0.f, 0.f, 0.f};
        pwA[0] = pwA[1] = pwB[0] = pwB[1] = (v4u){0u, 0u, 0u, 0u};
#define S2_LOAD(X, ci) do { const size_t rc = rec0 + (ci); \
            _Pragma("unroll") for (int j = 0; j < 2; ++j) { const int idx = tid + 512 * j; \
                if (type == 0) pw##X[j] = *(const v4u*)(Wg + (recw0 + (ci)) * 8192 + idx * 8); \
                pq##X[j] = *(const v4u*)(QDg + rc * 8192 + idx * 8); pk##X[j] = *(const v4u*)(KDg + rc * 8192 + idx * 8); } \
            pu##X = *(const v4u*)(U0g + rc * 8192 + (size_t)vh * 4096 + tid * 8); \
            pa##X = *(const v4u*)(ATg + rc * 4096 + tid * 8); \
            if (tid < 32) pg##X = *(const f32x4*)(GLg + rc * 128 + tid * 4); } while (0)
#define S2_STEP(X, ci) do { \
            __syncthreads(); \
            _Pragma("unroll") for (int j = 0; j < 2; ++j) { const int idx = tid + 512 * j; \
                { const int row = idx >> 4, c16 = idx & 15; *(LAS v4u*)(L + O_W + sw256(row, c16 * 16)) = pw##X[j]; *(LAS v4u*)(L + O_QD + sw256(row, c16 * 16)) = pq##X[j]; } \
                { const int row = idx >> 3, c16 = idx & 7; *(LAS v4u*)(L + O_KD + sw128(row, c16 * 16)) = pk##X[j]; } } \
            { const int row = tid >> 3, c16 = tid & 7; *(LAS v4u*)(L + O_AT + sw128(row, c16 * 16)) = pa##X; *(LAS v4u*)(L + O_U0 + sw128(row, c16 * 16)) = pu##X; } \
            if (tid < 32) *(LAS f32x4*)(L + O_GL + tid * 16) = pg##X; \
            __syncthreads(); \
            if ((ci) + 2 < 36) S2_LOAD(X, (ci) + 2); \
            s2_compute(L, type, ci, w, l32, hi, b, h, dir, vh, Og, Sacc); } while (0)
        S2_LOAD(A, 0); S2_LOAD(B, 1);
#pragma unroll 1
        for (int ci = 0; ci < 36; ci += 2) { S2_STEP(A, ci); S2_STEP(B, ci + 1); }
        __syncthreads();
#undef S2_LOAD
#undef S2_STEP
    }
}

__device__ __forceinline__ void phase_outnorm0(Frame& F, const Args& A) {
    const bf16* P = (const bf16*)(F.ws + WS_PROJ0 * MiB); bf16* Y = (bf16*)(F.ws + WS_Y * MiB);
    const int gw = F.bid * NWAVES + F.wave, NGW = F.G * NWAVES, lane = F.lane;
    for (int row = gw; row < TT; row += NGW) {
        v4u oin[4][3];
#pragma unroll
        for (int p = 0; p < 4; ++p) { const int t2 = p >> 1, c0 = (p & 1) * 512 + lane * 8; const bf16* O0 = (const bf16*)(F.ws + (t2 ? WS_OH : WS_OD) * MiB) + (size_t)row * 1024 + c0;
            oin[p][0] = *(const v4u*)O0; oin[p][1] = *(const v4u*)(O0 + (size_t)TT * 1024); oin[p][2] = *(const v4u*)(P + (size_t)row * N0 + (t2 ? C_OG : C_Z) + c0); }
#pragma unroll
        for (int p = 0; p < 4; ++p) { const int t2 = p >> 1, c0 = (p & 1) * 512 + lane * 8;
            float fa[8], fb[8]; unpack8(oin[p][0], fa); unpack8(oin[p][1], fb);
            float o[8] = {fa[0] + fb[0], fa[1] + fb[1], fa[2] + fb[2], fa[3] + fb[3], fa[4] + fb[4], fa[5] + fb[5], fa[6] + fb[6], fa[7] + fb[7]};
            float ss = 0.f;
#pragma unroll
            for (int e = 0; e < 8; ++e) ss += o[e] * o[e];
            ss += __shfl_xor(ss, 1); ss += __shfl_xor(ss, 2); ss += __shfl_xor(ss, 4); ss += __shfl_xor(ss, 8);
            const float rstd = 1.f / sqrtf(ss * (1.f / 128.f) + EPS);
            const float* nw = (t2 ? ARG(14) : ARG(13)) + (c0 & 127);
            float gf[8]; unpack8(oin[p][2], gf);
#pragma unroll
            for (int e = 0; e < 8; ++e) o[e] = o[e] * rstd * nw[e] * (t2 ? sigmoidf_(gf[e]) : siluf_(gf[e]));
            *(v4u*)(Y + (size_t)row * DM + t2 * 1024 + c0) = pack8(o);
        }
    }
}

struct EpiProj0 {
    static constexpr bool PERM = true, AFTER_DRAIN = false, PERM2 = false;
    bf16* O;
    __device__ __forceinline__ void operator()(const pg8::f32x4 (&acc)[2][2][4][2], const pg8::Unit& u, int wr, int wc, int fr, int fq) const {
        const int row0 = u.pm * 256 + wr * 64 + fr, col0 = u.pn * 256 + wc * 32 + 8 * fq;
#pragma unroll
        for (int ai = 0; ai < 2; ++ai)
#pragma unroll
            for (int m = 0; m < 4; ++m) { bf16* rowp = O + (size_t)(row0 + ai * 128 + m * 16) * N0 + col0;
#pragma unroll
                for (int bj = 0; bj < 2; ++bj) { if (col0 + bj * 128 < N0) { const pg8::f32x4 v0 = acc[ai][bj][m][0], v1 = acc[ai][bj][m][1];
                    pg8::u32x4 w; w.x = pg8::cvt_pk_bf16(v0[0], v0[1]); w.y = pg8::cvt_pk_bf16(v0[2], v0[3]); w.z = pg8::cvt_pk_bf16(v1[0], v1[1]); w.w = pg8::cvt_pk_bf16(v1[2], v1[3]);
                    *(pg8::u32x4*)(rowp + bj * 128) = w; } } }
    }
};
template <bool BASE16> struct EpiResidT {
    static constexpr bool PERM = false, AFTER_DRAIN = false, PERM2 = false;
    const void* baseL; const void* baseC; bf16* out; const float* gate;
    __device__ __forceinline__ void operator()(const pg8::f32x4 (&acc)[2][2][4][2], const pg8::Unit& u, int wr, int wc, int fr, int fq) const {
        const int row0 = u.pm * 256 + wr * 64 + fr, col0 = u.pn * 256 + wc * 32 + 4 * fq;
#pragma unroll
        for (int ai = 0; ai < 2; ++ai)
#pragma unroll
            for (int m = 0; m < 4; ++m) { const int row = row0 + ai * 128 + m * 16;
                const size_t boff = (row < TL ? (size_t)row * DM : (size_t)(row - TL) * DM) + col0; const void* bsel = row < TL ? baseL : baseC;
                const float* gp = gate + (size_t)bidx_of_row(row) * 12288 + col0; bf16* op = out + (size_t)row * DM + col0;
#pragma unroll
                for (int bj = 0; bj < 2; ++bj)
#pragma unroll
                    for (int n = 0; n < 2; ++n) { const int o = bj * 128 + n * 16; pg8::f32x4 bs;
                        if constexpr (BASE16) { const u32x2 bw = *(const u32x2*)((const bf16*)bsel + boff + o); bs = (pg8::f32x4){bflo(bw.x), bfhi(bw.x), bflo(bw.y), bfhi(bw.y)}; }
                        else bs = *(const pg8::f32x4*)((const float*)bsel + boff + o);
                        const pg8::f32x4 g = *(const pg8::f32x4*)(gp + o); const pg8::f32x4 r = bs + g * acc[ai][bj][m][n];
                        u32x2 pw; pw.x = pk2(r[0], r[1]); pw.y = pk2(r[2], r[3]); *(u32x2*)(op + o) = pw; } }
    }
};
struct EpiSwiGLU {
    static constexpr bool PERM = true, AFTER_DRAIN = false, PERM2 = false;
    bf16* ACT;
    __device__ __forceinline__ void operator()(const pg8::f32x4 (&acc)[2][2][4][2], const pg8::Unit& u, int wr, int wc, int fr, int fq) const {
        const int row0 = u.pm * 256 + wr * 64 + fr, col0 = (u.pn & 3) * 128 + wc * 32 + 8 * fq;
#pragma unroll
        for (int ai = 0; ai < 2; ++ai)
#pragma unroll
            for (int m = 0; m < 4; ++m) { bf16* rowp = ACT + (size_t)(row0 + ai * 128 + m * 16) * 512 + col0; float r[8];
#pragma unroll
                for (int n = 0; n < 2; ++n)
#pragma unroll
                    for (int i = 0; i < 4; ++i) { const float a = acc[ai][0][m][n][i], b = acc[ai][1][m][n][i]; r[n * 4 + i] = siluf_(a) * b; }
                pg8::u32x4 w; w.x = pg8::cvt_pk_bf16(r[0], r[1]); w.y = pg8::cvt_pk_bf16(r[2], r[3]); w.z = pg8::cvt_pk_bf16(r[4], r[5]); w.w = pg8::cvt_pk_bf16(r[6], r[7]);
                *(pg8::u32x4*)rowp = w; }
    }
};
struct EpiDown {
    static constexpr bool PERM = true, AFTER_DRAIN = false, PERM2 = false;
    bf16* Yo; const float* lw; const LAS int* lcnt; const LAS int* rstart; const LAS int* tile_e; int nsh;
    __device__ __forceinline__ void operator()(const pg8::f32x4 (&acc)[2][2][4][2], const pg8::Unit& u, int wr, int wc, int fr, int fq) const {
        const int r0 = wr * 64 + fr, col0 = (u.pn & 7) * 256 + wc * 32 + 8 * fq;
        int e = 0, base = 0, cnt = 0; const bool shared = u.pm < nsh;
        if (!shared) { const int t = u.pm - nsh; e = tile_e[t]; base = t * 256 - rstart[e]; cnt = lcnt[e]; }
#pragma unroll
        for (int ai = 0; ai < 2; ++ai)
#pragma unroll
            for (int m = 0; m < 4; ++m) { const int r = r0 + ai * 128 + m * 16; const int pos = base + r;
                const float sw = shared ? 1.f : (pos < cnt ? lw[(size_t)e * TCAP + pos] : 0.f); bf16* rowp = Yo + (size_t)(u.pm * 256 + r) * DM + col0;
#pragma unroll
                for (int bj = 0; bj < 2; ++bj) { const pg8::f32x4 v0 = acc[ai][bj][m][0] * sw, v1 = acc[ai][bj][m][1] * sw;
                    pg8::u32x4 w; w.x = pg8::cvt_pk_bf16(v0[0], v0[1]); w.y = pg8::cvt_pk_bf16(v0[2], v0[3]); w.z = pg8::cvt_pk_bf16(v1[0], v1[1]); w.w = pg8::cvt_pk_bf16(v1[2], v1[3]);
                    *(pg8::u32x4*)(rowp + bj * 128) = w; } }
    }
};
#ifndef Y8MASK
#define Y8MASK 2
#endif
constexpr float Y8_SCALE = 8.f;
struct EpiDown8 {
    static constexpr bool PERM = true, AFTER_DRAIN = false, PERM2 = true;
    unsigned char* Yo;
    __device__ __forceinline__ void operator()(const pg8::f32x4 (&acc)[2][2][4][2], const pg8::Unit& u, int wr, int wc, int fr, int fq) const {
        const int r0 = u.pm * 256 + wr * 64 + fr, col0 = (u.pn & 7) * 256 + wc * 64 + 16 * fq;
#pragma unroll
        for (int ai = 0; ai < 2; ++ai)
#pragma unroll
            for (int m = 0; m < 4; ++m) { unsigned char* rowp = Yo + (size_t)(r0 + ai * 128 + m * 16) * DM + col0; pg8::u32x4 o;
#pragma unroll
                for (int bj = 0; bj < 2; ++bj)
#pragma unroll
                    for (int n = 0; n < 2; ++n) { const pg8::f32x4 v = acc[ai][bj][m][n] * Y8_SCALE;
                        int w = __builtin_amdgcn_cvt_pk_fp8_f32(v[0], v[1], 0, false); w = __builtin_amdgcn_cvt_pk_fp8_f32(v[2], v[3], w, true); o[bj * 2 + n] = (unsigned)w; }
                *(pg8::u32x4*)rowp = o; }
    }
};
template <int LAYER> struct MoeAGather {
    static constexpr bool GATHER = true;
    const int* ltok; const LAS int* lcnt; const LAS int* rstart; const LAS int* tile_e;
    __device__ __forceinline__ unsigned rowoff(int pm, int R) const {
        constexpr int T = LAYER ? TL : TT; constexpr int NSH = T / 256;
        if (pm < NSH) return (unsigned)(pm * 256 + R) * 4096u;
        const int t = pm - NSH, e = tile_e[t], pos = t * 256 + R - rstart[e];
        return pos < lcnt[e] ? (unsigned)ltok[(size_t)e * TCAP + pos] * 4096u : (unsigned)T * 4096u;
    }
};
struct MoeOrder {
    int nsh, ntiles, nN, G, c; const LAS int* tile_e; const LAS int* xt_pm; int xt_n; const LAS int* lcnt; const LAS int* rstart;
    __device__ __forceinline__ bool next(int i, pg8::Unit& u) const {
        int pm, pnl;
        if (G == 256) { const int L = i * 32 + (c >> 3); if (L >= xt_n * nN) return false; const int t = L / nN; pnl = L - t * nN; pm = xt_pm[t]; }
        else { const int L = i * G + c; if (L >= ntiles * nN) return false; pm = L / nN; pnl = L - pm * nN; }
        int e = NE, hf = 0;
        if (pm >= nsh) { const int t = pm - nsh; e = tile_e[t]; hf = (lcnt[e] - (t * 256 - rstart[e]) <= 128) ? 1 : 0; }
        u.pm = pm; u.pn = e * nN + pnl; u.half = hf; return true;
    }
    __device__ __forceinline__ void a_ready(const pg8::Unit&) const {}
    __device__ __forceinline__ void done(const pg8::Unit&) const {}
};

template <int LAYER> __device__ __forceinline__ void phase_route(Frame& F, const Args& A) {
    constexpr int T = LAYER ? TL : TT;
    const float* modv = (const float*)(F.ws + WS_MODV * MiB) + (size_t)LAYER * 5 * 12288;
    const bf16* XR = (const bf16*)(F.ws + WS_XR * MiB); bf16* HA = (bf16*)(F.ws + WS_HA * MiB);
    const float* nw = ARG(LAYER ? 25 : 8); const float* rw = ARG(LAYER ? 32 : 16); const float* rbias = ARG(LAYER ? 33 : 17);
    int* cnt = (int*)(F.ctl + CW_CNT + LAYER * 64);
    int* ltok = (int*)(F.ws + WS_LTOK * MiB); float* lw = (float*)(F.ws + WS_LW * MiB); int* sele = (int*)(F.ws + WS_SELE * MiB); int* selp = (int*)(F.ws + WS_SELP * MiB);
    if (F.bid == 0 && F.tid < 256) { v4u z; z.x = z.y = z.z = z.w = 0u; *(v4u*)(HA + (size_t)T * DM + F.tid * 8) = z; }
    LAS float* h2s = (LAS float*)(F.lds); LAS float* parts = (LAS float*)(F.lds);
    const int w = F.wave;
    for (int grp = F.bid; grp < T / 16; grp += F.G) {
        int lane = F.lane; asm volatile("" : "+v"(lane));
        {
          const int m0 = 2 * w, row0 = grp * 16 + m0; const float* mv = modv + (size_t)bidx_of_row(row0) * 12288;
          const bf16* xr0 = XR + (size_t)row0 * DM;
          f32x4 xa[8], xb[8], cm[8], cs[8]; float ssa = 0.f, ssb = 0.f;
#pragma unroll
          for (int j = 0; j < 8; ++j) { const int c = j * 256 + lane * 4; const u32x2 wa = *(const u32x2*)(xr0 + c), wb = *(const u32x2*)(xr0 + DM + c);
              xa[j] = (f32x4){bflo(wa.x), bfhi(wa.x), bflo(wa.y), bfhi(wa.y)}; xb[j] = (f32x4){bflo(wb.x), bfhi(wb.x), bflo(wb.y), bfhi(wb.y)}; }
#pragma unroll
          for (int j = 0; j < 8; ++j) { const int c = j * 256 + lane * 4; const f32x4 w4 = *(const f32x4*)(nw + c), g4 = *(const f32x4*)(mv + 8192 + c); cs[j] = *(const f32x4*)(mv + 6144 + c); cm[j] = w4 * (g4 + 1.f); }
#pragma unroll
          for (int j = 0; j < 8; ++j) { ssa += (xa[j].x * xa[j].x + xa[j].y * xa[j].y) + (xa[j].z * xa[j].z + xa[j].w * xa[j].w); ssb += (xb[j].x * xb[j].x + xb[j].y * xb[j].y) + (xb[j].z * xb[j].z + xb[j].w * xb[j].w); }
#pragma unroll
          for (int o = 1; o < 64; o <<= 1) { ssa += __shfl_xor(ssa, o); ssb += __shfl_xor(ssb, o); }
          const float ra = 1.f / sqrtf(ssa * (1.f / 2048.f) + EPS), rb = 1.f / sqrtf(ssb * (1.f / 2048.f) + EPS);
#pragma unroll
          for (int j = 0; j < 8; ++j) { const int c = j * 256 + lane * 4; const f32x4 oa = xa[j] * ra * cm[j] + cs[j], ob = xb[j] * rb * cm[j] + cs[j];
              *(LAS f32x4*)(h2s + m0 * 2048 + ((c + 4 * m0) & 2047)) = oa; *(LAS f32x4*)(h2s + (m0 + 1) * 2048 + ((c + 4 * (m0 + 1)) & 2047)) = ob;
              uint2 pa; pa.x = pk2(oa.x, oa.y); pa.y = pk2(oa.z, oa.w); *(uint2*)(HA + (size_t)row0 * DM + c) = pa;
              uint2 pb; pb.x = pk2(ob.x, ob.y); pb.y = pk2(ob.z, ob.w); *(uint2*)(HA + (size_t)(row0 + 1) * DM + c) = pb; } }
        __syncthreads();
        f32x4 acc[4];
#pragma unroll
        for (int c = 0; c < 4; ++c) acc[c] = (f32x4){0.f, 0.f, 0.f, 0.f};
        { const int m = lane & 15, kq = lane >> 4;
          const float* rwp = rw + (size_t)(w * 256 + kq) * 64 + m * 4;
          f32x4 bc[16], bn[16];
#pragma unroll
          for (int u = 0; u < 16; ++u) bc[u] = *(const f32x4*)(rwp + (size_t)(4 * u) * 64);
#pragma unroll 1
          for (int s0 = 0; s0 < 64; s0 += 16) {
              if (s0 + 16 < 64) {
#pragma unroll
                  for (int u = 0; u < 16; ++u) bn[u] = *(const f32x4*)(rwp + (size_t)(4 * (s0 + 16 + u)) * 64); }
#pragma unroll
              for (int u = 0; u < 16; ++u) { const int kk = w * 256 + 4 * (s0 + u) + kq; const float av = h2s[m * 2048 + ((kk + 4 * m) & 2047)]; const f32x4 bv = bc[u];
                  acc[0] = __builtin_amdgcn_mfma_f32_16x16x4f32(av, bv.x, acc[0], 0, 0, 0); acc[1] = __builtin_amdgcn_mfma_f32_16x16x4f32(av, bv.y, acc[1], 0, 0, 0);
                  acc[2] = __builtin_amdgcn_mfma_f32_16x16x4f32(av, bv.z, acc[2], 0, 0, 0); acc[3] = __builtin_amdgcn_mfma_f32_16x16x4f32(av, bv.w, acc[3], 0, 0, 0); }
#pragma unroll
              for (int u = 0; u < 16; ++u) bc[u] = bn[u];
          } }
        __syncthreads();
#pragma unroll
        for (int c = 0; c < 4; ++c)
#pragma unroll
            for (int i = 0; i < 4; ++i) parts[(w * 16 + 4 * (lane >> 4) + i) * 64 + 4 * (lane & 15) + c] = acc[c][i];
        __syncthreads();
        {
          float score[2], biased[2], gsum[2], mb[2]; int rg[2], gr[2], er[2]; bool gsel[2];
#pragma unroll
          for (int rr = 0; rr < 2; ++rr) { const int mrow = 2 * w + rr; float logit = 0.f;
#pragma unroll
              for (int ww = 0; ww < 8; ++ww) logit += parts[(ww * 16 + mrow) * 64 + lane];
              score[rr] = 1.f / (1.f + expf(-logit)); biased[rr] = score[rr] + rbias[lane]; rg[rr] = 0; gr[rr] = 0; er[rr] = 0; }
#pragma unroll
          for (int j = 1; j < 8; ++j) { const int ol = (lane & ~7) | ((lane + j) & 7);
#pragma unroll
              for (int rr = 0; rr < 2; ++rr) { const float ob = __shfl(biased[rr], ol); rg[rr] += (ob > biased[rr] || (ob == biased[rr] && ol < lane)) ? 1 : 0; } }
#pragma unroll
          for (int rr = 0; rr < 2; ++rr) gsum[rr] = rg[rr] < 2 ? biased[rr] : 0.f;
#pragma unroll
          for (int o = 1; o < 8; o <<= 1) { gsum[0] += __shfl_xor(gsum[0], o); gsum[1] += __shfl_xor(gsum[1], o); }
          const int g = lane >> 3;
#pragma unroll
          for (int j = 0; j < 8; ++j) {
#pragma unroll
              for (int rr = 0; rr < 2; ++rr) { const float og = __shfl(gsum[rr], j * 8); gr[rr] += (j != g && (og > gsum[rr] || (og == gsum[rr] && j < g))) ? 1 : 0; } }
#pragma unroll
          for (int rr = 0; rr < 2; ++rr) { gsel[rr] = gr[rr] < 4; mb[rr] = gsel[rr] ? biased[rr] : -__builtin_inff(); }
#pragma unroll 1
          for (int j = 0; j < 64; ++j) { const float o0 = __uint_as_float(__builtin_amdgcn_readlane(__float_as_uint(mb[0]), j)), o1 = __uint_as_float(__builtin_amdgcn_readlane(__float_as_uint(mb[1]), j));
              er[0] += (o0 > mb[0] || (o0 == mb[0] && j < lane)) ? 1 : 0; er[1] += (o1 > mb[1] || (o1 == mb[1] && j < lane)) ? 1 : 0; }
#pragma unroll
          for (int rr = 0; rr < 2; ++rr) { const int row = grp * 16 + 2 * w + rr; const bool sel = gsel[rr] && er[rr] < 8;
              const float wsum = wave_sum(sel ? score[rr] : 0.f); const float wt = score[rr] / wsum * 2.5f;
              const unsigned long long mk = __ballot(sel); const int kidx = __popcll(mk & ((1ull << lane) - 1ull));
              if (sel) { const int pos = atomicAdd(&cnt[lane], 1); ltok[(size_t)lane * TCAP + pos] = row; lw[(size_t)lane * TCAP + pos] = wt; sele[(size_t)row * 8 + kidx] = lane; selp[(size_t)row * 8 + kidx] = pos; } }
        }
        __syncthreads();
    }
}
template <int LAYER> __device__ __forceinline__ int moe_tables(Frame& F) {
    LAS int* lcnt = (LAS int*)(F.lds + L_CNT); LAS int* rstart = (LAS int*)(F.lds + L_RSTART); LAS int* tile_e = (LAS int*)(F.lds + L_TILEE);
    const int* cnt = (const int*)(F.ctl + CW_CNT + LAYER * 64);
    __syncthreads();
    if (F.tid < 64) { const int c = __hip_atomic_load(cnt + F.tid, __ATOMIC_RELAXED, __HIP_MEMORY_SCOPE_AGENT); const int p = (c + 255) & ~255; int incl = p;
#pragma unroll
        for (int o = 1; o < 64; o <<= 1) { const int v = __shfl_up(incl, o); if (F.lane >= o) incl += v; }
        lcnt[F.tid] = c; rstart[F.tid] = incl - p; if (F.tid == 63) rstart[64] = incl; }
    __syncthreads();
    const int total = rstart[64];
    for (int t = F.tid; t < (total >> 8); t += 512) { const int r = t << 8; int e = 0;
#pragma unroll 1
        for (int q = 1; q < 64; ++q) e += (rstart[q] <= r) ? 1 : 0;
        tile_e[t] = e; }
    if (F.tid == 0) {
        constexpr int NSH = (LAYER ? TL : TT) / 256; LAS int* xt = (LAS int*)(F.lds + L_XT); const int x = F.bid & 7; int n = 0;
#pragma unroll 1
        for (int pm = x; pm < NSH; pm += 8) xt[n++] = pm;
#pragma unroll 1
        for (int e = x; e < 64; e += 8) { const int t0 = rstart[e] >> 8, t1 = rstart[e + 1] >> 8;
#pragma unroll 1
            for (int t = t0; t < t1; ++t) xt[n++] = NSH + t; }
        *(LAS int*)(F.lds + L_XTN) = n; }
    __syncthreads();
    return total;
}
template <int LAYER> __device__ __forceinline__ void phase_moe_gemm1(Frame& F) {
    constexpr int T = LAYER ? TL : TT;
    const int total = moe_tables<LAYER>(F);
    pg8::Gemm g{(const bf16*)(F.ws + WS_HA * MiB), (const bf16*)(F.ws + (LAYER ? WS_GU1 : WS_GU0) * MiB), 0, 1024, 2048};
    MoeOrder S{T / 256, T / 256 + (total >> 8), 4, F.G, F.bid, (const LAS int*)(F.lds + L_TILEE), (const LAS int*)(F.lds + L_XT), *(const LAS int*)(F.lds + L_XTN), (const LAS int*)(F.lds + L_CNT), (const LAS int*)(F.lds + L_RSTART)};
    EpiSwiGLU E{(bf16*)(F.ws + WS_ACT * MiB)};
    MoeAGather<LAYER> AM{(const int*)(F.ws + WS_LTOK * MiB), (const LAS int*)(F.lds + L_CNT), (const LAS int*)(F.lds + L_RSTART), (const LAS int*)(F.lds + L_TILEE)};
    pg8::gemm_phase<EpiSwiGLU, MoeOrder, true, true, MoeAGather<LAYER>>(F.lds, g, S, E, AM);
}
template <int LAYER> __device__ __forceinline__ void phase_moe_gemm2(Frame& F) {
    constexpr int T = LAYER ? TL : TT;
    const int total = moe_tables<LAYER>(F);
    pg8::Gemm g{(const bf16*)(F.ws + WS_ACT * MiB), (const bf16*)(F.ws + (LAYER ? WS_DN1 : WS_DN0) * MiB), 0, 2048, 512};
    MoeOrder S{T / 256, T / 256 + (total >> 8), 8, F.G, F.bid, (const LAS int*)(F.lds + L_TILEE), (const LAS int*)(F.lds + L_XT), *(const LAS int*)(F.lds + L_XTN), (const LAS int*)(F.lds + L_CNT), (const LAS int*)(F.lds + L_RSTART)};
    EpiDown E{(bf16*)(F.ws + WS_HA * MiB), (const float*)(F.ws + WS_LW * MiB), (const LAS int*)(F.lds + L_CNT), (const LAS int*)(F.lds + L_RSTART), (const LAS int*)(F.lds + L_TILEE), T / 256};
    if constexpr ((Y8MASK >> LAYER) & 1) { EpiDown8 E8{(unsigned char*)(F.ws + WS_HA * MiB)};
        pg8::gemm_phase<EpiDown8, MoeOrder, true, true>(F.lds, g, S, E8); }
    else pg8::gemm_phase<EpiDown, MoeOrder, true, true>(F.lds, g, S, E);
}
template <int LAYER> __device__ __forceinline__ void phase_combine(Frame& F, const Args& A) {
    constexpr int T = LAYER ? TL : TT;
    (void)moe_tables<LAYER>(F);
    const LAS int* rstart = (const LAS int*)(F.lds + L_RSTART);
    const bf16* Yb = (const bf16*)(F.ws + WS_HA * MiB); bf16* XR = (bf16*)(F.ws + WS_XR * MiB); bf16* H = (bf16*)(F.ws + WS_H * MiB);
    const int* sele = (const int*)(F.ws + WS_SELE * MiB); const int* selp = (const int*)(F.ws + WS_SELP * MiB); const float* lwp = (const float*)(F.ws + WS_LW * MiB);
    const float* modv = (const float*)(F.ws + WS_MODV * MiB);
    const int gw = F.bid * NWAVES + F.wave, NGW = F.G * NWAVES, lane = F.lane;
    for (int row = gw; row < T; row += NGW) {
        int rws[9]; float rwt[9]; rws[0] = row; rwt[0] = 1.f;
#pragma unroll
        for (int k = 0; k < 8; ++k) { const int e = sele[(size_t)row * 8 + k], pos = selp[(size_t)row * 8 + k]; rws[k + 1] = T + rstart[e] + pos; rwt[k + 1] = lwp[(size_t)e * TCAP + pos]; }
        const float* gate = modv + (size_t)(LAYER * 5 + bidx_of_row(row)) * 12288 + 10240;
        float xv[4][8]; float ss = 0.f;
#pragma unroll
        for (int j = 0; j < 4; ++j) { const int c0 = j * 512 + lane * 8; float s[8];
#pragma unroll
            for (int e = 0; e < 8; ++e) s[e] = 0.f;
#pragma unroll
            for (int k = 0; k < 9; ++k) { float yf[8];
                if constexpr ((Y8MASK >> LAYER) & 1) { const uint2 y8 = *(const uint2*)((const unsigned char*)Yb + (size_t)rws[k] * DM + c0);
                    typedef float f2_t __attribute__((ext_vector_type(2)));
                    const f2_t p0 = __builtin_amdgcn_cvt_pk_f32_fp8((int)y8.x, false), p1 = __builtin_amdgcn_cvt_pk_f32_fp8((int)y8.x, true), p2 = __builtin_amdgcn_cvt_pk_f32_fp8((int)y8.y, false), p3 = __builtin_amdgcn_cvt_pk_f32_fp8((int)y8.y, true);
                    yf[0] = p0.x * (1.f / Y8_SCALE); yf[1] = p0.y * (1.f / Y8_SCALE); yf[2] = p1.x * (1.f / Y8_SCALE); yf[3] = p1.y * (1.f / Y8_SCALE); yf[4] = p2.x * (1.f / Y8_SCALE); yf[5] = p2.y * (1.f / Y8_SCALE); yf[6] = p3.x * (1.f / Y8_SCALE); yf[7] = p3.y * (1.f / Y8_SCALE); }
                else { const v4u yw = *(const v4u*)(Yb + (size_t)rws[k] * DM + c0); unpack8(yw, yf); }
#pragma unroll
                for (int e = 0; e < 8; ++e) s[e] += rwt[k] * yf[e]; }
            float xin_[8]; unpack8(*(const v4u*)(XR + (size_t)row * DM + c0), xin_); const f32x4 x0 = {xin_[0], xin_[1], xin_[2], xin_[3]}, x1 = {xin_[4], xin_[5], xin_[6], xin_[7]};
            const f32x4 g0 = *(const f32x4*)(gate + c0), g1 = *(const f32x4*)(gate + c0 + 4);
            xv[j][0] = x0.x + g0.x * s[0]; xv[j][1] = x0.y + g0.y * s[1]; xv[j][2] = x0.z + g0.z * s[2]; xv[j][3] = x0.w + g0.w * s[3];
            xv[j][4] = x1.x + g1.x * s[4]; xv[j][5] = x1.y + g1.y * s[5]; xv[j][6] = x1.z + g1.z * s[6]; xv[j][7] = x1.w + g1.w * s[7];
#pragma unroll
            for (int e = 0; e < 8; ++e) ss += xv[j][e] * xv[j][e];
            if (LAYER) { float* op = ARG_OUT() + (size_t)row * DM + c0; *(f32x4*)op = (f32x4){xv[j][0], xv[j][1], xv[j][2], xv[j][3]}; *(f32x4*)(op + 4) = (f32x4){xv[j][4], xv[j][5], xv[j][6], xv[j][7]}; }
            else *(v4u*)(XR + (size_t)row * DM + c0) = pack8(xv[j]);
        }
        if (LAYER == 0) {
            const float rstd = 1.f / sqrtf(wave_sum(ss) * (1.f / 2048.f) + EPS);
            const float* mv = modv + (size_t)(5 + bidx_of_row(row)) * 12288; const float* nw = ARG(24);
#pragma unroll
            for (int j = 0; j < 4; ++j) { const int c0 = j * 512 + lane * 8; float o[8];
#pragma unroll
                for (int e = 0; e < 8; ++e) o[e] = xv[j][e] * rstd * nw[c0 + e] * (1.f + mv[2048 + c0 + e]) + mv[c0 + e];
                *(v4u*)(H + (size_t)row * DM + c0) = pack8(o); }
        }
    }
}

__device__ __forceinline__ void phase_qkprep1(Frame& F, const Args& A) {
    const bf16* QKV = (const bf16*)(F.ws + WS_QKV * MiB); bf16* Qo = (bf16*)(F.ws + WS_Q * MiB); bf16* Ko = (bf16*)(F.ws + WS_K * MiB); bf16* Vo = (bf16*)(F.ws + WS_V * MiB);
    const int gw = F.bid * NWAVES + F.wave, NGW = F.G * NWAVES, lane = F.lane;
    const int j16 = lane & 15;
    for (int row = gw; row < TT; row += NGW) {
        const bool lat = row < TL; int b, t, key;
        if (lat) { b = row >> 11; t = row & 2047; key = t; } else { const int rr = row - TL; b = rr >> 8; t = rr & 255; key = SEQ + t; }
        const float prow = (float)(t >> 6), pcol = (float)(t & 63);
        v4u xin[12];
#pragma unroll
        for (int p = 0; p < 12; ++p) xin[p] = (p < 4 && !lat) ? (v4u){0u, 0u, 0u, 0u} : *(const v4u*)(QKV + (size_t)row * N1 + p * 512 + lane * 8);
#pragma unroll
        for (int p = 0; p < 8; ++p) {
            if (p < 4 && !lat) continue;
            const int isk = p >> 2; const int hs = (p & 3) * 4 + (lane >> 4), h = hs >> 1, s = hs & 1;
            float x[8]; unpack8(xin[p], x);
            float ss = 0.f;
#pragma unroll
            for (int e = 0; e < 8; ++e) ss += x[e] * x[e];
            ss += __shfl_xor(ss, 1); ss += __shfl_xor(ss, 2); ss += __shfl_xor(ss, 4); ss += __shfl_xor(ss, 8);
            const float rstd = 1.f / sqrtf(ss * (1.f / 128.f) + EPS);
            const float* nw = ARG(isk ? 28 : 27) + j16 * 8;
#pragma unroll
            for (int e = 0; e < 8; ++e) x[e] = x[e] * rstd * nw[e];
            if (lat) {
                const float pos = (j16 & 8) ? pcol : prow; const bool second = (j16 & 4) != 0;
#pragma unroll
                for (int e = 0; e < 8; ++e) { const float other = __shfl_xor(x[e], 4); const int fi = 8 * (j16 & 3) + e;
                    const float inv_freq = __expf(-(float)fi * (9.210340371976184f / 32.f)); const float ang = pos * inv_freq; const float cs = __cosf(ang), sn = __sinf(ang);
                    x[e] = second ? (x[e] * cs + other * sn) : (x[e] * cs - other * sn); }
            }
            bf16* dst = isk ? Ko + ((size_t)((b * 8 + h) * 2 + s) * 2304 + key) * 128 + j16 * 8 : Qo + ((size_t)((b * 8 + h) * 2 + s) * 2048 + t) * 128 + j16 * 8;
            *(v4u*)dst = pack8(x);
        }
#pragma unroll
        for (int p = 0; p < 4; ++p) { const int c0 = p * 512 + lane * 8, h = c0 >> 8, dv = c0 & 255;
            *(v4u*)(Vo + ((size_t)((b * 8 + h) * 2 + (dv >> 7)) * 2304 + key) * 128 + (dv & 127)) = xin[8 + p]; }
    }
}
__device__ __forceinline__ void phase_attn1(Frame& F) {
    const att::bf16* Qo = (const att::bf16*)(F.ws + WS_Q * MiB); const att::bf16* Ko = (const att::bf16*)(F.ws + WS_K * MiB); const att::bf16* Vo = (const att::bf16*)(F.ws + WS_V * MiB);
    att::bf16* OA = (att::bf16*)(F.ws + WS_OATT * MiB);
#pragma unroll 1
    for (int i = 0; i < 4; ++i) {
        const int x = F.bid & 7, j = F.bid >> 3; const int grp = (8 * x + 2 * i + (j >> 4)) & 63, qb = j & 15, s = grp & 1, bh = grp >> 1;
        att::attn_pair_body(Qo + ((size_t)(bh * 2 + s) * 2048 + qb * 128) * 128, Ko + (size_t)(bh * 2 + s) * 2304 * 128, Vo + (size_t)(bh * 2) * 2304 * 128, Vo + (size_t)(bh * 2 + 1) * 2304 * 128,
                            OA + ((size_t)((s * 32 + bh) * 2) * 2048 + qb * 128) * 128, OA + ((size_t)((s * 32 + bh) * 2 + 1) * 2048 + qb * 128) * 128, 2304, F.lds);
        __syncthreads();
    }
}
__device__ __forceinline__ void phase_attncomb1(Frame& F, const Args& A) {
    const bf16* OA = (const bf16*)(F.ws + WS_OATT * MiB); bf16* Y = (bf16*)(F.ws + WS_Y * MiB);
    const int gw = F.bid * NWAVES + F.wave, NGW = F.G * NWAVES, lane = F.lane;
    const float* lam = ARG(29);
    const float s01 = wave_sum(lam[lane] * lam[128 + lane] + lam[64 + lane] * lam[192 + lane]);
    const float s23 = wave_sum(lam[256 + lane] * lam[384 + lane] + lam[320 + lane] * lam[448 + lane]);
    const float lmbda = expf(s01) - expf(s23) + LAM_INIT;
    const f32x4 sn = *(const f32x4*)(ARG(30) + lane * 4);
    for (int row = gw; row < TL; row += NGW) { const int b = row >> 11, t = row & 2047;
        uint2 win[8][2];
#pragma unroll
        for (int h = 0; h < 8; ++h) { const size_t oo = ((size_t)((b * 8 + h) * 2 + (lane >> 5)) * 2048 + t) * 128 + (lane & 31) * 4;
            win[h][0] = *(const uint2*)(OA + oo); win[h][1] = *(const uint2*)(OA + (size_t)64 * 2048 * 128 + oo); }
#pragma unroll
        for (int h = 0; h < 8; ++h) {
            const uint2 w0 = win[h][0], w1 = win[h][1];
            const f32x4 o0 = {bflo(w0.x), bfhi(w0.x), bflo(w0.y), bfhi(w0.y)}, o1 = {bflo(w1.x), bfhi(w1.x), bflo(w1.y), bfhi(w1.y)};
            const f32x4 o = o0 - o1 * lmbda;
            const float ss = wave_sum((o.x * o.x + o.y * o.y) + (o.z * o.z + o.w * o.w));
            const float rstd = 1.f / sqrtf(ss * (1.f / 256.f) + EPS) * (1.f - LAM_INIT);
            uint2 w; w.x = pk2(o.x * rstd * sn.x, o.y * rstd * sn.y); w.y = pk2(o.z * rstd * sn.z, o.w * rstd * sn.w);
            *(uint2*)(Y + (size_t)row * DM + h * 256 + lane * 4) = w;
        }
    }
}

#ifndef PHM
#define PHM 0xffffffffu
#endif
#ifndef REPM
#define REPM 0u
#endif
__global__ void __launch_bounds__(NWAVES * 64, 2) mega_fwd(Args args) {
    extern __shared__ __attribute__((aligned(16))) unsigned char lds[];
    Frame F;
    F.lds = (LAS unsigned char*)lds; F.ldsg = lds;
    F.tid = threadIdx.x; F.lane = F.tid & 63; F.wave = __builtin_amdgcn_readfirstlane(F.tid >> 6);
    F.G = gridDim.x; F.bid = blockIdx.x; F.ws = args.ws; F.ctl = (gu32*)(args.ws + WS_CTL);
    for (int u = F.tid; u < (LDS_BYTES - LDSCTL_OFF) / 4; u += NWAVES * 64) ((LAS unsigned*)(F.lds + LDSCTL_OFF))[u] = 0u;
    __syncthreads();
    XcdBarrier bar = xcd_barrier_post((unsigned*)(F.ctl + CW_BAR), (volatile LAS unsigned*)(F.lds + L_MISC));
    unsigned char* ws = args.ws;
#define GRID_BAR() do { xcd_barrier(bar); int t_ = threadIdx.x; asm volatile("" : "+v"(t_)); F.tid = t_; F.lane = t_ & 63; F.wave = __builtin_amdgcn_readfirstlane(t_ >> 6); } while (0)

#if (PHM >> 0) & 1
    phase_mod(F, args);
    __syncthreads();
    phase_convert(F, args);
#endif
#if (REPM >> 0) & 1
    GRID_BAR();
    phase_mod(F, args);
    __syncthreads();
    phase_convert(F, args);
#endif
    GRID_BAR();
#if (PHM >> 1) & 1
    phase_norm0(F, args);
#endif
#if (REPM >> 1) & 1
    GRID_BAR();
    phase_norm0(F, args);
#endif
    GRID_BAR();
#if (PHM >> 2) & 1
    { pg8::Gemm g{(const bf16*)(ws + WS_H * MiB), (const bf16*)(ws + WS_WIN0 * MiB), TT, N0P, 2048}; pg8::StaticOrder S; S.init(TT, N0P, F.G, F.bid);
      EpiProj0 E{(bf16*)(ws + WS_PROJ0 * MiB)};
      pg8::gemm_phase<EpiProj0, pg8::StaticOrder, true, true>(F.lds, g, S, E); }
    if (F.G == 256) phase_tail_fill(F, 0, F.bid < (36 * 37) % 256, (36 * 37) % 256);
#endif
#if (REPM >> 2) & 1
    GRID_BAR();
    { pg8::Gemm g{(const bf16*)(ws + WS_H * MiB), (const bf16*)(ws + WS_WIN0 * MiB), TT, N0P, 2048}; pg8::StaticOrder S; S.init(TT, N0P, F.G, F.bid);
      EpiProj0 E{(bf16*)(ws + WS_PROJ0 * MiB)};
      pg8::gemm_phase<EpiProj0, pg8::StaticOrder, true, true>(F.lds, g, S, E); }
#endif
    GRID_BAR();
#if (PHM >> 3) & 1
    phase_s1_dn(F);
    phase_s1_hg(F);
    if (F.G == 256) phase_tail_fill(F, 1, F.bid < 128, 128);
#endif
#if (REPM >> 3) & 1
    GRID_BAR();
    phase_s1_dn(F);
    phase_s1_hg(F);
#endif
    GRID_BAR();
#if (PHM >> 4) & 1
    phase_s2(F);
    if (F.G == 256) phase_tail_fill(F, 2, F.bid < 128, 128);
#endif
#if (REPM >> 4) & 1
    GRID_BAR();
    phase_s2(F);
#endif
    GRID_BAR();
#if (PHM >> 5) & 1
    phase_outnorm0(F, args);
#endif
#if (REPM >> 5) & 1
    GRID_BAR();
    phase_outnorm0(F, args);
#endif
    GRID_BAR();
#if (PHM >> 6) & 1
    { pg8::Gemm g{(const bf16*)(ws + WS_Y * MiB), (const bf16*)(ws + WS_WOUT0 * MiB), TT, 2048, 2048}; pg8::StaticOrder S; S.init(TT, 2048, F.G, F.bid);
      EpiResidT<false> E{ARG(0), ARG(2), (bf16*)(ws + WS_XR * MiB), (const float*)(ws + WS_MODV * MiB) + 4096};
      pg8::gemm_phase<EpiResidT<false>, pg8::StaticOrder, true, true>(F.lds, g, S, E); }
    if (F.G == 256) phase_tail_fill(F, 3, F.bid < (36 * 8) % 256, (36 * 8) % 256);
#endif
#if (REPM >> 6) & 1
    GRID_BAR();
    { pg8::Gemm g{(const bf16*)(ws + WS_Y * MiB), (const bf16*)(ws + WS_WOUT0 * MiB), TT, 2048, 2048}; pg8::StaticOrder S; S.init(TT, 2048, F.G, F.bid);
      EpiResidT<false> E{ARG(0), ARG(2), (bf16*)(ws + WS_XR * MiB), (const float*)(ws + WS_MODV * MiB) + 4096};
      pg8::gemm_phase<EpiResidT<false>, pg8::StaticOrder, true, true>(F.lds, g, S, E); }
#endif
    GRID_BAR();
#if (PHM >> 7) & 1
    phase_route<0>(F, args);
    convert_queue(F, CVQ_L0END, nullptr, 0u);
#endif
#if (REPM >> 7) & 1
    GRID_BAR();
    phase_route<0>(F, args);
#endif
    GRID_BAR();
#if (PHM >> 9) & 1
    phase_moe_gemm1<0>(F);
#endif
#if (REPM >> 9) & 1
    GRID_BAR();
    phase_moe_gemm1<0>(F);
#endif
    GRID_BAR();
#if (PHM >> 10) & 1
    phase_moe_gemm2<0>(F);
#endif
#if (REPM >> 10) & 1
    GRID_BAR();
    phase_moe_gemm2<0>(F);
#endif
    GRID_BAR();
#if (PHM >> 11) & 1
    phase_combine<0>(F, args);
    __syncthreads();
    convert_queue(F, CVQ_IN1END, nullptr, 0u);
#endif
#if (REPM >> 11) & 1
    GRID_BAR();
    phase_combine<0>(F, args);
#endif
    GRID_BAR();
#if (PHM >> 12) & 1
    { pg8::Gemm g{(const bf16*)(ws + WS_H * MiB), (const bf16*)(ws + WS_WIN1 * MiB), TT, N1, 2048}; pg8::StaticOrder S; S.init(TT, N1, F.G, F.bid);
      pg8::EpiBf16<0> E{(bf16*)(ws + WS_QKV * MiB), N1, nullptr, 0, 0, 1.f};
      pg8::gemm_phase<pg8::EpiBf16<0>, pg8::StaticOrder, true, true>(F.lds, g, S, E); }
    if (F.G == 256) phase_tail_fill(F, 4, F.bid < (36 * 24) % 256, (36 * 24) % 256);
#endif
#if (REPM >> 12) & 1
    GRID_BAR();
    { pg8::Gemm g{(const bf16*)(ws + WS_H * MiB), (const bf16*)(ws + WS_WIN1 * MiB), TT, N1, 2048}; pg8::StaticOrder S; S.init(TT, N1, F.G, F.bid);
      pg8::EpiBf16<0> E{(bf16*)(ws + WS_QKV * MiB), N1, nullptr, 0, 0, 1.f};
      pg8::gemm_phase<pg8::EpiBf16<0>, pg8::StaticOrder, true, true>(F.lds, g, S, E); }
#endif
    GRID_BAR();
#if (PHM >> 13) & 1
    phase_qkprep1(F, args);
#endif
#if (REPM >> 13) & 1
    GRID_BAR();
    phase_qkprep1(F, args);
#endif
    GRID_BAR();
#if (PHM >> 14) & 1
    phase_attn1(F);
#endif
#if (REPM >> 14) & 1
    GRID_BAR();
    phase_attn1(F);
#endif
    GRID_BAR();
#if (PHM >> 15) & 1
    phase_attncomb1(F, args);
#endif
#if (REPM >> 15) & 1
    GRID_BAR();
    phase_attncomb1(F, args);
#endif
    GRID_BAR();
#if (PHM >> 16) & 1
    { pg8::Gemm g{(const bf16*)(ws + WS_Y * MiB), (const bf16*)(ws + WS_WOUT1 * MiB), TL, 2048, 2048}; pg8::StaticOrder S; S.init(TL, 2048, F.G, F.bid);
      EpiResidT<true> E{(const bf16*)(ws + WS_XR * MiB), (const bf16*)(ws + WS_XR * MiB) + (size_t)TL * DM, (bf16*)(ws + WS_XR * MiB), (const float*)(ws + WS_MODV * MiB) + (size_t)5 * 12288 + 4096};
      pg8::gemm_phase<EpiResidT<true>, pg8::StaticOrder, true, true>(F.lds, g, S, E); }
#endif
#if (REPM >> 16) & 1
    GRID_BAR();
    { pg8::Gemm g{(const bf16*)(ws + WS_Y * MiB), (const bf16*)(ws + WS_WOUT1 * MiB), TL, 2048, 2048}; pg8::StaticOrder S; S.init(TL, 2048, F.G, F.bid);
      EpiResidT<true> E{(const bf16*)(ws + WS_XR * MiB), (const bf16*)(ws + WS_XR * MiB) + (size_t)TL * DM, (bf16*)(ws + WS_XR * MiB), (const float*)(ws + WS_MODV * MiB) + (size_t)5 * 12288 + 4096};
      pg8::gemm_phase<EpiResidT<true>, pg8::StaticOrder, true, true>(F.lds, g, S, E); }
#endif
    GRID_BAR();
#if (PHM >> 17) & 1
    phase_route<1>(F, args);
    convert_queue(F, CVQ_END, nullptr, 0u);
#endif
#if (REPM >> 17) & 1
    GRID_BAR();
    phase_route<1>(F, args);
#endif
    GRID_BAR();
#if (PHM >> 19) & 1
    phase_moe_gemm1<1>(F);
#endif
#if (REPM >> 19) & 1
    GRID_BAR();
    phase_moe_gemm1<1>(F);
#endif
    GRID_BAR();
#if (PHM >> 20) & 1
    phase_moe_gemm2<1>(F);
#endif
#if (REPM >> 20) & 1
    GRID_BAR();
    phase_moe_gemm2<1>(F);
#endif
    GRID_BAR();
#if (PHM >> 21) & 1
    phase_combine<1>(F, args);

#endif
#if (REPM >> 21) & 1
    GRID_BAR();
    phase_combine<1>(F, args);

#endif
#undef GRID_BAR
}

extern "C" void kernel_launch(void* const* d_in, const int* in_sizes, int n_in, void* d_out, int out_size, void* d_ws, size_t ws_size, hipStream_t stream) {
    static int grid = 0;
    if (grid == 0) {
        if (n_in != 38 || out_size != TL * DM || ws_size < WS_END * MiB) { fprintf(stderr, "kernel_launch: shape mismatch n_in %d out %d ws %zu\n", n_in, out_size, ws_size); grid = -1; return; }
        int dev = 0, cus = 0, per_cu = 0;
        if (hipGetDevice(&dev) != hipSuccess || hipDeviceGetAttribute(&cus, hipDeviceAttributeMultiprocessorCount, dev) != hipSuccess) { grid = -1; return; }
        if (hipFuncSetAttribute((const void*)mega_fwd, hipFuncAttributeMaxDynamicSharedMemorySize, LDS_BYTES) != hipSuccess) { fprintf(stderr, "kernel_launch: hipFuncSetAttribute failed\n"); grid = -1; return; }
        if (hipOccupancyMaxActiveBlocksPerMultiprocessor(&per_cu, (const void*)mega_fwd, NWAVES * 64, LDS_BYTES) != hipSuccess || per_cu < 1)
            fprintf(stderr, "kernel_launch: occupancy query reports %d workgroups per CU\n", per_cu);
        (void)hipGetLastError();
        grid = cus;
    }
    if (grid < 0) return;
    if (hipMemsetAsync((char*)d_ws + WS_CTL, 0, CTL_ZERO_BYTES, stream) != hipSuccess) return;
    Args a{};
    for (int i = 0; i < 38; ++i) a.in[i] = (const float*)d_in[i];
    a.out = (float*)d_out; a.ws = (unsigned char*)d_ws;
    hipLaunchKernelGGL(mega_fwd, dim3(grid), dim3(NWAVES * 64), LDS_BYTES, stream, a);
}
```
